# Optimizing an MI355X kernel written in HIP

```python
import jax, jax.numpy as jnp
from jax import lax
import numpy as np

D_MODEL = 2048
BATCH = 4
SEQ = 2048
DEPTH = 1

CHUNK = 64
N_LEFT_CHUNKS = 8
BAND_CHUNKS = N_LEFT_CHUNKS + 1
BAND = BAND_CHUNKS * CHUNK
HEAD_DIM = 128
D_MIX = D_MODEL
N_HEADS = D_MIX // HEAD_DIM
N_HEADS_A = N_HEADS // 2
N_HEADS_B = N_HEADS - N_HEADS_A
D_A = N_HEADS_A * HEAD_DIM
D_B = N_HEADS_B * HEAD_DIM
REL_CLIP = 256
N_REL = 2 * REL_CLIP + 1
Q_BLOCK = 128
D_FF = 256 * ((8 * D_MODEL // 3 + 255) // 256)
D_PLE = 256
EPS = 1e-6
NEG_INF = -1e30
D_IN = 3 * D_A + 3 * D_B + N_HEADS_B
SPLIT_POINTS = (D_A, 2 * D_A, 3 * D_A, 3 * D_A + D_B, 3 * D_A + 2 * D_B, 3 * D_A + 3 * D_B)

kernel_name = "hymba_chunked_relpos_fox_macaron"


def rms_norm(x, g):
    xf = x.astype(jnp.float32)
    y = xf * lax.rsqrt(jnp.mean(xf * xf, axis=-1, keepdims=True) + EPS)
    return (y * g.astype(jnp.float32)).astype(x.dtype)


def swiglu(x, w_gu, w_down):
    a, b = jnp.split(x @ w_gu, 2, axis=-1)
    return (jax.nn.silu(a) * b) @ w_down


def chunked_relpos_attention(q, k, v, rel_bias):
    B, S, H, Dh = q.shape
    nc = S // CHUNK
    pad = N_LEFT_CHUNKS * CHUNK
    qc = q.reshape(B, nc, CHUNK, H, Dh)
    kp = jnp.pad(k, ((0, 0), (pad, 0), (0, 0), (0, 0))).reshape(B, nc + N_LEFT_CHUNKS, CHUNK, H, Dh)
    vp = jnp.pad(v, ((0, 0), (pad, 0), (0, 0), (0, 0))).reshape(B, nc + N_LEFT_CHUNKS, CHUNK, H, Dh)
    kb = jnp.concatenate([kp[:, w:w + nc] for w in range(BAND_CHUNKS)], axis=2)
    vb = jnp.concatenate([vp[:, w:w + nc] for w in range(BAND_CHUNKS)], axis=2)
    s = jnp.einsum('bcihd,bcjhd->bchij', qc, kb).astype(jnp.float32) * (Dh ** -0.5)
    i_idx = jnp.arange(CHUNK)[:, None]
    j_idx = jnp.arange(BAND)[None, :]
    dist = jnp.clip(pad + i_idx - j_idx, -REL_CLIP, REL_CLIP) + REL_CLIP
    bias = rel_bias[:, dist].astype(jnp.float32)
    s = s + bias[None, None]
    c_idx = jnp.arange(nc)[:, None]
    w_idx = (jnp.arange(BAND) // CHUNK)[None, :]
    valid = (c_idx - N_LEFT_CHUNKS + w_idx) >= 0
    s = jnp.where(valid[None, :, None, None, :], s, NEG_INF)
    pr = jax.nn.softmax(s, axis=-1)
    o = jnp.einsum('bchij,bcjhd->bcihd', pr.astype(v.dtype), vb)
    return o.reshape(B, S, H, Dh)


def forgetting_attention(q, k, v, f_logit):
    B, S, H, Dh = q.shape
    log_f = jax.nn.log_sigmoid(f_logit.astype(jnp.float32))
    F = jnp.cumsum(log_f, axis=1)
    Ft = jnp.transpose(F, (0, 2, 1))
    scale = Dh ** -0.5
    outs = []
    for blk in range(S // Q_BLOCK):
        q0 = blk * Q_BLOCK
        q1 = q0 + Q_BLOCK
        s = jnp.einsum('bihd,bjhd->bhij', q[:, q0:q1], k[:, :q1]).astype(jnp.float32) * scale
        s = s + Ft[:, :, q0:q1, None] - Ft[:, :, None, :q1]
        mask = (q0 + jnp.arange(Q_BLOCK))[:, None] >= jnp.arange(q1)[None, :]
        s = jnp.where(mask[None, None], s, NEG_INF)
        pr = jax.nn.softmax(s, axis=-1)
        outs.append(jnp.einsum('bhij,bjhd->bihd', pr.astype(v.dtype), v[:, :q1]))
    return jnp.concatenate(outs, axis=1)


def setup_inputs(seed: int = 0) -> dict:
    key = jax.random.key(seed)
    ks = jax.random.split(key, 20)
    f32 = jnp.float32

    def nrm(k, shape, scale):
        return jax.random.normal(k, shape, f32) * scale

    def gain(k, shape):
        return 1.0 + 0.05 * jax.random.normal(k, shape, f32)

    return {
        "x": jax.random.normal(ks[0], (BATCH, SEQ, D_MODEL), f32),
        "p": jax.random.normal(ks[1], (DEPTH, BATCH, SEQ, D_PLE), f32),
        "g_ffn1": gain(ks[2], (DEPTH, D_MODEL)),
        "w_ffn1_gu": nrm(ks[3], (DEPTH, D_MODEL, 2 * D_FF), D_MODEL ** -0.5),
        "w_ffn1_down": nrm(ks[4], (DEPTH, D_FF, D_MODEL), D_FF ** -0.5),
        "g_mix": gain(ks[5], (DEPTH, D_MODEL)),
        "w_in": nrm(ks[6], (DEPTH, D_MODEL, D_IN), D_MODEL ** -0.5),
        "b_forget": 2.0 + 0.5 * jax.random.normal(ks[7], (DEPTH, N_HEADS_B), f32),
        "rel_bias": nrm(ks[8], (DEPTH, N_HEADS_A, N_REL), 0.5),
        "w_out": nrm(ks[9], (DEPTH, D_MIX, D_MODEL), D_MIX ** -0.5),
        "g_ffn2": gain(ks[10], (DEPTH, D_MODEL)),
        "w_ffn2_gu": nrm(ks[11], (DEPTH, D_MODEL, 2 * D_FF), D_MODEL ** -0.5),
        "w_ffn2_down": nrm(ks[12], (DEPTH, D_FF, D_MODEL), D_FF ** -0.5),
        "g_ple": gain(ks[13], (DEPTH, D_MODEL)),
        "w_ple_gate": nrm(ks[14], (DEPTH, D_MODEL, D_MODEL), D_MODEL ** -0.5),
        "w_ple_proj": nrm(ks[15], (DEPTH, D_PLE, D_MODEL), D_PLE ** -0.5),
        "g_final": gain(ks[16], (D_MODEL,)),
    }


def reference(x, p, g_ffn1, w_ffn1_gu, w_ffn1_down, g_mix, w_in, b_forget, rel_bias, w_out,
              g_ffn2, w_ffn2_gu, w_ffn2_down, g_ple, w_ple_gate, w_ple_proj, g_final):
    h = x
    B, S, _ = x.shape
    for i in range(DEPTH):
        h = h + 0.5 * swiglu(rms_norm(h, g_ffn1[i]), w_ffn1_gu[i], w_ffn1_down[i])
        u = rms_norm(h, g_mix[i])
        z = u @ w_in[i]
        qa, ka, va, qb, kb, vb, fl = jnp.split(z, SPLIT_POINTS, axis=-1)
        hd = lambda t, nh: t.reshape(B, S, nh, HEAD_DIM)
        o_a = chunked_relpos_attention(hd(qa, N_HEADS_A), hd(ka, N_HEADS_A), hd(va, N_HEADS_A), rel_bias[i])
        o_b = forgetting_attention(hd(qb, N_HEADS_B), hd(kb, N_HEADS_B), hd(vb, N_HEADS_B), fl + b_forget[i])
        o = jnp.concatenate([o_a.reshape(B, S, D_A), o_b.reshape(B, S, D_B)], axis=-1)
        h = h + o @ w_out[i]
        h = h + 0.5 * swiglu(rms_norm(h, g_ffn2[i]), w_ffn2_gu[i], w_ffn2_down[i])
        gate = jax.nn.sigmoid(rms_norm(h, g_ple[i]) @ w_ple_gate[i])
        h = h + gate * (p[i] @ w_ple_proj[i])
    return rms_norm(h, g_final)
```

```cpp
#include <hip/hip_runtime.h>
#include <hip/hip_cooperative_groups.h>
#include <cstdio>
#include <cstdint>
namespace cg = cooperative_groups;
#define LAS __attribute__((address_space(3)))
#define XB_TMO      128
#define XB_XCNT(j)  (256  + 64 * (j))
#define XB_XSUB(j)  (1280 + 64 * (j))
#define XB_XGEN(j)  (2304 + 64 * (j))
#define XB_TOP      3328
#define XB_TOPGEN   3392
#define XCD_BAR_WORDS 3456
#define XB_SPIN_CAP (1u << 18)

__device__ __forceinline__ unsigned xb_ld(unsigned* p)              { return __hip_atomic_load(p, __ATOMIC_RELAXED, __HIP_MEMORY_SCOPE_AGENT); }
__device__ __forceinline__ unsigned xb_add(unsigned* p, unsigned v) { return __hip_atomic_fetch_add(p, v, __ATOMIC_RELAXED, __HIP_MEMORY_SCOPE_AGENT); }
__device__ __forceinline__ unsigned xb_xcc_id() { return (unsigned)__builtin_amdgcn_s_getreg((3 << 11) | 20) & 0xFu; }
#define XB_SPIN(cond, bar) do { unsigned _sp = 0; while (cond) { __builtin_amdgcn_s_sleep(1); \
    if ((++_sp & 255u) == 0u) { if (xb_ld(&(bar)[XB_TMO])) break; if (_sp > XB_SPIN_CAP) { atomicAdd(&(bar)[XB_TMO], 1u); break; } } } } while (0)

struct XcdBarrier {
    unsigned* bar; unsigned x;
    volatile LAS unsigned* st;
};

__device__ __forceinline__ XcdBarrier xcd_barrier_post(unsigned* bar, volatile LAS unsigned* st) {
    XcdBarrier b; b.bar = bar; b.x = xb_xcc_id(); b.st = st;
    if (threadIdx.x == 0) (void)xb_add(&bar[XB_XCNT(b.x)], 1u);
    return b;
}
__device__ __forceinline__ void xcd_barrier_complete(unsigned* bar, unsigned x, unsigned& nloc, unsigned& nx) {
    const unsigned G = gridDim.x * gridDim.y * gridDim.z;
    unsigned sum, cnt, mine, sp = 0u;
    for (;;) {
        sum = 0u; cnt = 0u; mine = 0u;
#pragma unroll
        for (unsigned j = 0; j < 16; ++j) { const unsigned c = xb_ld(&bar[XB_XCNT(j)]); sum += c; cnt += (c > 0u) ? 1u : 0u; mine = (j == x) ? c : mine; }
        if (sum == G) break;
        __builtin_amdgcn_s_sleep(1);
        if ((++sp & 255u) == 0u) { if (xb_ld(&bar[XB_TMO])) break; if (sp > XB_SPIN_CAP) { atomicAdd(&bar[XB_TMO], 1u); break; } }
    }
    nloc = mine > 0u ? mine : 1u; nx = cnt > 0u ? cnt : 1u;
}

__device__ __forceinline__ void xcd_barrier(const XcdBarrier& b) {
    asm volatile("s_waitcnt vmcnt(0)" ::: "memory");
    __syncthreads();
    if (threadIdx.x == 0) {
        unsigned* bar = b.bar;
        __builtin_amdgcn_s_waitcnt(0);
        unsigned nloc = b.st[0], nx = b.st[1];
        if (nloc == 0u) { xcd_barrier_complete(bar, b.x, nloc, nx); b.st[0] = nloc; b.st[1] = nx; }
        const unsigned old = xb_add(&bar[XB_XSUB(b.x)], 1u);
        const unsigned gen = old / nloc;
        if (old + 1u == (gen + 1u) * nloc) {
            __builtin_amdgcn_fence(__ATOMIC_RELEASE, "agent");
            asm volatile("s_waitcnt vmcnt(0)" ::: "memory");
            const unsigned og = xb_add(&bar[XB_TOP], 1u);
            const unsigned tg = og / nx;
            if (og + 1u == (tg + 1u) * nx) xb_add(&bar[XB_TOPGEN], 1u);
            else XB_SPIN(xb_ld(&bar[XB_TOPGEN]) == tg, bar);
            __builtin_amdgcn_fence(__ATOMIC_ACQUIRE, "agent");
            xb_add(&bar[XB_XGEN(b.x)], 1u);
            asm volatile("s_waitcnt vmcnt(0)" ::: "memory");
        } else {
            XB_SPIN(xb_ld(&bar[XB_XGEN(b.x)]) == gen, bar);
            __builtin_amdgcn_fence(__ATOMIC_ACQUIRE, "agent");
            asm volatile("s_waitcnt vmcnt(0)" ::: "memory");
        }
    }
    __syncthreads();
}

namespace pg8 {
#define PG8_LAS __attribute__((address_space(3)))
typedef unsigned short bf16_t;
typedef short bf16x8 __attribute__((ext_vector_type(8)));
typedef float f32x4 __attribute__((ext_vector_type(4)));
typedef unsigned u32x4 __attribute__((ext_vector_type(4)));
constexpr int BM = 256, BK = 64, HALF = 128, HTB = HALF * BK * 2  , STAGE_BYTES = 8 * HTB, NXCD = 8, WGM = 8;

__host__ __device__ __forceinline__ int lds_byte(int r, int c) { const int st = (r >> 4) * 2 + (c >> 5), rr = r & 15, cc = c & 31, ob = rr * 64 + cc * 2; return st * 1024 + (ob ^ (((ob >> 9) & 1) << 5)); }
__host__ __device__ __forceinline__ void stage_rc(int b, int& R, int& C) { const int st = b / 1024, sb = b % 1024, swz = sb ^ (((sb >> 9) & 1) << 5); R = (st >> 1) * 16 + swz / 64; C = (st & 1) * 32 + (swz % 64) / 2; }
__host__ __device__ __forceinline__ int perm32(int rho) { const int n = rho >> 4, i = rho & 15; return 8 * (i >> 2) + 4 * n + (i & 3); }

struct Unit { int pm, pn; };
struct Gemm { const bf16_t* A; const bf16_t* Bt; int M, N, K; };

struct StaticOrder {
    int nM, nN, nwg, G, c;
    __host__ __device__ void init(int M, int N, int G_, int c_) { nM = M / BM; nN = N / BM; nwg = nM * nN; G = G_; c = c_; }
    __host__ __device__ bool next(int i, Unit& u) const {
        const long L = (long)i * G + c; if (L >= nwg) return false;
        int wgid = (int)L; { const int q = nwg / NXCD, r = nwg % NXCD, xcd = wgid % NXCD, off = wgid / NXCD; wgid = (xcd < r ? xcd * (q + 1) : r * (q + 1) + (xcd - r) * q) + off; }
        const int nig = WGM * nN, gid = wgid / nig, fm = gid * WGM, gsz = (nM - fm) < WGM ? (nM - fm) : WGM;
        u.pm = fm + ((wgid % nig) % gsz); u.pn = (wgid % nig) / gsz; return true;
    }
    __device__ __forceinline__ void a_ready(const Unit&) const {}
    __device__ __forceinline__ void done(const Unit&) const {}
};

__device__ __forceinline__ unsigned cvt_pk_bf16(float lo, float hi) { unsigned r; asm volatile("v_cvt_pk_bf16_f32 %0, %1, %2" : "=v"(r) : "v"(lo), "v"(hi)); return r; }
typedef float f32x2 __attribute__((ext_vector_type(2)));
#ifndef USE_TILED
#define USE_TILED false
#endif
constexpr float RMS_EPS = 1e-6f;
constexpr int DM = 2048, DFF = 5632;
__device__ __forceinline__ float rs_of(const float* ss, int row) { return __builtin_amdgcn_rsqf(ss[row] * (1.0f / 2048.0f) + RMS_EPS); }
__device__ __forceinline__ float silu_f(float a) { return a * __builtin_amdgcn_rcpf(1.0f + __builtin_amdgcn_exp2f(-1.4426950408889634f * a)); }
__device__ __forceinline__ float sigm_f(float a) { return __builtin_amdgcn_rcpf(1.0f + __builtin_amdgcn_exp2f(-1.4426950408889634f * a)); }
__device__ __forceinline__ u32x4 pack8(const f32x4 v0, const f32x4 v1) { u32x4 w; w.x = cvt_pk_bf16(v0[0], v0[1]); w.y = cvt_pk_bf16(v0[2], v0[3]); w.z = cvt_pk_bf16(v1[0], v1[1]); w.w = cvt_pk_bf16(v1[2], v1[3]); return w; }

struct EpiSwiglu {
    static constexpr bool PERM = true, AFTER_DRAIN = false;
    static constexpr bool PRELOAD = true;
    bf16_t* O; const float* ss;
    __device__ __forceinline__ void preload(const Unit& u, int wr, int fr, float (&pre)[8]) const {
#pragma unroll
        for (int i = 0; i < 8; ++i) pre[i] = ss[u.pm * BM + wr * 64 + fr + (i >> 2) * HALF + (i & 3) * 16];
    }
    __device__ __forceinline__ void operator()(const f32x4 (&acc)[2][2][4][2], const Unit& u, int wr, int wc, int fr, int fq, const float (&pre)[8]) const {
        const int row0 = u.pm * BM + wr * 64 + fr, col0 = u.pn * 128 + wc * 32 + 8 * fq;
        float rsv[2][4];
#pragma unroll
        for (int ai = 0; ai < 2; ++ai)
#pragma unroll
            for (int m = 0; m < 4; ++m) rsv[ai][m] = pre[4 * ai + m];
#pragma unroll
        for (int ai = 0; ai < 2; ++ai)
#pragma unroll
            for (int m = 0; m < 4; ++m) {
                const int r = row0 + ai * HALF + m * 16; const float rs = __builtin_amdgcn_rsqf(rsv[ai][m] * (1.0f / 2048.0f) + RMS_EPS);
                f32x4 v[2];
                const float k1 = -1.4426950408889634f * rs, rs2 = rs * rs;
#pragma unroll
                for (int n = 0; n < 2; ++n) { const f32x4 a = acc[ai][0][m][n], b = acc[ai][1][m][n];
#pragma unroll
                    for (int q = 0; q < 4; ++q) v[n][q] = (a[q] * b[q]) * rs2 * __builtin_amdgcn_rcpf(1.0f + __builtin_amdgcn_exp2f(k1 * a[q])); }
                if (USE_TILED) *(u32x4*)(O + ((size_t)(r >> 8) * (DFF / 64) + (col0 >> 6)) * 16384 + (size_t)(r & 255) * 64 + (col0 & 63)) = pack8(v[0], v[1]);
                else *(u32x4*)(O + (size_t)r * DFF + col0) = pack8(v[0], v[1]);
            }
    }
};
template <bool IN_BF16> struct EpiResid {
    static constexpr bool PERM = true, AFTER_DRAIN = true;
    const float* hin; bf16_t* hb; float* ss; float scale; ::XcdBarrier xbar;
    __device__ __forceinline__ void fused(f32x4 (&acc)[2][2][4][2], const Unit& u, int wr, int wc, int fr, int fq, PG8_LAS unsigned char*, int, int) const {
        const int row0 = u.pm * BM + wr * 64 + fr, col0 = u.pn * BM + wc * 32 + 8 * fq;
        f32x4 xv[4][2][2][2];
#define EPIRESID_LOAD(k) _Pragma("unroll") for (int mm = 0; mm < 2; ++mm) _Pragma("unroll") for (int bj = 0; bj < 2; ++bj) { \
            const size_t off_ = (size_t)(row0 + ((k) >> 1) * HALF + (2 * ((k) & 1) + mm) * 16) * DM + col0 + bj * HALF; \
            if (IN_BF16) { const u32x4 w_ = *(const u32x4*)(hb + off_); \
                xv[k][mm][bj][0] = (f32x4){__uint_as_float(w_.x << 16), __uint_as_float(w_.x & 0xffff0000u), __uint_as_float(w_.y << 16), __uint_as_float(w_.y & 0xffff0000u)}; \
                xv[k][mm][bj][1] = (f32x4){__uint_as_float(w_.z << 16), __uint_as_float(w_.z & 0xffff0000u), __uint_as_float(w_.w << 16), __uint_as_float(w_.w & 0xffff0000u)}; } \
            else { xv[k][mm][bj][0] = *(const f32x4*)(hin + off_); xv[k][mm][bj][1] = *(const f32x4*)(hin + off_ + 4); } }
        EPIRESID_LOAD(0)
#pragma unroll
        for (int k = 0; k < 4; ++k) {
            if (k == 0) { EPIRESID_LOAD(1) } else if (k == 1) { EPIRESID_LOAD(2) } else if (k == 2) { EPIRESID_LOAD(3) }
            asm volatile("" ::: "memory");
            const int ai = k >> 1;
#pragma unroll
            for (int mm = 0; mm < 2; ++mm) { const int m = 2 * (k & 1) + mm, r = row0 + ai * HALF + m * 16; float sq = 0.f;
#pragma unroll
                for (int bj = 0; bj < 2; ++bj) { const size_t off = (size_t)r * DM + col0 + bj * HALF;
                    const f32x4 a = xv[k][mm][bj][0] + acc[ai][bj][m][0] * scale, b = xv[k][mm][bj][1] + acc[ai][bj][m][1] * scale;
                    *(u32x4*)(hb + off) = pack8(a, b);
                    sq += (a[0] * a[0] + a[1] * a[1]) + (a[2] * a[2] + a[3] * a[3]) + (b[0] * b[0] + b[1] * b[1]) + (b[2] * b[2] + b[3] * b[3]); }
                sq += __shfl_xor(sq, 16); sq += __shfl_xor(sq, 32);
                if (fq == 0) unsafeAtomicAdd(ss + r, sq); }
            asm volatile("" ::: "memory");
        }
#undef EPIRESID_LOAD
        ::xcd_barrier(xbar);
    }
};
struct EpiQKV {
    static constexpr bool PERM = true, AFTER_DRAIN = false;
    static constexpr bool PRELOAD = true;
    bf16_t* base; const float* ss; float qscale; size_t tstride;
    __device__ __forceinline__ void preload(const Unit& u, int wr, int fr, float (&pre)[8]) const {
#pragma unroll
        for (int i = 0; i < 8; ++i) pre[i] = ss[u.pm * BM + wr * 64 + fr + (i >> 2) * HALF + (i & 3) * 16];
    }
    __device__ __forceinline__ void operator()(const f32x4 (&acc)[2][2][4][2], const Unit& u, int wr, int wc, int fr, int fq, const float (&pre)[8]) const {
        const int t = u.pn >> 2; const float sc = (t == 0 || t == 3) ? qscale : 1.0f;
        const int row0 = u.pm * BM + wr * 64 + fr, col0 = (u.pn & 3) * BM + wc * 32 + 8 * fq; bf16_t* O = base + (size_t)t * tstride;
        float rsv[2][4];
#pragma unroll
        for (int ai = 0; ai < 2; ++ai)
#pragma unroll
            for (int m = 0; m < 4; ++m) rsv[ai][m] = pre[4 * ai + m];
#pragma unroll
        for (int ai = 0; ai < 2; ++ai)
#pragma unroll
            for (int m = 0; m < 4; ++m) {
                const int r = row0 + ai * HALF + m * 16; const float rs = __builtin_amdgcn_rsqf(rsv[ai][m] * (1.0f / 2048.0f) + RMS_EPS) * sc;
#pragma unroll
                for (int bj = 0; bj < 2; ++bj) *(u32x4*)(O + (size_t)r * 1024 + col0 + bj * HALF) = pack8(acc[ai][bj][m][0] * rs, acc[ai][bj][m][1] * rs);
            }
    }
};
struct EpiF32 {
    static constexpr bool PERM = true, AFTER_DRAIN = false;
    float* O;
    __device__ __forceinline__ void operator()(const f32x4 (&acc)[2][2][4][2], const Unit& u, int wr, int wc, int fr, int fq) const {
        const int row0 = u.pm * BM + wr * 64 + fr, col0 = u.pn * BM + wc * 32 + 8 * fq;
#pragma unroll
        for (int ai = 0; ai < 2; ++ai)
#pragma unroll
            for (int m = 0; m < 4; ++m)
            {
#pragma unroll
              for (int bj = 0; bj < 2; ++bj) { float* o = O + (size_t)(row0 + ai * HALF + m * 16) * DM + col0 + bj * HALF; *(f32x4*)o = acc[ai][bj][m][0]; *(f32x4*)(o + 4) = acc[ai][bj][m][1]; } }
    }
};
struct EpiBf16Plain {
    static constexpr bool PERM = true, AFTER_DRAIN = false;
    bf16_t* O;
    __device__ __forceinline__ void operator()(const f32x4 (&acc)[2][2][4][2], const Unit& u, int wr, int wc, int fr, int fq) const {
        const int row0 = u.pm * BM + wr * 64 + fr, col0 = u.pn * BM + wc * 32 + 8 * fq;
#pragma unroll
        for (int ai = 0; ai < 2; ++ai)
#pragma unroll
            for (int m = 0; m < 4; ++m)
#pragma unroll
                for (int bj = 0; bj < 2; ++bj) *(u32x4*)(O + (size_t)(row0 + ai * HALF + m * 16) * DM + col0 + bj * HALF) = pack8(acc[ai][bj][m][0], acc[ai][bj][m][1]);
    }
};
struct EpiPle {
    static constexpr bool PERM = true, AFTER_DRAIN = false;
    const float* hin; float* out; const float* ss3; float* ss4;
    __device__ __forceinline__ void operator()(const f32x4 (&acc)[2][2][4][2], const Unit& u, int wr, int wc, int fr, int fq) const {
        const int row0 = u.pm * BM + wr * 64 + fr, col0 = u.pn * BM + wc * 32 + 8 * fq;
#pragma unroll
        for (int ai = 0; ai < 2; ++ai)
#pragma unroll
            for (int m = 0; m < 4; ++m) {
                const int r = row0 + ai * HALF + m * 16; const float rs = rs_of(ss3, r); float sq = 0.f;
#pragma unroll
                for (int bj = 0; bj < 2; ++bj) { const size_t off = (size_t)r * DM + col0 + bj * HALF;
                    const f32x4 x0 = *(const f32x4*)(hin + off), x1 = *(const f32x4*)(hin + off + 4), p0 = *(const f32x4*)(out + off), p1 = *(const f32x4*)(out + off + 4);
                    const f32x4 a0 = acc[ai][bj][m][0] * rs, a1 = acc[ai][bj][m][1] * rs;
                    const f32x4 g0 = (f32x4){sigm_f(a0[0]), sigm_f(a0[1]), sigm_f(a0[2]), sigm_f(a0[3])}, g1 = (f32x4){sigm_f(a1[0]), sigm_f(a1[1]), sigm_f(a1[2]), sigm_f(a1[3])};
                    const f32x4 y0 = x0 + g0 * p0, y1 = x1 + g1 * p1;
                    *(f32x4*)(out + off) = y0; *(f32x4*)(out + off + 4) = y1;
                    sq += (y0[0] * y0[0] + y0[1] * y0[1]) + (y0[2] * y0[2] + y0[3] * y0[3]) + (y1[0] * y1[0] + y1[1] * y1[1]) + (y1[2] * y1[2] + y1[3] * y1[3]); }
                sq += __shfl_xor(sq, 16); sq += __shfl_xor(sq, 32);
                if (fq == 0) unsafeAtomicAdd(ss4 + r, sq);
            }
    }
};

struct EpiPleNorm {
    static constexpr bool PERM = true, AFTER_DRAIN = true;
    const bf16_t* hbin; float* out; const float* ss3; float* ss4; const float* gfin; unsigned* pcnt; const bf16_t* ppb;
    __device__ __forceinline__ void fused(f32x4 (&acc)[2][2][4][2], const Unit& u, int wr, int wc, int fr, int fq, PG8_LAS unsigned char*, int, int lane) const {
        const int row0 = u.pm * BM + wr * 64 + fr, col0 = u.pn * BM + wc * 32 + 8 * fq;
        float rsv[2][4];
#pragma unroll
        for (int ai = 0; ai < 2; ++ai)
#pragma unroll
            for (int m = 0; m < 4; ++m) rsv[ai][m] = ss3[row0 + ai * HALF + m * 16];
#pragma unroll
        for (int ai = 0; ai < 2; ++ai)
#pragma unroll
            for (int mh = 0; mh < 2; ++mh) {
                f32x4 xv[2][2][2]; u32x4 pw[2][2];
#pragma unroll
                for (int mm = 0; mm < 2; ++mm)
#pragma unroll
                    for (int bj = 0; bj < 2; ++bj) { const size_t off = (size_t)(row0 + ai * HALF + (2 * mh + mm) * 16) * DM + col0 + bj * HALF;
                        const u32x4 w_ = *(const u32x4*)(hbin + off);
                        xv[mm][bj][0] = (f32x4){__uint_as_float(w_.x << 16), __uint_as_float(w_.x & 0xffff0000u), __uint_as_float(w_.y << 16), __uint_as_float(w_.y & 0xffff0000u)};
                        xv[mm][bj][1] = (f32x4){__uint_as_float(w_.z << 16), __uint_as_float(w_.z & 0xffff0000u), __uint_as_float(w_.w << 16), __uint_as_float(w_.w & 0xffff0000u)};
                        pw[mm][bj] = *(const u32x4*)(ppb + off); }
#pragma unroll
                for (int mm = 0; mm < 2; ++mm) { const int m = 2 * mh + mm, r = row0 + ai * HALF + m * 16; const float rs = __builtin_amdgcn_rsqf(rsv[ai][m] * (1.0f / 2048.0f) + RMS_EPS); float sq = 0.f;
#pragma unroll
                    for (int bj = 0; bj < 2; ++bj) {
                        const f32x4 a0 = acc[ai][bj][m][0] * rs, a1 = acc[ai][bj][m][1] * rs;
                        const f32x4 g0 = (f32x4){sigm_f(a0[0]), sigm_f(a0[1]), sigm_f(a0[2]), sigm_f(a0[3])}, g1 = (f32x4){sigm_f(a1[0]), sigm_f(a1[1]), sigm_f(a1[2]), sigm_f(a1[3])};
                        const u32x4 w = pw[mm][bj];
                        const f32x4 p0 = (f32x4){__uint_as_float(w.x << 16), __uint_as_float(w.x & 0xffff0000u), __uint_as_float(w.y << 16), __uint_as_float(w.y & 0xffff0000u)}, p1 = (f32x4){__uint_as_float(w.z << 16), __uint_as_float(w.z & 0xffff0000u), __uint_as_float(w.w << 16), __uint_as_float(w.w & 0xffff0000u)};
                        const f32x4 y0 = xv[mm][bj][0] + g0 * p0, y1 = xv[mm][bj][1] + g1 * p1;
                        acc[ai][bj][m][0] = y0; acc[ai][bj][m][1] = y1;
                        sq += (y0[0] * y0[0] + y0[1] * y0[1]) + (y0[2] * y0[2] + y0[3] * y0[3]) + (y1[0] * y1[0] + y1[1] * y1[1]) + (y1[2] * y1[2] + y1[3] * y1[3]); }
                    sq += __shfl_xor(sq, 16); sq += __shfl_xor(sq, 32);
                    if (fq == 0) unsafeAtomicAdd(ss4 + r, sq); }
            }
        asm volatile("s_waitcnt vmcnt(0)" ::: "memory");
        unsigned* c = pcnt + 64 * u.pm;
        if (lane == 0) __hip_atomic_fetch_add(c, 1u, __ATOMIC_RELAXED, __HIP_MEMORY_SCOPE_AGENT);
        if (wr == 0 && wc == 0) { unsigned sp = 0; while ((unsigned)__builtin_amdgcn_readfirstlane(__hip_atomic_load(c, __ATOMIC_RELAXED, __HIP_MEMORY_SCOPE_AGENT)) < 64u) { __builtin_amdgcn_s_sleep(4); if (++sp > (1u << 21)) break; } }
        asm volatile("s_waitcnt vmcnt(0) lgkmcnt(0)" ::: "memory"); __builtin_amdgcn_s_barrier(); asm volatile("" ::: "memory");
        f32x4 gv[2][2];
#pragma unroll
        for (int bj = 0; bj < 2; ++bj) { gv[bj][0] = *(const f32x4*)(gfin + col0 + bj * HALF); gv[bj][1] = *(const f32x4*)(gfin + col0 + bj * HALF + 4); }
        float s4[2][4];
#pragma unroll
        for (int ai = 0; ai < 2; ++ai)
#pragma unroll
            for (int m = 0; m < 4; ++m) s4[ai][m] = __hip_atomic_load(ss4 + row0 + ai * HALF + m * 16, __ATOMIC_RELAXED, __HIP_MEMORY_SCOPE_AGENT);
#pragma unroll
        for (int ai = 0; ai < 2; ++ai)
#pragma unroll
            for (int m = 0; m < 4; ++m) {
                const int r = row0 + ai * HALF + m * 16;
                const float rs = __builtin_amdgcn_rsqf(s4[ai][m] * (1.0f / 2048.0f) + RMS_EPS);
#pragma unroll
                for (int bj = 0; bj < 2; ++bj) { float* o = out + (size_t)r * DM + col0 + bj * HALF;
                    *(f32x4*)o = acc[ai][bj][m][0] * rs * gv[bj][0]; *(f32x4*)(o + 4) = acc[ai][bj][m][1] * rs * gv[bj][1]; }
            }
    }
};
template <class E_> struct has_preload { template <class T> static constexpr auto test(int) -> decltype(T::PRELOAD, true) { return T::PRELOAD; } template <class> static constexpr bool test(...) { return false; } static constexpr bool value = test<E_>(0); };
template <class Epi, class Sched, bool ALIGN_EPI = false, bool SP2 = false, bool TILED = false  >
__device__ __forceinline__ void gemm_phase(PG8_LAS unsigned char* lds, const Gemm g, const Sched& S, const Epi& E) {
    int tid_l = threadIdx.x; asm volatile("" : "+v"(tid_l));
    const int tid = tid_l, wid = __builtin_amdgcn_readfirstlane(tid >> 6), lane = tid & 63, wr = wid >> 2, wc = wid & 3, fr = lane & 15, fq = lane >> 4;
    const int K = g.K, nt = K / BK;
    unsigned voffA[2], voffB[2];
#pragma unroll
    for (int i = 0; i < 2; ++i) { int R, C; stage_rc(tid * 16 + i * 8192, R, C); const int Rb = Epi::PERM ? ((R & ~31) + perm32(R & 31)) : R;
        voffA[i] = (unsigned)(R * (TILED ? BK : K) + C) * 2u; voffB[i] = (unsigned)(Rb * (TILED ? BK : K) + C) * 2u; }
    const size_t kstep = TILED ? (size_t)(BM * BK * 2) : (size_t)(BK * 2);
    const size_t hstep = TILED ? (size_t)(HALF * BK * 2) : (size_t)HALF * K * 2;
    const size_t tstep = (size_t)BM * K * 2;
    const unsigned ldsw = (unsigned)wid * 1024u;
    const int aoff = lds_byte(wr * 64 + fr, fq * 8), boff = lds_byte(wc * 32 + fr, fq * 8);
#define PG8_SA(b, h) (((b) * 2 + (h)) * HTB)
#define PG8_SB(b, h) ((4 + (b) * 2 + (h)) * HTB)
#define PG8_STAGE(bufoff, gbase, voff) do { _Pragma("unroll") for (int _i = 0; _i < 2; ++_i) \
        __builtin_amdgcn_global_load_lds((const unsigned*)((const char*)(gbase) + (voff)[_i]), (PG8_LAS unsigned*)(lds + (bufoff) + ldsw + _i * 8192), 16, 0, 0); } while (0)
#define PG8_LDA(dst, b, h) do { _Pragma("unroll") for (int m = 0; m < 4; ++m) _Pragma("unroll") for (int k = 0; k < 2; ++k) dst[m][k] = *(const PG8_LAS bf16x8*)(lds + PG8_SA(b, h) + aoff + m * 2048 + k * 1024); } while (0)
#define PG8_LDB(dst, b, h) do { _Pragma("unroll") for (int n = 0; n < 2; ++n) _Pragma("unroll") for (int k = 0; k < 2; ++k) dst[n][k] = *(const PG8_LAS bf16x8*)(lds + PG8_SB(b, h) + boff + n * 2048 + k * 1024); } while (0)
#define PG8_MMA(ai, bj, At, Bt) do { __builtin_amdgcn_s_setprio(1); _Pragma("unroll") for (int m = 0; m < 4; ++m) _Pragma("unroll") for (int n = 0; n < 2; ++n) _Pragma("unroll") for (int k = 0; k < 2; ++k) \
        acc[ai][bj][m][n] = __builtin_amdgcn_mfma_f32_16x16x32_bf16(Bt[n][k], At[m][k], acc[ai][bj][m][n], 0, 0, 0); __builtin_amdgcn_s_setprio(0); } while (0)
#define PG8_WAIT_V(n) asm volatile("s_waitcnt vmcnt(" #n ")" ::: "memory")
#define PG8_WAIT_L(n) asm volatile("s_waitcnt lgkmcnt(" #n ")" ::: "memory")
#define PG8_BAR __builtin_amdgcn_s_barrier()
#define PG8_SCHED __builtin_amdgcn_sched_barrier(0)
    Unit cur, nxt; int ui = 0;
    if (!S.next(0, cur)) return;
    f32x4 acc[2][2][4][2];
#pragma unroll
    for (int a = 0; a < 2; ++a)
#pragma unroll
        for (int b = 0; b < 2; ++b)
#pragma unroll
            for (int m = 0; m < 4; ++m)
#pragma unroll
                for (int n = 0; n < 2; ++n) acc[a][b][m][n] = (f32x4){0.f, 0.f, 0.f, 0.f};
    bf16x8 At[4][2], B0[2][2], B1[2][2];
    const char* cA = (const char*)g.A + (size_t)cur.pm * tstep; const char* cB = (const char*)g.Bt + (size_t)cur.pn * tstep;
    S.a_ready(cur);
    float pre[8];
    if constexpr (has_preload<Epi>::value) E.preload(cur, wr, fr, pre);
    if constexpr (SP2) {
        PG8_STAGE(PG8_SB(0, 0), cB, voffB); PG8_STAGE(PG8_SB(0, 1), cB + hstep, voffB); PG8_STAGE(PG8_SA(0, 0), cA, voffA); PG8_STAGE(PG8_SA(0, 1), cA + hstep, voffA);
        if (wr == 1) PG8_BAR;
        PG8_WAIT_V(2); PG8_BAR;
        PG8_STAGE(PG8_SB(1, 0), cB + kstep, voffB); PG8_STAGE(PG8_SA(1, 0), cA + kstep, voffA); PG8_STAGE(PG8_SB(1, 1), cB + hstep + kstep, voffB);
        PG8_WAIT_V(6); PG8_BAR;
    } else {
        PG8_STAGE(PG8_SB(0, 0), cB, voffB); PG8_STAGE(PG8_SA(0, 0), cA, voffA); PG8_STAGE(PG8_SB(0, 1), cB + hstep, voffB); PG8_STAGE(PG8_SA(0, 1), cA + hstep, voffA);
        if (wr == 1) PG8_BAR;
        PG8_WAIT_V(4); PG8_BAR;
        PG8_STAGE(PG8_SB(1, 0), cB + kstep, voffB); PG8_STAGE(PG8_SA(1, 0), cA + kstep, voffA); PG8_STAGE(PG8_SB(1, 1), cB + hstep + kstep, voffB);
        PG8_WAIT_V(6); PG8_BAR;
    }
    for (;;) {
        const bool has_next = S.next(ui + 1, nxt);
        const char* nA = has_next ? (const char*)g.A + (size_t)nxt.pm * tstep : cA; const char* nB = has_next ? (const char*)g.Bt + (size_t)nxt.pn * tstep : cB;
        for (int t = 0; t < nt; t += 2) {
            const bool last = (t == nt - 2);
            const char* a1 = cA + (size_t)(t + 1) * kstep;
            const char* a2 = last ? nA : cA + (size_t)(t + 2) * kstep; const char* b2 = last ? nB : cB + (size_t)(t + 2) * kstep;
            const char* a3 = a2 + kstep; const char* b3 = b2 + kstep;
            if (last && has_next) S.a_ready(nxt);
            if constexpr (SP2) {
            PG8_LDB(B0, 0, 0); PG8_LDB(B1, 0, 1); PG8_SCHED; PG8_LDA(At, 0, 0); PG8_STAGE(PG8_SA(1, 1), a1 + hstep, voffA);
            PG8_WAIT_V(8); PG8_WAIT_L(0); PG8_BAR; PG8_MMA(0, 0, At, B0); PG8_MMA(0, 1, At, B1); PG8_BAR; PG8_SCHED;
            PG8_LDA(At, 0, 1); PG8_STAGE(PG8_SB(0, 0), b2, voffB); PG8_STAGE(PG8_SB(0, 1), b2 + hstep, voffB); PG8_STAGE(PG8_SA(0, 0), a2, voffA);
            PG8_WAIT_V(8); PG8_WAIT_L(0); PG8_BAR; PG8_MMA(1, 0, At, B0); PG8_MMA(1, 1, At, B1); PG8_BAR; PG8_SCHED;
            PG8_LDB(B0, 1, 0); PG8_LDB(B1, 1, 1); PG8_SCHED; PG8_LDA(At, 1, 0); PG8_STAGE(PG8_SA(0, 1), a2 + hstep, voffA);
            PG8_WAIT_V(8); PG8_WAIT_L(0); PG8_BAR; PG8_MMA(0, 0, At, B0); PG8_MMA(0, 1, At, B1); PG8_BAR; PG8_SCHED;
            PG8_LDA(At, 1, 1); PG8_STAGE(PG8_SB(1, 0), b3, voffB); PG8_STAGE(PG8_SB(1, 1), b3 + hstep, voffB); PG8_STAGE(PG8_SA(1, 0), a3, voffA);
            PG8_WAIT_V(8); PG8_WAIT_L(0); PG8_BAR; PG8_MMA(1, 0, At, B0); PG8_MMA(1, 1, At, B1); PG8_BAR; PG8_SCHED;
            } else {
            PG8_LDB(B0, 0, 0); PG8_SCHED; PG8_LDA(At, 0, 0); PG8_STAGE(PG8_SA(1, 1), a1 + hstep, voffA);
            PG8_WAIT_L(8); PG8_BAR; PG8_WAIT_L(0); PG8_MMA(0, 0, At, B0); PG8_BAR; PG8_SCHED;
            PG8_LDB(B1, 0, 1); PG8_STAGE(PG8_SB(0, 0), b2, voffB);
            PG8_BAR; PG8_WAIT_L(0); PG8_MMA(0, 1, At, B1); PG8_BAR;
            PG8_LDA(At, 0, 1); PG8_STAGE(PG8_SA(0, 0), a2, voffA);
            PG8_BAR; PG8_WAIT_L(0); PG8_MMA(1, 0, At, B0); PG8_BAR; PG8_SCHED;
            PG8_STAGE(PG8_SB(0, 1), b2 + hstep, voffB);
            PG8_WAIT_V(6); PG8_BAR; PG8_MMA(1, 1, At, B1); PG8_BAR;
            PG8_LDB(B0, 1, 0); PG8_SCHED; PG8_LDA(At, 1, 0); PG8_STAGE(PG8_SA(0, 1), a2 + hstep, voffA);
            PG8_WAIT_L(8); PG8_BAR; PG8_WAIT_L(0); PG8_MMA(0, 0, At, B0); PG8_BAR; PG8_SCHED;
            PG8_LDB(B1, 1, 1); PG8_STAGE(PG8_SB(1, 0), b3, voffB);
            PG8_BAR; PG8_WAIT_L(0); PG8_MMA(0, 1, At, B1); PG8_BAR;
            PG8_LDA(At, 1, 1); PG8_STAGE(PG8_SA(1, 0), a3, voffA);
            PG8_BAR; PG8_WAIT_L(0); PG8_MMA(1, 0, At, B0); PG8_BAR; PG8_SCHED;
            PG8_STAGE(PG8_SB(1, 1), b3 + hstep, voffB);
            PG8_WAIT_V(6); PG8_BAR; PG8_MMA(1, 1, At, B1); PG8_BAR;
            }
        }
        if constexpr (ALIGN_EPI) { if (wr == 0) PG8_BAR; }
        if constexpr (!Epi::AFTER_DRAIN) { if constexpr (has_preload<Epi>::value) E(acc, cur, wr, wc, fr, fq, pre); else E(acc, cur, wr, wc, fr, fq); S.done(cur); }
        if (!has_next) break;
#pragma unroll
        for (int a = 0; a < 2; ++a)
#pragma unroll
            for (int b = 0; b < 2; ++b)
#pragma unroll
                for (int m = 0; m < 4; ++m)
#pragma unroll
                    for (int n = 0; n < 2; ++n) acc[a][b][m][n] = (f32x4){0.f, 0.f, 0.f, 0.f};
        cur = nxt; cA = nA; cB = nB; ++ui;
        if constexpr (has_preload<Epi>::value) E.preload(cur, wr, fr, pre);
        if constexpr (ALIGN_EPI) { if (wr == 1) PG8_BAR; }
    }
    PG8_WAIT_V(0);
    if constexpr (!ALIGN_EPI) { if (wr == 0) PG8_BAR; }
    PG8_BAR;
    if constexpr (Epi::AFTER_DRAIN) { E.fused(acc, cur, wr, wc, fr, fq, lds, wid, lane); S.done(cur); }
#undef PG8_SA
#undef PG8_SB
#undef PG8_STAGE
#undef PG8_LDA
#undef PG8_LDB
#undef PG8_MMA
#undef PG8_WAIT_V
#undef PG8_WAIT_L
#undef PG8_BAR
#undef PG8_SCHED
}
}
namespace att {
#define ALAS __attribute__((address_space(3)))
typedef unsigned short bf16;
typedef short bf16x8 __attribute__((ext_vector_type(8)));
typedef short s16x4 __attribute__((ext_vector_type(4)));
typedef float f32x16 __attribute__((ext_vector_type(16)));
typedef float f32x4 __attribute__((ext_vector_type(4)));
typedef unsigned u32x4 __attribute__((ext_vector_type(4)));
typedef unsigned u32x2 __attribute__((ext_vector_type(2)));
typedef float f32x2_t __attribute__((ext_vector_type(2))); typedef __bf16 bf16x2_t __attribute__((ext_vector_type(2)));
constexpr int SEQ = 2048, NB = 4, NH = 8, HD = 128, ROWP = 1024;
constexpr int OFF_K = 0, OFF_V = 32768, OFF_NEGF = 65536, OFF_BIAS = 65536 + 8192, OFF_MISC = OFF_BIAS + 2304;
constexpr float LOG2E = 1.4426950408889634f;
__device__ __forceinline__ unsigned off_b(unsigned row, unsigned ch) { return 256u * row + 16u * (ch ^ (((row & 3u) << 2) | ((row >> 2) & 3u))); }
__device__ __forceinline__ unsigned cvtpk_s(float lo, float hi) { f32x2_t v = {lo, hi}; bf16x2_t b = __builtin_convertvector(v, bf16x2_t); return __builtin_bit_cast(unsigned, b); }
__device__ __forceinline__ float fadd_s(float x, float y) { float r = x + y; asm("" : "+v"(r)); return r; }
__device__ __forceinline__ float fsub_s(float x, float y) { float r = x - y; asm("" : "+v"(r)); return r; }
__device__ __forceinline__ float fmul_s(float x, float y) { float r = x * y; asm("" : "+v"(r)); return r; }
__device__ __forceinline__ s16x4 vtr(ALAS const unsigned char* p) { return __builtin_bit_cast(s16x4, __builtin_amdgcn_ds_read_tr16_b64_v4i16((ALAS s16x4*)p)); }

struct TileRegs { u32x4 k[2], v[2]; };
__device__ __forceinline__ void tile_gload(TileRegs& R, const bf16* Kg, const bf16* Vg, int tok0, int tid) {
#pragma unroll
    for (int i = 0; i < 2; ++i) { const int id = tid + 512 * i, row = id >> 4, ch = id & 15; const size_t o = (size_t)(tok0 + row) * ROWP + ch * 8;
        R.k[i] = *(const u32x4*)(Kg + o); R.v[i] = *(const u32x4*)(Vg + o); }
}
__device__ __forceinline__ void tile_lstore(const TileRegs& R, ALAS unsigned char* kbuf, ALAS unsigned char* vbuf, int tid) {
#pragma unroll
    for (int i = 0; i < 2; ++i) { const int id = tid + 512 * i, row = id >> 4, ch = id & 15; const unsigned o = off_b(row, ch);
        *(ALAS u32x4*)(kbuf + o) = R.k[i]; *(ALAS u32x4*)(vbuf + o) = R.v[i]; }
}

template <int MODE>
__device__ __forceinline__ void tile_compute(f32x16 (&o)[4], float& m_run, float& l_run, const bf16x8 (&qf)[8], ALAS const unsigned char* lds, ALAS const unsigned char* kbuf, ALAS const unsigned char* vbuf,
                                             int lane, int rel0  , bool cst  , int key0  , bool diag, int tloc  ) {
    const int r = lane & 31, h = lane >> 5;
    const int kap = (r & 0x13) | ((r & 4) << 1) | ((r & 8) >> 1);
    f32x16 s[2];
    if (MODE == 1) {
        ALAS const float* nf = (ALAS const float*)(lds + OFF_NEGF) + key0;
#pragma unroll
        for (int kb = 0; kb < 2; ++kb)
#pragma unroll
            for (int g = 0; g < 4; ++g) { const f32x4 f = *(ALAS const f32x4*)(nf + 32 * kb + 4 * (g & 1) + 16 * (g >> 1));
#pragma unroll
                for (int e = 0; e < 4; ++e) s[kb][4 * g + e] = f[e]; }
    } else {
        const float c = cst ? ((ALAS const float*)(lds + OFF_BIAS))[512] : 0.f;
#pragma unroll
        for (int i = 0; i < 16; ++i) { s[0][i] = c; s[1][i] = c; }
    }
#pragma unroll
    for (int ks = 0; ks < 8; ++ks) {
        const bf16x8 k0 = *(ALAS const bf16x8*)(kbuf + off_b(kap, 2 * ks + h));
        const bf16x8 k1 = *(ALAS const bf16x8*)(kbuf + 8192 + off_b(kap, 2 * ks + h));
        s[0] = __builtin_amdgcn_mfma_f32_32x32x16_bf16(k0, qf[ks], s[0], 0, 0, 0);
        s[1] = __builtin_amdgcn_mfma_f32_32x32x16_bf16(k1, qf[ks], s[1], 0, 0, 0);
    }
    if (MODE == 0) {
        if (!cst) { ALAS const float* bt = (ALAS const float*)(lds + OFF_BIAS);
#pragma unroll
            for (int kb = 0; kb < 2; ++kb)
#pragma unroll
                for (int i = 0; i < 16; ++i) { int rel = rel0 - 32 * kb - (i & 7) - 16 * (i >> 3); rel = rel < 256 ? rel : 256; rel = rel > -256 ? rel : -256; s[kb][i] = fadd_s(s[kb][i], bt[rel + 256]); }
        }
    } else if (diag) {
#pragma unroll
        for (int kb = 0; kb < 2; ++kb)
#pragma unroll
            for (int i = 0; i < 16; ++i) if (32 * kb + (i & 7) + 16 * (i >> 3) > tloc) s[kb][i] = -INFINITY;
    }
    float mx = s[0][0];
#pragma unroll
    for (int i = 1; i < 16; ++i) mx = fmaxf(mx, s[0][i]);
#pragma unroll
    for (int i = 0; i < 16; ++i) mx = fmaxf(mx, s[1][i]);
    { auto rr = __builtin_amdgcn_permlane32_swap(__float_as_uint(mx), __float_as_uint(mx), false, false); mx = fmaxf(__uint_as_float(rr[0]), __uint_as_float(rr[1])); }
    constexpr float RESC_THR = 10.0f;
    if (__builtin_amdgcn_ballot_w64(mx > m_run + RESC_THR) != 0ull) {
        const float m_new = fmaxf(m_run, mx), alpha = __builtin_amdgcn_exp2f(m_run - m_new);
        m_run = m_new; l_run *= alpha;
#pragma unroll
        for (int c = 0; c < 4; ++c)
#pragma unroll
            for (int i = 0; i < 16; ++i) o[c][i] = fmul_s(o[c][i], alpha);
    }
    float ps = 0.f;
#pragma unroll
    for (int kb = 0; kb < 2; ++kb)
#pragma unroll
        for (int i = 0; i < 16; ++i) { const float p = __builtin_amdgcn_exp2f(fsub_s(s[kb][i], m_run)); s[kb][i] = p; ps = fadd_s(ps, p); }
    l_run += ps;
    bf16x8 pf[4];
#pragma unroll
    for (int ks = 0; ks < 4; ++ks) { const int kb = ks >> 1, b8 = 8 * (ks & 1); u32x4 w;
        w.x = cvtpk_s(s[kb][b8 + 0], s[kb][b8 + 1]); w.y = cvtpk_s(s[kb][b8 + 2], s[kb][b8 + 3]); w.z = cvtpk_s(s[kb][b8 + 4], s[kb][b8 + 5]); w.w = cvtpk_s(s[kb][b8 + 6], s[kb][b8 + 7]);
        pf[ks] = __builtin_bit_cast(bf16x8, w); }
    const unsigned blk = (lane >> 4) & 1, q4 = (lane & 15) >> 2, p4 = lane & 3;
#pragma unroll
    for (int c = 0; c < 4; ++c)
#pragma unroll
        for (int ks = 0; ks < 4; ++ks) {
            ALAS const unsigned char* a0 = vbuf + off_b(16 * ks + 8 * h + q4, 4 * c + 2 * blk + (p4 >> 1)) + 8 * (p4 & 1);
            ALAS const unsigned char* a1 = vbuf + off_b(16 * ks + 8 * h + 4 + q4, 4 * c + 2 * blk + (p4 >> 1)) + 8 * (p4 & 1);
            const s16x4 lo = vtr(a0), hi = vtr(a1);
            const bf16x8 vf = (bf16x8){lo[0], lo[1], lo[2], lo[3], hi[0], hi[1], hi[2], hi[3]};
            o[c] = __builtin_amdgcn_mfma_f32_32x32x16_bf16(vf, pf[ks], o[c], 0, 0, 0);
        }
}

struct Tensors { const bf16* q; const bf16* k; const bf16* v; bf16* o; const float* lf; const float* rel_bias; };

template <int MODE>
__device__ __forceinline__ void attn_item(ALAS unsigned char* lds, const Tensors& T, int b, int hd, int blk) {
    int tid_l = threadIdx.x; asm volatile("" : "+v"(tid_l));
    const int tid = tid_l, lane = tid & 63, w = __builtin_amdgcn_readfirstlane(tid >> 6), r = lane & 31, h = lane >> 5;
    if (MODE == 0) {
        ALAS float* bt = (ALAS float*)(lds + OFF_BIAS);
        for (int i = tid; i < 513; i += 512) bt[i] = T.rel_bias[hd * 513 + i] * LOG2E;
    } else {
        ALAS float* negF = (ALAS float*)(lds + OFF_NEGF); ALAS float* wsum = (ALAS float*)(lds + OFF_MISC + 64);
        float v[4];
#pragma unroll
        for (int e = 0; e < 4; ++e) v[e] = T.lf[((size_t)(b * SEQ + 4 * tid + e)) * 8 + hd];
        v[1] += v[0]; v[2] += v[1]; v[3] += v[2];
        const float tot = v[3]; float x = tot;
#pragma unroll
        for (int o_ = 1; o_ < 64; o_ <<= 1) { const float y = __shfl_up(x, o_); if (lane >= o_) x += y; }
        if (lane == 63) wsum[w] = x;
        __syncthreads();
        float offs = x - tot;
        for (int j = 0; j < w; ++j) offs += wsum[j];
#pragma unroll
        for (int e = 0; e < 4; ++e) negF[4 * tid + e] = -(v[e] + offs) * LOG2E;
    }
    const int qt = 4 * blk + (w >> 1);
    const int t_lo = (MODE == 0) ? (4 * blk - 8 > 0 ? 4 * blk - 8 : 0) : 0, t_hi = 4 * blk + 3;
    const int w_lo = (MODE == 0) ? qt - 8 : 0, w_hi = qt;
    const int tokq = b * SEQ + 64 * qt + 32 * (w & 1) + r;
    bf16x8 qf[8];
#pragma unroll
    for (int ks = 0; ks < 8; ++ks) qf[ks] = *(const bf16x8*)(T.q + (size_t)tokq * ROWP + hd * HD + 16 * ks + 8 * h);
    f32x16 o[4];
#pragma unroll
    for (int c = 0; c < 4; ++c)
#pragma unroll
        for (int i = 0; i < 16; ++i) o[c][i] = 0.f;
    float m_run = -1e30f, l_run = 0.f;
    const bf16* Kg = T.k + hd * HD; const bf16* Vg = T.v + hd * HD;
    TileRegs R;
    tile_gload(R, Kg, Vg, b * SEQ + 64 * t_lo, tid);
    tile_lstore(R, lds + OFF_K, lds + OFF_V, tid);
    __syncthreads();
    int cur = 0;
    for (int t = t_lo; t <= t_hi; ++t) {
        const bool more = t < t_hi;
        if (more) tile_gload(R, Kg, Vg, b * SEQ + 64 * (t + 1), tid);
        if (t >= w_lo && t <= w_hi) {
            const int tq = 64 * qt + 32 * (w & 1) + r;
            tile_compute<MODE>(o, m_run, l_run, qf, lds, lds + OFF_K + cur * 16384, lds + OFF_V + cur * 16384, lane,
                               tq - 64 * t - 8 * h, (qt - t) >= 5, 64 * t + 8 * h, t == qt, tq - 64 * t - 8 * h);
        }
        if (more) tile_lstore(R, lds + OFF_K + (cur ^ 1) * 16384, lds + OFF_V + (cur ^ 1) * 16384, tid);
        __syncthreads();
        cur ^= 1;
    }
    float l_tot = l_run; { auto rr = __builtin_amdgcn_permlane32_swap(__float_as_uint(l_run), __float_as_uint(l_run), false, false); l_tot = __uint_as_float(rr[0]) + __uint_as_float(rr[1]); }
    const float inv = 1.0f / l_tot;
    bf16* orow = T.o + (size_t)tokq * 2048 + hd * HD + 4 * h;
#pragma unroll
    for (int c = 0; c < 4; ++c)
#pragma unroll
        for (int g = 0; g < 4; ++g) { u32x2 wv; wv.x = cvtpk_s(o[c][4 * g] * inv, o[c][4 * g + 1] * inv); wv.y = cvtpk_s(o[c][4 * g + 2] * inv, o[c][4 * g + 3] * inv);
            *(u32x2*)(orow + 32 * c + 8 * g) = wv; }
}
}
typedef unsigned short bf16;
typedef float f32x4 __attribute__((ext_vector_type(4)));
typedef unsigned v4u __attribute__((ext_vector_type(4)));
typedef unsigned v2u __attribute__((ext_vector_type(2)));
constexpr int NWAVES = 8, NTHR = 512;
constexpr int M = 8192, D = 2048, FF = 5632, NGU = 2 * FF, DIN = 6152, NQKV = 6144, DPLE = 256, SEQ = 2048, NHB = 8;
constexpr size_t MiB = 1u << 20;
constexpr size_t WS_CTL = 0;
constexpr size_t CTL_CNT = 0;
constexpr size_t CTL_SS = 4096;
constexpr size_t CTL_LF = CTL_SS + 5 * (size_t)M * 4;
constexpr size_t CTL_WF = CTL_LF + (size_t)M * 8 * 4;
static_assert(CTL_WF + 8 * (size_t)D * 4 <= MiB, "control region");
constexpr size_t WS_WGU1 = 1 * MiB, WS_WD1 = WS_WGU1 + 44 * MiB, WS_WIN = WS_WD1 + 22 * MiB, WS_WOUT = WS_WIN + 24 * MiB, WS_WGU2 = WS_WOUT + 8 * MiB,
                 WS_WD2 = WS_WGU2 + 44 * MiB, WS_WG = WS_WD2 + 22 * MiB, WS_WP = WS_WG + 8 * MiB, WS_PB = WS_WP + 1 * MiB  , WS_AB = WS_PB + 4 * MiB  ,
                 WS_R1 = WS_AB + 32 * MiB  , WS_H = WS_R1 + 128 * MiB  , WS_END = WS_H + 64 * MiB;
constexpr size_t QKV_T = (size_t)M * 1024;
constexpr int LDS_BYTES = 147456;

__device__ __forceinline__ unsigned f2bf(float f) { unsigned u = __builtin_bit_cast(unsigned, f); return (u + 0x7fffu + ((u >> 16) & 1u)) >> 16; }
__device__ __forceinline__ unsigned pk2(float lo, float hi) { typedef float f2_t __attribute__((ext_vector_type(2))); typedef __bf16 b2_t __attribute__((ext_vector_type(2))); f2_t v = {lo, hi}; b2_t b = __builtin_convertvector(v, b2_t); return __builtin_bit_cast(unsigned, b); }
__device__ __forceinline__ float wave_sum(float v) {
#pragma unroll
    for (int o = 1; o < 64; o <<= 1) v += __shfl_xor(v, o);
    return v;
}
struct ConvRegs { f32x4 v[16]; };
constexpr int LDS_G = 8 * 16896;
__device__ __forceinline__ void conv_load(ConvRegs& R, const float* __restrict__ W, int ldw, int k0, int n0, int lane) {
#pragma unroll
    for (int it = 0; it < 8; ++it) { const int kk = 8 * it + (lane >> 3); const float* src = W + (size_t)(k0 + kk) * ldw + n0 + 4 * (lane & 7);
        R.v[it] = __builtin_nontemporal_load((const f32x4*)src); R.v[8 + it] = __builtin_nontemporal_load((const f32x4*)(src + 32)); }
}
template <bool HAS_G, bool TILED> __device__ __forceinline__ void conv_store(const ConvRegs& R, const LAS float* gl, bf16* WT, int K, int k0, int drowA, int drowB, LAS float* scr, int lane) {
#pragma unroll
    for (int it = 0; it < 8; ++it) { const int kk = 8 * it + (lane >> 3); const float gg = HAS_G ? gl[k0 + kk] : 1.0f; LAS float* s = scr + kk * 33 + 4 * (lane & 7);
        s[0] = R.v[it][0] * gg; s[1] = R.v[it][1] * gg; s[2] = R.v[it][2] * gg; s[3] = R.v[it][3] * gg;
        s[2112 + 0] = R.v[8 + it][0] * gg; s[2112 + 1] = R.v[8 + it][1] * gg; s[2112 + 2] = R.v[8 + it][2] * gg; s[2112 + 3] = R.v[8 + it][3] * gg; }
    asm volatile("s_waitcnt lgkmcnt(0)" ::: "memory");
    const int c = lane & 7;
#pragma unroll
    for (int hf = 0; hf < 2; ++hf)
#pragma unroll
        for (int j = 0; j < 4; ++j) { const int n = (lane >> 3) + 8 * j; const LAS float* s = scr + hf * 2112 + (8 * c) * 33 + n;
            v4u o; o.x = pk2(s[0 * 33], s[1 * 33]); o.y = pk2(s[2 * 33], s[3 * 33]); o.z = pk2(s[4 * 33], s[5 * 33]); o.w = pk2(s[6 * 33], s[7 * 33]);
            const int row = (hf ? drowB : drowA) + n;
            if (TILED) *(v4u*)(WT + ((size_t)(row >> 8) * (K >> 6) + (k0 >> 6)) * 16384 + (size_t)(row & 255) * 64 + 8 * c) = o;
            else *(v4u*)(WT + (size_t)row * K + k0 + 8 * c) = o; }
    asm volatile("s_waitcnt lgkmcnt(0)" ::: "memory");
}
__device__ __forceinline__ int gu_row(int n0) { const int hi = n0 >= FF, n = n0 - (hi ? FF : 0); return 256 * (n >> 7) + (n & 127) + 128 * hi; }
template <bool HAS_G, bool gu, bool PIPE, bool TILED = false> __device__ __forceinline__ void conv_matrix(const float* W, int ldw, const float* g, bf16* WT, int K, int ncols, int wv, int nwv, LAS float* scr, int lane, LAS unsigned char* lds) {
    const LAS float* gl = (const LAS float*)(lds + LDS_G);
    if (HAS_G) { __syncthreads(); for (int i = threadIdx.x; i < K; i += NTHR) ((LAS float*)(lds + LDS_G))[i] = g[i]; __syncthreads(); }
    const int nb = ncols / 64, total = (K / 64) * nb, last = total - 1;
    ConvRegs RA, RB;
    int it = wv;
    if (!PIPE) {
        if (it < total) conv_load(RA, W, ldw, 64 * (it / nb), 64 * (it % nb), lane);
        while (it < total) {
            const int itB = it + nwv, itA2 = itB + nwv;
            if (itB < total) conv_load(RB, W, ldw, 64 * (itB / nb), 64 * (itB % nb), lane);
            { const int n0 = 64 * (it % nb); conv_store<HAS_G, TILED>(RA, gl, WT, K, 64 * (it / nb), gu ? gu_row(n0) : n0, gu ? gu_row(n0 + 32) : n0 + 32, scr, lane); }
            if (itA2 < total) conv_load(RA, W, ldw, 64 * (itA2 / nb), 64 * (itA2 % nb), lane);
            if (itB < total) { const int n0 = 64 * (itB % nb); conv_store<HAS_G, TILED>(RB, gl, WT, K, 64 * (itB / nb), gu ? gu_row(n0) : n0, gu ? gu_row(n0 + 32) : n0 + 32, scr, lane); }
            it = itA2;
        }
        return;
    }
    if (it >= total) return;
    conv_load(RA, W, ldw, 64 * (it / nb), 64 * (it % nb), lane);
    while (it < total) {
        const int itB = (it + nwv < last) ? it + nwv : last, itA2 = (it + 2 * nwv < last) ? it + 2 * nwv : last;
        conv_load(RB, W, ldw, 64 * (itB / nb), 64 * (itB % nb), lane);
        { const int n0 = 64 * (it % nb); conv_store<HAS_G, TILED>(RA, gl, WT, K, 64 * (it / nb), gu ? gu_row(n0) : n0, gu ? gu_row(n0 + 32) : n0 + 32, scr, lane); }
        conv_load(RA, W, ldw, 64 * (itA2 / nb), 64 * (itA2 % nb), lane);
        { const int n0 = 64 * (itB % nb); conv_store<HAS_G, TILED>(RB, gl, WT, K, 64 * (itB / nb), gu ? gu_row(n0) : n0, gu ? gu_row(n0 + 32) : n0 + 32, scr, lane); }
        it += 2 * nwv;
    }
}


constexpr size_t CTL_BAR = 512 * 1024;
static_assert(CTL_WF + 8 * (size_t)D * 4 <= CTL_BAR && CTL_BAR + XCD_BAR_WORDS * 4 <= MiB, "control region");
constexpr size_t CTL_PCNT = CTL_BAR + 16384;
static_assert(CTL_PCNT + 32 * 256 <= MiB, "control region");
constexpr int LDS_XB = LDS_BYTES - 64;
#ifndef USE_TILED
#define USE_TILED false
#endif
#ifndef PHMASK
#define PHMASK 0x3ff
#endif
#define PH_ON(k) (((PHMASK) >> (k)) & 1)
struct Args { const float* in[17]; float* out; unsigned char* ws; };
typedef const __attribute__((address_space(4))) unsigned char* kargp_t;
__device__ __forceinline__ unsigned long long karg64(int i) { kargp_t p = (kargp_t)__builtin_amdgcn_kernarg_segment_ptr(); asm volatile("" : "+s"(p)); return *(const __attribute__((address_space(4))) unsigned long long*)(p + 8 * i); }
#define GAS1 __attribute__((address_space(1)))
#define ARG_IN(i) ((const float*)(const GAS1 float*)karg64(i))
#define ARG_OUT ((float*)(GAS1 float*)karg64(17))
#define ARG_WS ((unsigned char*)(GAS1 unsigned char*)karg64(18))

__global__ void __launch_bounds__(NTHR, 2) fwd_kernel(Args a) {
    extern __shared__ __attribute__((aligned(16))) unsigned char lds_raw[];
    LAS unsigned char* lds = (LAS unsigned char*)lds_raw;
    cg::grid_group grid = cg::this_grid();
    const int G = gridDim.x, bx = blockIdx.x, NGW = G * NWAVES;
    const int G1 = (G == 256) ? 235 : G - (G / 12 > 0 ? G / 12 : 1);
    if (threadIdx.x == 0) { ((volatile LAS unsigned*)(lds + LDS_XB))[0] = 0u; ((volatile LAS unsigned*)(lds + LDS_XB))[1] = 0u; }
    const XcdBarrier xbar = xcd_barrier_post((unsigned*)(ARG_WS + CTL_BAR), (volatile LAS unsigned*)(lds + LDS_XB));
#define TID_DECL int tid_l = threadIdx.x; asm volatile("" : "+v"(tid_l)); const int tid = tid_l, lane = tid & 63, wave = __builtin_amdgcn_readfirstlane(tid >> 6), gw = bx * NWAVES + wave; (void)lane; (void)gw;
#define P_SS(i) ((float*)(ws + CTL_SS) + (size_t)(i) * M)
#define P_LF ((float*)(ws + CTL_LF))
#define P_WF ((float*)(ws + CTL_WF))
#define P_CNT ((unsigned*)(ws + CTL_CNT))
#define P_BF(off) ((bf16*)(ws + (off)))
#define P_ACT P_BF(WS_R1)
#define P_QKV P_BF(WS_R1)
#define P_OB P_BF(WS_R1 + 96 * MiB)
#define P_AB P_BF(WS_AB)
#define P_H ((float*)(ws + WS_H))

    {
    if constexpr (PH_ON(0)) {
        unsigned char* const ws = ARG_WS;
        TID_DECL
        LAS float* scr = (LAS float*)(lds + wave * 16896);
        conv_matrix<true, true, false>(ARG_IN(3), NGU, ARG_IN(2), P_BF(WS_WGU1), D, NGU, gw, NGW, scr, lane, lds);
        for (int m = gw; m < M; m += 2 * NGW) {
            const int m2 = (m + NGW < M) ? m + NGW : m;
            const f32x4* xa = (const f32x4*)(ARG_IN(0) + (size_t)m * D) + lane; const f32x4* xb_ = (const f32x4*)(ARG_IN(0) + (size_t)m2 * D) + lane; f32x4 va[8], vb[8];
#pragma unroll
            for (int j = 0; j < 8; ++j) va[j] = __builtin_nontemporal_load(xa + 64 * j);
#pragma unroll
            for (int j = 0; j < 8; ++j) vb[j] = __builtin_nontemporal_load(xb_ + 64 * j);
            float sa = 0.f, sb = 0.f;
#pragma unroll
            for (int j = 0; j < 8; ++j) { sa += (va[j][0] * va[j][0] + va[j][1] * va[j][1]) + (va[j][2] * va[j][2] + va[j][3] * va[j][3]); sb += (vb[j][0] * vb[j][0] + vb[j][1] * vb[j][1]) + (vb[j][2] * vb[j][2] + vb[j][3] * vb[j][3]); }
            sa = wave_sum(sa); sb = wave_sum(sb); if (lane == 0) { P_SS(0)[m] = sa; P_SS(0)[m2] = sb; }
            v2u* oa = (v2u*)(P_AB + (size_t)m * D) + lane; v2u* ob_ = (v2u*)(P_AB + (size_t)m2 * D) + lane;
#pragma unroll
            for (int j = 0; j < 8; ++j) { v2u o; o.x = pk2(va[j][0], va[j][1]); o.y = pk2(va[j][2], va[j][3]); oa[64 * j] = o; }
#pragma unroll
            for (int j = 0; j < 8; ++j) { v2u o; o.x = pk2(vb[j][0], vb[j][1]); o.y = pk2(vb[j][2], vb[j][3]); ob_[64 * j] = o; }
        }
        for (int i = bx * NTHR + tid; i < M * DPLE / 4; i += G * NTHR) { const f32x4 v = ((const f32x4*)ARG_IN(1))[i]; v2u o; o.x = pk2(v[0], v[1]); o.y = pk2(v[2], v[3]); ((v2u*)P_BF(WS_PB))[i] = o; }
        for (int i = bx * NTHR + tid; i < 4 * M; i += G * NTHR) P_SS(1)[i] = 0.f;
        if (bx == 0 && tid == 0) { P_CNT[0] = 0u; P_CNT[64] = 0u; }
        if (bx == 1) for (int i = tid; i < 32 * 64; i += NTHR) ((unsigned*)(ws + CTL_PCNT))[i] = 0u;
        for (int i = bx * NTHR + tid; i < 8 * D; i += G * NTHR) { const int j = i / D, k = i % D; P_WF[i] = ARG_IN(5)[k] * ARG_IN(6)[(size_t)k * DIN + NQKV + j]; }
    }
    }
    if (ARG_WS == nullptr) grid.sync();
    xcd_barrier(xbar);

    {
    if constexpr (PH_ON(1)) {
        unsigned char* const ws = ARG_WS;
        if (bx < G1) { pg8::Gemm g{P_AB, P_BF(WS_WGU1), M, NGU, D}; pg8::StaticOrder S; S.init(M, NGU, G1, bx);
          pg8::EpiSwiglu E{P_ACT, P_SS(0)};
          pg8::gemm_phase<pg8::EpiSwiglu, pg8::StaticOrder, true, true>(lds, g, S, E); }
        else {
            TID_DECL
            LAS float* scr = (LAS float*)(lds + wave * 16896); const int wv = (bx - G1) * NWAVES + wave, nwv = (G - G1) * NWAVES;
            conv_matrix<false, false, true, USE_TILED>(ARG_IN(4), D, nullptr, P_BF(WS_WD1), FF, D, wv, nwv, scr, lane, lds);
            conv_matrix<false, false, true>(ARG_IN(15), D, nullptr, P_BF(WS_WP), DPLE, D, wv, nwv, scr, lane, lds);
            conv_matrix<true, false, true>(ARG_IN(6), DIN, ARG_IN(5), P_BF(WS_WIN), D, NQKV, wv, nwv, scr, lane, lds);
            conv_matrix<false, false, true>(ARG_IN(9), D, nullptr, P_BF(WS_WOUT), D, D, wv, nwv, scr, lane, lds);
        }
    }
    }
    xcd_barrier(xbar);
    if constexpr (PH_ON(2)) {
        unsigned char* const ws = ARG_WS;
        pg8::Gemm g{P_ACT, P_BF(WS_WD1), M, D, FF}; pg8::StaticOrder S; S.init(M, D, G, bx);
        pg8::EpiResid<true> E{nullptr, P_AB, P_SS(1), 0.5f, xbar};
        pg8::gemm_phase<pg8::EpiResid<true>, pg8::StaticOrder, false, true, USE_TILED>(lds, g, S, E);
    }
    {
    if constexpr (PH_ON(3)) {
        unsigned char* const ws = ARG_WS;
        TID_DECL
        pg8::Gemm g{P_AB, P_BF(WS_WIN), M, NQKV, D}; pg8::StaticOrder S; S.init(M, NQKV, G, bx);
        pg8::EpiQKV E{P_QKV, P_SS(1), 0.08838834764831845f * 1.4426950408889634f, QKV_T};
        pg8::gemm_phase<pg8::EpiQKV, pg8::StaticOrder, true, true>(lds, g, S, E);
        for (int m = gw; m < M; m += 2 * NGW) {
            const int m2 = (m + NGW < M) ? m + NGW : m;
            const v2u* hra = (const v2u*)(P_AB + (size_t)m * D) + lane; const v2u* hrb = (const v2u*)(P_AB + (size_t)m2 * D) + lane; f32x4 va[8], vb[8];
#pragma unroll
            for (int j = 0; j < 8; ++j) { const v2u w = hra[64 * j]; va[j] = (f32x4){__uint_as_float(w.x << 16), __uint_as_float(w.x & 0xffff0000u), __uint_as_float(w.y << 16), __uint_as_float(w.y & 0xffff0000u)}; }
#pragma unroll
            for (int j = 0; j < 8; ++j) { const v2u w = hrb[64 * j]; vb[j] = (f32x4){__uint_as_float(w.x << 16), __uint_as_float(w.x & 0xffff0000u), __uint_as_float(w.y << 16), __uint_as_float(w.y & 0xffff0000u)}; }
            float sa[8], sb[8];
#pragma unroll
            for (int jj = 0; jj < 8; ++jj) { const f32x4* wr_ = (const f32x4*)(P_WF + (size_t)jj * D) + lane; float a = 0.f, b = 0.f;
#pragma unroll
                for (int j = 0; j < 8; ++j) { const f32x4 wv = wr_[64 * j];
                    a += (va[j][0] * wv[0] + va[j][1] * wv[1]) + (va[j][2] * wv[2] + va[j][3] * wv[3]); b += (vb[j][0] * wv[0] + vb[j][1] * wv[1]) + (vb[j][2] * wv[2] + vb[j][3] * wv[3]); }
                sa[jj] = a; sb[jj] = b; }
            const bool u5 = lane >= 32, u4 = (lane >> 4) & 1, u3 = (lane >> 3) & 1;
#define FRED(s, out) { float b4[4], c2[2]; _Pragma("unroll") for (int k = 0; k < 4; ++k) { const float snd = u5 ? s[k] : s[k + 4]; b4[k] = (u5 ? s[k + 4] : s[k]) + __shfl_xor(snd, 32); } \
                _Pragma("unroll") for (int k = 0; k < 2; ++k) { const float snd = u4 ? b4[k] : b4[k + 2]; c2[k] = (u4 ? b4[k + 2] : b4[k]) + __shfl_xor(snd, 16); } \
                { const float snd = u3 ? c2[0] : c2[1]; out = (u3 ? c2[1] : c2[0]) + __shfl_xor(snd, 8); } out += __shfl_xor(out, 4); out += __shfl_xor(out, 2); out += __shfl_xor(out, 1); }
            float da, db; FRED(sa, da) FRED(sb, db)
#undef FRED
            if ((lane & 7) == 0) { const int jj = lane >> 3; const float bf = ARG_IN(7)[jj];
                const float za = da * pg8::rs_of(P_SS(1), m) + bf, zb = db * pg8::rs_of(P_SS(1), m2) + bf;
                P_LF[(size_t)m * 8 + jj] = fminf(za, 0.f) - log1pf(__expf(-fabsf(za))); P_LF[(size_t)m2 * 8 + jj] = fminf(zb, 0.f) - log1pf(__expf(-fabsf(zb))); }
        }
    }
    xcd_barrier(xbar);
    }
    if constexpr (PH_ON(4)) {
        unsigned char* const ws = ARG_WS;
        TID_DECL
        const int GA = G - 56;
        if (bx >= GA) {
            LAS float* scr = (LAS float*)(lds + wave * 16896); const int wv = (bx - GA) * NWAVES + wave, nwv = (G - GA) * NWAVES;
            conv_matrix<true, true, true>(ARG_IN(11), NGU, ARG_IN(10), P_BF(WS_WGU2), D, NGU, wv, nwv, scr, lane, lds);
            conv_matrix<true, false, true>(ARG_IN(14), D, ARG_IN(13), P_BF(WS_WG), D, D, wv, nwv, scr, lane, lds);
            __syncthreads();
        }
        {
        LAS unsigned* slot = (LAS unsigned*)(lds + att::OFF_MISC);
        att::Tensors TA{P_QKV, P_QKV + QKV_T, P_QKV + 2 * QKV_T, P_OB, P_LF, ARG_IN(8)};
        att::Tensors TB{P_QKV + 3 * QKV_T, P_QKV + 4 * QKV_T, P_QKV + 5 * QKV_T, P_OB + 1024, P_LF, ARG_IN(8)};
        { const int rep = 0;
        for (;;) {
            if (tid == 0) slot[0] = atomicAdd(P_CNT + 64 * rep, 1u);
            __syncthreads();
            const int item = (int)slot[0];
            __syncthreads();
            if (item >= 512) break;
            int mode, blk_, bh;
            bh = item % 32; { const int grp = item / 32;
              if (grp < 5) { mode = 1; blk_ = 7 - grp; }
              else if (grp < 11) { mode = 0; blk_ = 12 - grp; }
              else if (grp == 11) { mode = 1; blk_ = 2; }
              else if (grp == 12) { mode = 0; blk_ = 1; }
              else if (grp == 13) { mode = 1; blk_ = 1; }
              else if (grp == 14) { mode = 0; blk_ = 0; }
              else { mode = 1; blk_ = 0; } }
            if (mode) att::attn_item<1>(lds, TB, bh >> 3, bh & 7, blk_); else att::attn_item<0>(lds, TA, bh >> 3, bh & 7, blk_);
        }
        }
        }
    }
    xcd_barrier(xbar);
    if constexpr (PH_ON(5)) {
        unsigned char* const ws = ARG_WS;
        pg8::Gemm g{P_OB, P_BF(WS_WOUT), M, D, D}; pg8::StaticOrder S; S.init(M, D, G, bx);
        pg8::EpiResid<true> E{nullptr, P_AB, P_SS(2), 1.0f, xbar};
        pg8::gemm_phase<pg8::EpiResid<true>, pg8::StaticOrder, false, true>(lds, g, S, E);
    }
    {
    if constexpr (PH_ON(6)) {
        unsigned char* const ws = ARG_WS;
        if (bx < G1) { pg8::Gemm g{P_AB, P_BF(WS_WGU2), M, NGU, D}; pg8::StaticOrder S; S.init(M, NGU, G1, bx);
          pg8::EpiSwiglu E{P_ACT, P_SS(2)};
          pg8::gemm_phase<pg8::EpiSwiglu, pg8::StaticOrder, true, true>(lds, g, S, E); }
        else {
            { int Kpp = DPLE; asm volatile("" : "+s"(Kpp));
              pg8::Gemm g2{P_BF(WS_PB), P_BF(WS_WP), M, D, Kpp}; pg8::StaticOrder S2; S2.init(M, D, G - G1, bx - G1); pg8::EpiBf16Plain E2{P_OB};
              pg8::gemm_phase<pg8::EpiBf16Plain, pg8::StaticOrder, true, true>(lds, g2, S2, E2); }
            TID_DECL
            LAS float* scr = (LAS float*)(lds + wave * 16896); const int wv = (bx - G1) * NWAVES + wave, nwv = (G - G1) * NWAVES;
            conv_matrix<false, false, true, USE_TILED>(ARG_IN(12), D, nullptr, P_BF(WS_WD2), FF, D, wv, nwv, scr, lane, lds);
        }
    }
    xcd_barrier(xbar);
    }
    if constexpr (PH_ON(7)) {
        unsigned char* const ws = ARG_WS;
        pg8::Gemm g{P_ACT, P_BF(WS_WD2), M, D, FF}; pg8::StaticOrder S; S.init(M, D, G, bx);
        pg8::EpiResid<true> E{nullptr, P_AB, P_SS(3), 0.5f, xbar};
        pg8::gemm_phase<pg8::EpiResid<true>, pg8::StaticOrder, false, true, USE_TILED>(lds, g, S, E);
    }
    if constexpr (PH_ON(8)) {
        unsigned char* const ws = ARG_WS;
        pg8::Gemm g{P_AB, P_BF(WS_WG), M, D, D}; pg8::StaticOrder S; S.init(M, D, G, bx);
        pg8::EpiPleNorm E{P_AB, ARG_OUT, P_SS(3), P_SS(4), ARG_IN(16), (unsigned*)(ws + CTL_PCNT), P_OB};
        pg8::gemm_phase<pg8::EpiPleNorm, pg8::StaticOrder, false, true>(lds, g, S, E);
    }
}

extern "C" void kernel_launch(void* const* d_in, const int* in_sizes, int n_in, void* d_out, int out_size, void* d_ws, size_t ws_size, hipStream_t stream) {
    static int grid = 0;
    if (grid == 0) {
        if (n_in != 17 || out_size != M * D || ws_size < WS_END) { fprintf(stderr, "kernel_launch: unexpected problem (n_in %d, out %d, ws %zu, need %zu)\n", n_in, out_size, ws_size, (size_t)WS_END); grid = -1; return; }
        int dev = 0, cus = 0, per_cu = 0;
        hipGetDevice(&dev); hipDeviceGetAttribute(&cus, hipDeviceAttributeMultiprocessorCount, dev);
        if (hipFuncSetAttribute((const void*)fwd_kernel, hipFuncAttributeMaxDynamicSharedMemorySize, LDS_BYTES) != hipSuccess) { fprintf(stderr, "kernel_launch: hipFuncSetAttribute failed\n"); grid = -1; return; }
        if (hipOccupancyMaxActiveBlocksPerMultiprocessor(&per_cu, (const void*)fwd_kernel, NTHR, LDS_BYTES) != hipSuccess || per_cu < 1) { fprintf(stderr, "kernel_launch: occupancy query says %d\n", per_cu); per_cu = 1; }
        (void)hipGetLastError();
        if (cus != 256) { fprintf(stderr, "kernel_launch: built for a 256-CU device (got %d CUs); nothing launched\n", cus); grid = -1; return; }
        grid = cus;
    }
    if (grid < 0) return;
    Args a{};
    for (int i = 0; i < 17; ++i) a.in[i] = (const float*)d_in[i];
    a.out = (float*)d_out; a.ws = (unsigned char*)d_ws;
    void* args[] = {&a};
    if (hipMemsetAsync((char*)d_ws + CTL_BAR, 0, XCD_BAR_WORDS * 4, stream) != hipSuccess) { fprintf(stderr, "kernel_launch: hipMemsetAsync failed\n"); return; }
    hipError_t e = hipLaunchCooperativeKernel((const void*)fwd_kernel, dim3(grid), dim3(NTHR), args, LDS_BYTES, stream);
    if (e != hipSuccess) fprintf(stderr, "cooperative launch failed: %s (grid %d)\n", hipGetErrorString(e), grid);
}
```

```cpp
#include <hip/hip_runtime.h>
#include <hip/hip_cooperative_groups.h>
#include <cstdio>
#include <cstdint>
namespace cg = cooperative_groups;
#define LAS __attribute__((address_space(3)))
#define XB_TMO      128
#define XB_XCNT(j)  (256  + 64 * (j))
#define XB_XSUB(j)  (1280 + 64 * (j))
#define XB_XGEN(j)  (2304 + 64 * (j))
#define XB_TOP      3328
#define XB_TOPGEN   3392
#define XCD_BAR_WORDS 3456
#define XB_SPIN_CAP (1u << 18)

__device__ __forceinline__ unsigned xb_ld(unsigned* p)              { return __hip_atomic_load(p, __ATOMIC_RELAXED, __HIP_MEMORY_SCOPE_AGENT); }
__device__ __forceinline__ unsigned xb_add(unsigned* p, unsigned v) { return __hip_atomic_fetch_add(p, v, __ATOMIC_RELAXED, __HIP_MEMORY_SCOPE_AGENT); }
__device__ __forceinline__ unsigned xb_xcc_id() { return (unsigned)__builtin_amdgcn_s_getreg((3 << 11) | 20) & 0xFu; }
#define XB_SPIN(cond, bar) do { unsigned _sp = 0; while (cond) { __builtin_amdgcn_s_sleep(1); \
    if ((++_sp & 255u) == 0u) { if (xb_ld(&(bar)[XB_TMO])) break; if (_sp > XB_SPIN_CAP) { atomicAdd(&(bar)[XB_TMO], 1u); break; } } } } while (0)

struct XcdBarrier {
    unsigned* bar; unsigned x;
    volatile LAS unsigned* st;
};

__device__ __forceinline__ XcdBarrier xcd_barrier_post(unsigned* bar, volatile LAS unsigned* st) {
    XcdBarrier b; b.bar = bar; b.x = xb_xcc_id(); b.st = st;
    if (threadIdx.x == 0) (void)xb_add(&bar[XB_XCNT(b.x)], 1u);
    return b;
}
__device__ __forceinline__ void xcd_barrier_complete(unsigned* bar, unsigned x, unsigned& nloc, unsigned& nx) {
    const unsigned G = gridDim.x * gridDim.y * gridDim.z;
    unsigned sum, cnt, mine, sp = 0u;
    for (;;) {
        sum = 0u; cnt = 0u; mine = 0u;
#pragma unroll
        for (unsigned j = 0; j < 16; ++j) { const unsigned c = xb_ld(&bar[XB_XCNT(j)]); sum += c; cnt += (c > 0u) ? 1u : 0u; mine = (j == x) ? c : mine; }
        if (sum == G) break;
        __builtin_amdgcn_s_sleep(1);
        if ((++sp & 255u) == 0u) { if (xb_ld(&bar[XB_TMO])) break; if (sp > XB_SPIN_CAP) { atomicAdd(&bar[XB_TMO], 1u); break; } }
    }
    nloc = mine > 0u ? mine : 1u; nx = cnt > 0u ? cnt : 1u;
}

__device__ __forceinline__ void xcd_barrier(const XcdBarrier& b) {
    asm volatile("s_waitcnt vmcnt(0)" ::: "memory");
    __syncthreads();
    if (threadIdx.x == 0) {
        unsigned* bar = b.bar;
        __builtin_amdgcn_s_waitcnt(0);
        unsigned nloc = b.st[0], nx = b.st[1];
        if (nloc == 0u) { xcd_barrier_complete(bar, b.x, nloc, nx); b.st[0] = nloc; b.st[1] = nx; }
        const unsigned old = xb_add(&bar[XB_XSUB(b.x)], 1u);
        const unsigned gen = old / nloc;
        if (old + 1u == (gen + 1u) * nloc) {
            __builtin_amdgcn_fence(__ATOMIC_RELEASE, "agent");
            asm volatile("s_waitcnt vmcnt(0)" ::: "memory");
            const unsigned og = xb_add(&bar[XB_TOP], 1u);
            const unsigned tg = og / nx;
            if (og + 1u == (tg + 1u) * nx) xb_add(&bar[XB_TOPGEN], 1u);
            else XB_SPIN(xb_ld(&bar[XB_TOPGEN]) == tg, bar);
            __builtin_amdgcn_fence(__ATOMIC_ACQUIRE, "agent");
            xb_add(&bar[XB_XGEN(b.x)], 1u);
            asm volatile("s_waitcnt vmcnt(0)" ::: "memory");
        } else {
            XB_SPIN(xb_ld(&bar[XB_XGEN(b.x)]) == gen, bar);
            __builtin_amdgcn_fence(__ATOMIC_ACQUIRE, "agent");
            asm volatile("s_waitcnt vmcnt(0)" ::: "memory");
        }
    }
    __syncthreads();
}

namespace pg8 {
#define PG8_LAS __attribute__((address_space(3)))
typedef unsigned short bf16_t;
typedef short bf16x8 __attribute__((ext_vector_type(8)));
typedef float f32x4 __attribute__((ext_vector_type(4)));
typedef unsigned u32x4 __attribute__((ext_vector_type(4)));
constexpr int BM = 256, BK = 64, HALF = 128, HTB = HALF * BK * 2  , STAGE_BYTES = 8 * HTB, NXCD = 8, WGM = 8;

__host__ __device__ __forceinline__ int lds_byte(int r, int c) { const int st = (r >> 4) * 2 + (c >> 5), rr = r & 15, cc = c & 31, ob = rr * 64 + cc * 2; return st * 1024 + (ob ^ (((ob >> 9) & 1) << 5)); }
__host__ __device__ __forceinline__ void stage_rc(int b, int& R, int& C) { const int st = b / 1024, sb = b % 1024, swz = sb ^ (((sb >> 9) & 1) << 5); R = (st >> 1) * 16 + swz / 64; C = (st & 1) * 32 + (swz % 64) / 2; }
__host__ __device__ __forceinline__ int perm32(int rho) { const int n = rho >> 4, i = rho & 15; return 8 * (i >> 2) + 4 * n + (i & 3); }

struct Unit { int pm, pn; };
struct Gemm { const bf16_t* A; const bf16_t* Bt; int M, N, K; };

struct StaticOrder {
    int nM, nN, nwg, G, c;
    __host__ __device__ void init(int M, int N, int G_, int c_) { nM = M / BM; nN = N / BM; nwg = nM * nN; G = G_; c = c_; }
    __host__ __device__ bool next(int i, Unit& u) const {
        const long L = (long)i * G + c; if (L >= nwg) return false;
        int wgid = (int)L; { const int q = nwg / NXCD, r = nwg % NXCD, xcd = wgid % NXCD, off = wgid / NXCD; wgid = (xcd < r ? xcd * (q + 1) : r * (q + 1) + (xcd - r) * q) + off; }
        const int nig = WGM * nN, gid = wgid / nig, fm = gid * WGM, gsz = (nM - fm) < WGM ? (nM - fm) : WGM;
        u.pm = fm + ((wgid % nig) % gsz); u.pn = (wgid % nig) / gsz; return true;
    }
    __device__ __forceinline__ void a_ready(const Unit&) const {}
    __device__ __forceinline__ void done(const Unit&) const {}
};

__device__ __forceinline__ unsigned cvt_pk_bf16(float lo, float hi) { unsigned r; asm volatile("v_cvt_pk_bf16_f32 %0, %1, %2" : "=v"(r) : "v"(lo), "v"(hi)); return r; }
typedef float f32x2 __attribute__((ext_vector_type(2)));
#ifndef USE_TILED
#define USE_TILED false
#endif
constexpr float RMS_EPS = 1e-6f;
constexpr int DM = 2048, DFF = 5632;
__device__ __forceinline__ float rs_of(const float* ss, int row) { return __builtin_amdgcn_rsqf(ss[row] * (1.0f / 2048.0f) + RMS_EPS); }
__device__ __forceinline__ float silu_f(float a) { return a * __builtin_amdgcn_rcpf(1.0f + __builtin_amdgcn_exp2f(-1.4426950408889634f * a)); }
__device__ __forceinline__ float sigm_f(float a) { return __builtin_amdgcn_rcpf(1.0f + __builtin_amdgcn_exp2f(-1.4426950408889634f * a)); }
__device__ __forceinline__ u32x4 pack8(const f32x4 v0, const f32x4 v1) { u32x4 w; w.x = cvt_pk_bf16(v0[0], v0[1]); w.y = cvt_pk_bf16(v0[2], v0[3]); w.z = cvt_pk_bf16(v1[0], v1[1]); w.w = cvt_pk_bf16(v1[2], v1[3]); return w; }

struct EpiSwiglu {
    static constexpr bool PERM = true, AFTER_DRAIN = false;
    static constexpr bool PRELOAD = true;
    bf16_t* O; const float* ss;
    __device__ __forceinline__ void preload(const Unit& u, int wr, int fr, float (&pre)[8]) const {
#pragma unroll
        for (int i = 0; i < 8; ++i) pre[i] = ss[u.pm * BM + wr * 64 + fr + (i >> 2) * HALF + (i & 3) * 16];
    }
    __device__ __forceinline__ void operator()(const f32x4 (&acc)[2][2][4][2], const Unit& u, int wr, int wc, int fr, int fq, const float (&pre)[8]) const {
        const int row0 = u.pm * BM + wr * 64 + fr, col0 = u.pn * 128 + wc * 32 + 8 * fq;
        float rsv[2][4];
#pragma unroll
        for (int ai = 0; ai < 2; ++ai)
#pragma unroll
            for (int m = 0; m < 4; ++m) rsv[ai][m] = pre[4 * ai + m];
#pragma unroll
        for (int ai = 0; ai < 2; ++ai)
#pragma unroll
            for (int m = 0; m < 4; ++m) {
                const int r = row0 + ai * HALF + m * 16; const float rs = __builtin_amdgcn_rsqf(rsv[ai][m] * (1.0f / 2048.0f) + RMS_EPS);
                f32x4 v[2];
                const float k1 = -1.4426950408889634f * rs, rs2 = rs * rs;
#pragma unroll
                for (int n = 0; n < 2; ++n) { const f32x4 a = acc[ai][0][m][n], b = acc[ai][1][m][n];
#pragma unroll
                    for (int q = 0; q < 4; ++q) v[n][q] = (a[q] * b[q]) * rs2 * __builtin_amdgcn_rcpf(1.0f + __builtin_amdgcn_exp2f(k1 * a[q])); }
                if (USE_TILED) *(u32x4*)(O + ((size_t)(r >> 8) * (DFF / 64) + (col0 >> 6)) * 16384 + (size_t)(r & 255) * 64 + (col0 & 63)) = pack8(v[0], v[1]);
                else *(u32x4*)(O + (size_t)r * DFF + col0) = pack8(v[0], v[1]);
            }
    }
};
template <bool IN_BF16> struct EpiResid {
    static constexpr bool PERM = true, AFTER_DRAIN = true;
    const float* hin; bf16_t* hb; float* ss; float scale; ::XcdBarrier xbar;
    __device__ __forceinline__ void fused(f32x4 (&acc)[2][2][4][2], const Unit& u, int wr, int wc, int fr, int fq, PG8_LAS unsigned char*, int, int) const {
        const int row0 = u.pm * BM + wr * 64 + fr, col0 = u.pn * BM + wc * 32 + 8 * fq;
        f32x4 xv[4][2][2][2];
#define EPIRESID_LOAD(k) _Pragma("unroll") for (int mm = 0; mm < 2; ++mm) _Pragma("unroll") for (int bj = 0; bj < 2; ++bj) { \
            const size_t off_ = (size_t)(row0 + ((k) >> 1) * HALF + (2 * ((k) & 1) + mm) * 16) * DM + col0 + bj * HALF; \
            if (IN_BF16) { const u32x4 w_ = *(const u32x4*)(hb + off_); \
                xv[k][mm][bj][0] = (f32x4){__uint_as_float(w_.x << 16), __uint_as_float(w_.x & 0xffff0000u), __uint_as_float(w_.y << 16), __uint_as_float(w_.y & 0xffff0000u)}; \
                xv[k][mm][bj][1] = (f32x4){__uint_as_float(w_.z << 16), __uint_as_float(w_.z & 0xffff0000u), __uint_as_float(w_.w << 16), __uint_as_float(w_.w & 0xffff0000u)}; } \
            else { xv[k][mm][bj][0] = *(const f32x4*)(hin + off_); xv[k][mm][bj][1] = *(const f32x4*)(hin + off_ + 4); } }
        EPIRESID_LOAD(0)
#pragma unroll
        for (int k = 0; k < 4; ++k) {
            if (k == 0) { EPIRESID_LOAD(1) } else if (k == 1) { EPIRESID_LOAD(2) } else if (k == 2) { EPIRESID_LOAD(3) }
            asm volatile("" ::: "memory");
            const int ai = k >> 1;
#pragma unroll
            for (int mm = 0; mm < 2; ++mm) { const int m = 2 * (k & 1) + mm, r = row0 + ai * HALF + m * 16; float sq = 0.f;
#pragma unroll
                for (int bj = 0; bj < 2; ++bj) { const size_t off = (size_t)r * DM + col0 + bj * HALF;
                    const f32x4 a = xv[k][mm][bj][0] + acc[ai][bj][m][0] * scale, b = xv[k][mm][bj][1] + acc[ai][bj][m][1] * scale;
                    *(u32x4*)(hb + off) = pack8(a, b);
                    sq += (a[0] * a[0] + a[1] * a[1]) + (a[2] * a[2] + a[3] * a[3]) + (b[0] * b[0] + b[1] * b[1]) + (b[2] * b[2] + b[3] * b[3]); }
                sq += __shfl_xor(sq, 16); sq += __shfl_xor(sq, 32);
                if (fq == 0) unsafeAtomicAdd(ss + r, sq); }
            asm volatile("" ::: "memory");
        }
#undef EPIRESID_LOAD
        ::xcd_barrier(xbar);
    }
};
struct EpiQKV {
    static constexpr bool PERM = true, AFTER_DRAIN = false;
    static constexpr bool PRELOAD = true;
    bf16_t* base; const float* ss; float qscale; size_t tstride;
    __device__ __forceinline__ void preload(const Unit& u, int wr, int fr, float (&pre)[8]) const {
#pragma unroll
        for (int i = 0; i < 8; ++i) pre[i] = ss[u.pm * BM + wr * 64 + fr + (i >> 2) * HALF + (i & 3) * 16];
    }
    __device__ __forceinline__ void operator()(const f32x4 (&acc)[2][2][4][2], const Unit& u, int wr, int wc, int fr, int fq, const float (&pre)[8]) const {
        const int t = u.pn >> 2; const float sc = (t == 0 || t == 3) ? qscale : 1.0f;
        const int row0 = u.pm * BM + wr * 64 + fr, col0 = (u.pn & 3) * BM + wc * 32 + 8 * fq; bf16_t* O = base + (size_t)t * tstride;
        float rsv[2][4];
#pragma unroll
        for (int ai = 0; ai < 2; ++ai)
#pragma unroll
            for (int m = 0; m < 4; ++m) rsv[ai][m] = pre[4 * ai + m];
#pragma unroll
        for (int ai = 0; ai < 2; ++ai)
#pragma unroll
            for (int m = 0; m < 4; ++m) {
                const int r = row0 + ai * HALF + m * 16; const float rs = __builtin_amdgcn_rsqf(rsv[ai][m] * (1.0f / 2048.0f) + RMS_EPS) * sc;
#pragma unroll
                for (int bj = 0; bj < 2; ++bj) *(u32x4*)(O + (size_t)r * 1024 + col0 + bj * HALF) = pack8(acc[ai][bj][m][0] * rs, acc[ai][bj][m][1] * rs);
            }
    }
};
struct EpiF32 {
    static constexpr bool PERM = true, AFTER_DRAIN = false;
    float* O;
    __device__ __forceinline__ void operator()(const f32x4 (&acc)[2][2][4][2], const Unit& u, int wr, int wc, int fr, int fq) const {
        const int row0 = u.pm * BM + wr * 64 + fr, col0 = u.pn * BM + wc * 32 + 8 * fq;
#pragma unroll
        for (int ai = 0; ai < 2; ++ai)
#pragma unroll
            for (int m = 0; m < 4; ++m)
            {
#pragma unroll
              for (int bj = 0; bj < 2; ++bj) { float* o = O + (size_t)(row0 + ai * HALF + m * 16) * DM + col0 + bj * HALF; *(f32x4*)o = acc[ai][bj][m][0]; *(f32x4*)(o + 4) = acc[ai][bj][m][1]; } }
    }
};
struct EpiBf16Plain {
    static constexpr bool PERM = true, AFTER_DRAIN = false;
    bf16_t* O;
    __device__ __forceinline__ void operator()(const f32x4 (&acc)[2][2][4][2], const Unit& u, int wr, int wc, int fr, int fq) const {
        const int row0 = u.pm * BM + wr * 64 + fr, col0 = u.pn * BM + wc * 32 + 8 * fq;
#pragma unroll
        for (int ai = 0; ai < 2; ++ai)
#pragma unroll
            for (int m = 0; m < 4; ++m)
#pragma unroll
                for (int bj = 0; bj < 2; ++bj) *(u32x4*)(O + (size_t)(row0 + ai * HALF + m * 16) * DM + col0 + bj * HALF) = pack8(acc[ai][bj][m][0], acc[ai][bj][m][1]);
    }
};
struct EpiPle {
    static constexpr bool PERM = true, AFTER_DRAIN = false;
    const float* hin; float* out; const float* ss3; float* ss4;
    __device__ __forceinline__ void operator()(const f32x4 (&acc)[2][2][4][2], const Unit& u, int wr, int wc, int fr, int fq) const {
        const int row0 = u.pm * BM + wr * 64 + fr, col0 = u.pn * BM + wc * 32 + 8 * fq;
#pragma unroll
        for (int ai = 0; ai < 2; ++ai)
#pragma unroll
            for (int m = 0; m < 4; ++m) {
                const int r = row0 + ai * HALF + m * 16; const float rs = rs_of(ss3, r); float sq = 0.f;
#pragma unroll
                for (int bj = 0; bj < 2; ++bj) { const size_t off = (size_t)r * DM + col0 + bj * HALF;
                    const f32x4 x0 = *(const f32x4*)(hin + off), x1 = *(const f32x4*)(hin + off + 4), p0 = *(const f32x4*)(out + off), p1 = *(const f32x4*)(out + off + 4);
                    const f32x4 a0 = acc[ai][bj][m][0] * rs, a1 = acc[ai][bj][m][1] * rs;
                    const f32x4 g0 = (f32x4){sigm_f(a0[0]), sigm_f(a0[1]), sigm_f(a0[2]), sigm_f(a0[3])}, g1 = (f32x4){sigm_f(a1[0]), sigm_f(a1[1]), sigm_f(a1[2]), sigm_f(a1[3])};
                    const f32x4 y0 = x0 + g0 * p0, y1 = x1 + g1 * p1;
                    *(f32x4*)(out + off) = y0; *(f32x4*)(out + off + 4) = y1;
                    sq += (y0[0] * y0[0] + y0[1] * y0[1]) + (y0[2] * y0[2] + y0[3] * y0[3]) + (y1[0] * y1[0] + y1[1] * y1[1]) + (y1[2] * y1[2] + y1[3] * y1[3]); }
                sq += __shfl_xor(sq, 16); sq += __shfl_xor(sq, 32);
                if (fq == 0) unsafeAtomicAdd(ss4 + r, sq);
            }
    }
};

struct EpiPleNorm {
    static constexpr bool PERM = true, AFTER_DRAIN = true;
    const bf16_t* hbin; float* out; const float* ss3; float* ss4; const float* gfin; unsigned* pcnt; const bf16_t* ppb;
    __device__ __forceinline__ void fused(f32x4 (&acc)[2][2][4][2], const Unit& u, int wr, int wc, int fr, int fq, PG8_LAS unsigned char*, int, int lane) const {
        const int row0 = u.pm * BM + wr * 64 + fr, col0 = u.pn * BM + wc * 32 + 8 * fq;
        float rsv[2][4];
#pragma unroll
        for (int ai = 0; ai < 2; ++ai)
#pragma unroll
            for (int m = 0; m < 4; ++m) rsv[ai][m] = ss3[row0 + ai * HALF + m * 16];
#pragma unroll
        for (int ai = 0; ai < 2; ++ai)
#pragma unroll
            for (int mh = 0; mh < 2; ++mh) {
                f32x4 xv[2][2][2]; u32x4 pw[2][2];
#pragma unroll
                for (int mm = 0; mm < 2; ++mm)
#pragma unroll
                    for (int bj = 0; bj < 2; ++bj) { const size_t off = (size_t)(row0 + ai * HALF + (2 * mh + mm) * 16) * DM + col0 + bj * HALF;
                        const u32x4 w_ = *(const u32x4*)(hbin + off);
                        xv[mm][bj][0] = (f32x4){__uint_as_float(w_.x << 16), __uint_as_float(w_.x & 0xffff0000u), __uint_as_float(w_.y << 16), __uint_as_float(w_.y & 0xffff0000u)};
                        xv[mm][bj][1] = (f32x4){__uint_as_float(w_.z << 16), __uint_as_float(w_.z & 0xffff0000u), __uint_as_float(w_.w << 16), __uint_as_float(w_.w & 0xffff0000u)};
                        pw[mm][bj] = *(const u32x4*)(ppb + off); }
#pragma unroll
                for (int mm = 0; mm < 2; ++mm) { const int m = 2 * mh + mm, r = row0 + ai * HALF + m * 16; const float rs = __builtin_amdgcn_rsqf(rsv[ai][m] * (1.0f / 2048.0f) + RMS_EPS); float sq = 0.f;
#pragma unroll
                    for (int bj = 0; bj < 2; ++bj) {
                        const f32x4 a0 = acc[ai][bj][m][0] * rs, a1 = acc[ai][bj][m][1] * rs;
                        const f32x4 g0 = (f32x4){sigm_f(a0[0]), sigm_f(a0[1]), sigm_f(a0[2]), sigm_f(a0[3])}, g1 = (f32x4){sigm_f(a1[0]), sigm_f(a1[1]), sigm_f(a1[2]), sigm_f(a1[3])};
                        const u32x4 w = pw[mm][bj];
                        const f32x4 p0 = (f32x4){__uint_as_float(w.x << 16), __uint_as_float(w.x & 0xffff0000u), __uint_as_float(w.y << 16), __uint_as_float(w.y & 0xffff0000u)}, p1 = (f32x4){__uint_as_float(w.z << 16), __uint_as_float(w.z & 0xffff0000u), __uint_as_float(w.w << 16), __uint_as_float(w.w & 0xffff0000u)};
                        const f32x4 y0 = xv[mm][bj][0] + g0 * p0, y1 = xv[mm][bj][1] + g1 * p1;
                        acc[ai][bj][m][0] = y0; acc[ai][bj][m][1] = y1;
                        sq += (y0[0] * y0[0] + y0[1] * y0[1]) + (y0[2] * y0[2] + y0[3] * y0[3]) + (y1[0] * y1[0] + y1[1] * y1[1]) + (y1[2] * y1[2] + y1[3] * y1[3]); }
                    sq += __shfl_xor(sq, 16); sq += __shfl_xor(sq, 32);
                    if (fq == 0) unsafeAtomicAdd(ss4 + r, sq); }
            }
        asm volatile("s_waitcnt vmcnt(0)" ::: "memory");
        unsigned* c = pcnt + 64 * u.pm;
        if (lane == 0) __hip_atomic_fetch_add(c, 1u, __ATOMIC_RELAXED, __HIP_MEMORY_SCOPE_AGENT);
        if (wr == 0 && wc == 0) { unsigned sp = 0; while ((unsigned)__builtin_amdgcn_readfirstlane(__hip_atomic_load(c, __ATOMIC_RELAXED, __HIP_MEMORY_SCOPE_AGENT)) < 64u) { __builtin_amdgcn_s_sleep(4); if (++sp > (1u << 21)) break; } }
        asm volatile("s_waitcnt vmcnt(0) lgkmcnt(0)" ::: "memory"); __builtin_amdgcn_s_barrier(); asm volatile("" ::: "memory");
        f32x4 gv[2][2];
#pragma unroll
        for (int bj = 0; bj < 2; ++bj) { gv[bj][0] = *(const f32x4*)(gfin + col0 + bj * HALF); gv[bj][1] = *(const f32x4*)(gfin + col0 + bj * HALF + 4); }
        float s4[2][4];
#pragma unroll
        for (int ai = 0; ai < 2; ++ai)
#pragma unroll
            for (int m = 0; m < 4; ++m) s4[ai][m] = __hip_atomic_load(ss4 + row0 + ai * HALF + m * 16, __ATOMIC_RELAXED, __HIP_MEMORY_SCOPE_AGENT);
#pragma unroll
        for (int ai = 0; ai < 2; ++ai)
#pragma unroll
            for (int m = 0; m < 4; ++m) {
                const int r = row0 + ai * HALF + m * 16;
                const float rs = __builtin_amdgcn_rsqf(s4[ai][m] * (1.0f / 2048.0f) + RMS_EPS);
#pragma unroll
                for (int bj = 0; bj < 2; ++bj) { float* o = out + (size_t)r * DM + col0 + bj * HALF;
                    *(f32x4*)o = acc[ai][bj][m][0] * rs * gv[bj][0]; *(f32x4*)(o + 4) = acc[ai][bj][m][1] * rs * gv[bj][1]; }
            }
    }
};
template <class E_> struct has_preload { template <class T> static constexpr auto test(int) -> decltype(T::PRELOAD, true) { return T::PRELOAD; } template <class> static constexpr bool test(...) { return false; } static constexpr bool value = test<E_>(0); };
template <class Epi, class Sched, bool ALIGN_EPI = false, bool SP2 = false, bool TILED = false  >
__device__ __forceinline__ void gemm_phase(PG8_LAS unsigned char* lds, const Gemm g, const Sched& S, const Epi& E) {
    int tid_l = threadIdx.x; asm volatile("" : "+v"(tid_l));
    const int tid = tid_l, wid = __builtin_amdgcn_readfirstlane(tid >> 6), lane = tid & 63, wr = wid >> 2, wc = wid & 3, fr = lane & 15, fq = lane >> 4;
    const int K = g.K, nt = K / BK;
    unsigned voffA[2], voffB[2];
#pragma unroll
    for (int i = 0; i < 2; ++i) { int R, C; stage_rc(tid * 16 + i * 8192, R, C); const int Rb = Epi::PERM ? ((R & ~31) + perm32(R & 31)) : R;
        voffA[i] = (unsigned)(R * (TILED ? BK : K) + C) * 2u; voffB[i] = (unsigned)(Rb * (TILED ? BK : K) + C) * 2u; }
    const size_t kstep = TILED ? (size_t)(BM * BK * 2) : (size_t)(BK * 2);
    const size_t hstep = TILED ? (size_t)(HALF * BK * 2) : (size_t)HALF * K * 2;
    const size_t tstep = (size_t)BM * K * 2;
    const unsigned ldsw = (unsigned)wid * 1024u;
    const int aoff = lds_byte(wr * 64 + fr, fq * 8), boff = lds_byte(wc * 32 + fr, fq * 8);
#define PG8_SA(b, h) (((b) * 2 + (h)) * HTB)
#define PG8_SB(b, h) ((4 + (b) * 2 + (h)) * HTB)
#define PG8_STAGE(bufoff, gbase, voff) do { _Pragma("unroll") for (int _i = 0; _i < 2; ++_i) \
        __builtin_amdgcn_global_load_lds((const unsigned*)((const char*)(gbase) + (voff)[_i]), (PG8_LAS unsigned*)(lds + (bufoff) + ldsw + _i * 8192), 16, 0, 0); } while (0)
#define PG8_LDA(dst, b, h) do { _Pragma("unroll") for (int m = 0; m < 4; ++m) _Pragma("unroll") for (int k = 0; k < 2; ++k) dst[m][k] = *(const PG8_LAS bf16x8*)(lds + PG8_SA(b, h) + aoff + m * 2048 + k * 1024); } while (0)
#define PG8_LDB(dst, b, h) do { _Pragma("unroll") for (int n = 0; n < 2; ++n) _Pragma("unroll") for (int k = 0; k < 2; ++k) dst[n][k] = *(const PG8_LAS bf16x8*)(lds + PG8_SB(b, h) + boff + n * 2048 + k * 1024); } while (0)
#define PG8_MMA(ai, bj, At, Bt) do { __builtin_amdgcn_s_setprio(1); _Pragma("unroll") for (int m = 0; m < 4; ++m) _Pragma("unroll") for (int n = 0; n < 2; ++n) _Pragma("unroll") for (int k = 0; k < 2; ++k) \
        acc[ai][bj][m][n] = __builtin_amdgcn_mfma_f32_16x16x32_bf16(Bt[n][k], At[m][k], acc[ai][bj][m][n], 0, 0, 0); __builtin_amdgcn_s_setprio(0); } while (0)
#define PG8_WAIT_V(n) asm volatile("s_waitcnt vmcnt(" #n ")" ::: "memory")
#define PG8_WAIT_L(n) asm volatile("s_waitcnt lgkmcnt(" #n ")" ::: "memory")
#define PG8_BAR __builtin_amdgcn_s_barrier()
#define PG8_SCHED __builtin_amdgcn_sched_barrier(0)
    Unit cur, nxt; int ui = 0;
    if (!S.next(0, cur)) return;
    f32x4 acc[2][2][4][2];
#pragma unroll
    for (int a = 0; a < 2; ++a)
#pragma unroll
        for (int b = 0; b < 2; ++b)
#pragma unroll
            for (int m = 0; m < 4; ++m)
#pragma unroll
                for (int n = 0; n < 2; ++n) acc[a][b][m][n] = (f32x4){0.f, 0.f, 0.f, 0.f};
    bf16x8 At[4][2], B0[2][2], B1[2][2];
    const char* cA = (const char*)g.A + (size_t)cur.pm * tstep; const char* cB = (const char*)g.Bt + (size_t)cur.pn * tstep;
    S.a_ready(cur);
    float pre[8];
    if constexpr (has_preload<Epi>::value) E.preload(cur, wr, fr, pre);
    if constexpr (SP2) {
        PG8_STAGE(PG8_SB(0, 0), cB, voffB); PG8_STAGE(PG8_SB(0, 1), cB + hstep, voffB); PG8_STAGE(PG8_SA(0, 0), cA, voffA); PG8_STAGE(PG8_SA(0, 1), cA + hstep, voffA);
        if (wr == 1) PG8_BAR;
        PG8_WAIT_V(2); PG8_BAR;
        PG8_STAGE(PG8_SB(1, 0), cB + kstep, voffB); PG8_STAGE(PG8_SA(1, 0), cA + kstep, voffA); PG8_STAGE(PG8_SB(1, 1), cB + hstep + kstep, voffB);
        PG8_WAIT_V(6); PG8_BAR;
    } else {
        PG8_STAGE(PG8_SB(0, 0), cB, voffB); PG8_STAGE(PG8_SA(0, 0), cA, voffA); PG8_STAGE(PG8_SB(0, 1), cB + hstep, voffB); PG8_STAGE(PG8_SA(0, 1), cA + hstep, voffA);
        if (wr == 1) PG8_BAR;
        PG8_WAIT_V(4); PG8_BAR;
        PG8_STAGE(PG8_SB(1, 0), cB + kstep, voffB); PG8_STAGE(PG8_SA(1, 0), cA + kstep, voffA); PG8_STAGE(PG8_SB(1, 1), cB + hstep + kstep, voffB);
        PG8_WAIT_V(6); PG8_BAR;
    }
    for (;;) {
        const bool has_next = S.next(ui + 1, nxt);
        const char* nA = has_next ? (const char*)g.A + (size_t)nxt.pm * tstep : cA; const char* nB = has_next ? (const char*)g.Bt + (size_t)nxt.pn * tstep : cB;
        for (int t = 0; t < nt; t += 2) {
            const bool last = (t == nt - 2);
            const char* a1 = cA + (size_t)(t + 1) * kstep;
            const char* a2 = last ? nA : cA + (size_t)(t + 2) * kstep; const char* b2 = last ? nB : cB + (size_t)(t + 2) * kstep;
            const char* a3 = a2 + kstep; const char* b3 = b2 + kstep;
            if (last && has_next) S.a_ready(nxt);
            if constexpr (SP2) {
            PG8_LDB(B0, 0, 0); PG8_LDB(B1, 0, 1); PG8_SCHED; PG8_LDA(At, 0, 0); PG8_STAGE(PG8_SA(1, 1), a1 + hstep, voffA);
            PG8_WAIT_V(8); PG8_WAIT_L(0); PG8_BAR; PG8_MMA(0, 0, At, B0); PG8_MMA(0, 1, At, B1); PG8_BAR; PG8_SCHED;
            PG8_LDA(At, 0, 1); PG8_STAGE(PG8_SB(0, 0), b2, voffB); PG8_STAGE(PG8_SB(0, 1), b2 + hstep, voffB); PG8_STAGE(PG8_SA(0, 0), a2, voffA);
            PG8_WAIT_V(8); PG8_WAIT_L(0); PG8_BAR; PG8_MMA(1, 0, At, B0); PG8_MMA(1, 1, At, B1); PG8_BAR; PG8_SCHED;
            PG8_LDB(B0, 1, 0); PG8_LDB(B1, 1, 1); PG8_SCHED; PG8_LDA(At, 1, 0); PG8_STAGE(PG8_SA(0, 1), a2 + hstep, voffA);
            PG8_WAIT_V(8); PG8_WAIT_L(0); PG8_BAR; PG8_MMA(0, 0, At, B0); PG8_MMA(0, 1, At, B1); PG8_BAR; PG8_SCHED;
            PG8_LDA(At, 1, 1); PG8_STAGE(PG8_SB(1, 0), b3, voffB); PG8_STAGE(PG8_SB(1, 1), b3 + hstep, voffB); PG8_STAGE(PG8_SA(1, 0), a3, voffA);
            PG8_WAIT_V(8); PG8_WAIT_L(0); PG8_BAR; PG8_MMA(1, 0, At, B0); PG8_MMA(1, 1, At, B1); PG8_BAR; PG8_SCHED;
            } else {
            PG8_LDB(B0, 0, 0); PG8_SCHED; PG8_LDA(At, 0, 0); PG8_STAGE(PG8_SA(1, 1), a1 + hstep, voffA);
            PG8_WAIT_L(8); PG8_BAR; PG8_WAIT_L(0); PG8_MMA(0, 0, At, B0); PG8_BAR; PG8_SCHED;
            PG8_LDB(B1, 0, 1); PG8_STAGE(PG8_SB(0, 0), b2, voffB);
            PG8_BAR; PG8_WAIT_L(0); PG8_MMA(0, 1, At, B1); PG8_BAR;
            PG8_LDA(At, 0, 1); PG8_STAGE(PG8_SA(0, 0), a2, voffA);
            PG8_BAR; PG8_WAIT_L(0); PG8_MMA(1, 0, At, B0); PG8_BAR; PG8_SCHED;
            PG8_STAGE(PG8_SB(0, 1), b2 + hstep, voffB);
            PG8_WAIT_V(6); PG8_BAR; PG8_MMA(1, 1, At, B1); PG8_BAR;
            PG8_LDB(B0, 1, 0); PG8_SCHED; PG8_LDA(At, 1, 0); PG8_STAGE(PG8_SA(0, 1), a2 + hstep, voffA);
            PG8_WAIT_L(8); PG8_BAR; PG8_WAIT_L(0); PG8_MMA(0, 0, At, B0); PG8_BAR; PG8_SCHED;
            PG8_LDB(B1, 1, 1); PG8_STAGE(PG8_SB(1, 0), b3, voffB);
            PG8_BAR; PG8_WAIT_L(0); PG8_MMA(0, 1, At, B1); PG8_BAR;
            PG8_LDA(At, 1, 1); PG8_STAGE(PG8_SA(1, 0), a3, voffA);
            PG8_BAR; PG8_WAIT_L(0); PG8_MMA(1, 0, At, B0); PG8_BAR; PG8_SCHED;
            PG8_STAGE(PG8_SB(1, 1), b3 + hstep, voffB);
            PG8_WAIT_V(6); PG8_BAR; PG8_MMA(1, 1, At, B1); PG8_BAR;
            }
        }
        if constexpr (ALIGN_EPI) { if (wr == 0) PG8_BAR; }
        if constexpr (!Epi::AFTER_DRAIN) { if constexpr (has_preload<Epi>::value) E(acc, cur, wr, wc, fr, fq, pre); else E(acc, cur, wr, wc, fr, fq); S.done(cur); }
        if (!has_next) break;
#pragma unroll
        for (int a = 0; a < 2; ++a)
#pragma unroll
            for (int b = 0; b < 2; ++b)
#pragma unroll
                for (int m = 0; m < 4; ++m)
#pragma unroll
                    for (int n = 0; n < 2; ++n) acc[a][b][m][n] = (f32x4){0.f, 0.f, 0.f, 0.f};
        cur = nxt; cA = nA; cB = nB; ++ui;
        if constexpr (has_preload<Epi>::value) E.preload(cur, wr, fr, pre);
        if constexpr (ALIGN_EPI) { if (wr == 1) PG8_BAR; }
    }
    PG8_WAIT_V(0);
    if constexpr (!ALIGN_EPI) { if (wr == 0) PG8_BAR; }
    PG8_BAR;
    if constexpr (Epi::AFTER_DRAIN) { E.fused(acc, cur, wr, wc, fr, fq, lds, wid, lane); S.done(cur); }
#undef PG8_SA
#undef PG8_SB
#undef PG8_STAGE
#undef PG8_LDA
#undef PG8_LDB
#undef PG8_MMA
#undef PG8_WAIT_V
#undef PG8_WAIT_L
#undef PG8_BAR
#undef PG8_SCHED
}
}
namespace att {
#define ALAS __attribute__((address_space(3)))
typedef unsigned short bf16;
typedef short bf16x8 __attribute__((ext_vector_type(8)));
typedef short s16x4 __attribute__((ext_vector_type(4)));
typedef float f32x16 __attribute__((ext_vector_type(16)));
typedef float f32x4 __attribute__((ext_vector_type(4)));
typedef unsigned u32x4 __attribute__((ext_vector_type(4)));
typedef unsigned u32x2 __attribute__((ext_vector_type(2)));
typedef float f32x2_t __attribute__((ext_vector_type(2))); typedef __bf16 bf16x2_t __attribute__((ext_vector_type(2)));
constexpr int SEQ = 2048, NB = 4, NH = 8, HD = 128, ROWP = 1024;
constexpr int OFF_K = 0, OFF_V = 32768, OFF_NEGF = 65536, OFF_BIAS = 65536 + 8192, OFF_MISC = OFF_BIAS + 2304;
constexpr float LOG2E = 1.4426950408889634f;
__device__ __forceinline__ unsigned off_b(unsigned row, unsigned ch) { return 256u * row + 16u * (ch ^ (((row & 3u) << 2) | ((row >> 2) & 3u))); }
__device__ __forceinline__ unsigned cvtpk_s(float lo, float hi) { f32x2_t v = {lo, hi}; bf16x2_t b = __builtin_convertvector(v, bf16x2_t); return __builtin_bit_cast(unsigned, b); }
__device__ __forceinline__ float fadd_s(float x, float y) { float r = x + y; asm("" : "+v"(r)); return r; }
__device__ __forceinline__ float fsub_s(float x, float y) { float r = x - y; asm("" : "+v"(r)); return r; }
__device__ __forceinline__ float fmul_s(float x, float y) { float r = x * y; asm("" : "+v"(r)); return r; }
__device__ __forceinline__ s16x4 vtr(ALAS const unsigned char* p) { return __builtin_bit_cast(s16x4, __builtin_amdgcn_ds_read_tr16_b64_v4i16((ALAS s16x4*)p)); }

struct TileRegs { u32x4 k[2], v[2]; };
__device__ __forceinline__ void tile_gload(TileRegs& R, const bf16* Kg, const bf16* Vg, int tok0, int tid) {
#pragma unroll
    for (int i = 0; i < 2; ++i) { const int id = tid + 512 * i, row = id >> 4, ch = id & 15; const size_t o = (size_t)(tok0 + row) * ROWP + ch * 8;
        R.k[i] = *(const u32x4*)(Kg + o); R.v[i] = *(const u32x4*)(Vg + o); }
}
__device__ __forceinline__ void tile_lstore(const TileRegs& R, ALAS unsigned char* kbuf, ALAS unsigned char* vbuf, int tid) {
#pragma unroll
    for (int i = 0; i < 2; ++i) { const int id = tid + 512 * i, row = id >> 4, ch = id & 15; const unsigned o = off_b(row, ch);
        *(ALAS u32x4*)(kbuf + o) = R.k[i]; *(ALAS u32x4*)(vbuf + o) = R.v[i]; }
}

template <int MODE>
__device__ __forceinline__ void tile_compute(f32x16 (&o)[4], float& m_run, float& l_run, const bf16x8 (&qf)[8], ALAS const unsigned char* lds, ALAS const unsigned char* kbuf, ALAS const unsigned char* vbuf,
                                             int lane, int rel0  , bool cst  , int key0  , bool diag, int tloc  ) {
    const int r = lane & 31, h = lane >> 5;
    const int kap = (r & 0x13) | ((r & 4) << 1) | ((r & 8) >> 1);
    f32x16 s[2];
    if (MODE == 1) {
        ALAS const float* nf = (ALAS const float*)(lds + OFF_NEGF) + key0;
#pragma unroll
        for (int kb = 0; kb < 2; ++kb)
#pragma unroll
            for (int g = 0; g < 4; ++g) { const f32x4 f = *(ALAS const f32x4*)(nf + 32 * kb + 4 * (g & 1) + 16 * (g >> 1));
#pragma unroll
                for (int e = 0; e < 4; ++e) s[kb][4 * g + e] = f[e]; }
    } else {
        const float c = cst ? ((ALAS const float*)(lds + OFF_BIAS))[512] : 0.f;
#pragma unroll
        for (int i = 0; i < 16; ++i) { s[0][i] = c; s[1][i] = c; }
    }
#pragma unroll
    for (int ks = 0; ks < 8; ++ks) {
        const bf16x8 k0 = *(ALAS const bf16x8*)(kbuf + off_b(kap, 2 * ks + h));
        const bf16x8 k1 = *(ALAS const bf16x8*)(kbuf + 8192 + off_b(kap, 2 * ks + h));
        s[0] = __builtin_amdgcn_mfma_f32_32x32x16_bf16(k0, qf[ks], s[0], 0, 0, 0);
        s[1] = __builtin_amdgcn_mfma_f32_32x32x16_bf16(k1, qf[ks], s[1], 0, 0, 0);
    }
    if (MODE == 0) {
        if (!cst) { ALAS const float* bt = (ALAS const float*)(lds + OFF_BIAS);
#pragma unroll
            for (int kb = 0; kb < 2; ++kb)
#pragma unroll
                for (int i = 0; i < 16; ++i) { int rel = rel0 - 32 * kb - (i & 7) - 16 * (i >> 3); rel = rel < 256 ? rel : 256; rel = rel > -256 ? rel : -256; s[kb][i] = fadd_s(s[kb][i], bt[rel + 256]); }
        }
    } else if (diag) {
#pragma unroll
        for (int kb = 0; kb < 2; ++kb)
#pragma unroll
            for (int i = 0; i < 16; ++i) if (32 * kb + (i & 7) + 16 * (i >> 3) > tloc) s[kb][i] = -INFINITY;
    }
    float mx = s[0][0];
#pragma unroll
    for (int i = 1; i < 16; ++i) mx = fmaxf(mx, s[0][i]);
#pragma unroll
    for (int i = 0; i < 16; ++i) mx = fmaxf(mx, s[1][i]);
    { auto rr = __builtin_amdgcn_permlane32_swap(__float_as_uint(mx), __float_as_uint(mx), false, false); mx = fmaxf(__uint_as_float(rr[0]), __uint_as_float(rr[1])); }
    constexpr float RESC_THR = 10.0f;
    if (__builtin_amdgcn_ballot_w64(mx > m_run + RESC_THR) != 0ull) {
        const float m_new = fmaxf(m_run, mx), alpha = __builtin_amdgcn_exp2f(m_run - m_new);
        m_run = m_new; l_run *= alpha;
#pragma unroll
        for (int c = 0; c < 4; ++c)
#pragma unroll
            for (int i = 0; i < 16; ++i) o[c][i] = fmul_s(o[c][i], alpha);
    }
    float ps = 0.f;
#pragma unroll
    for (int kb = 0; kb < 2; ++kb)
#pragma unroll
        for (int i = 0; i < 16; ++i) { const float p = __builtin_amdgcn_exp2f(fsub_s(s[kb][i], m_run)); s[kb][i] = p; ps = fadd_s(ps, p); }
    l_run += ps;
    bf16x8 pf[4];
#pragma unroll
    for (int ks = 0; ks < 4; ++ks) { const int kb = ks >> 1, b8 = 8 * (ks & 1); u32x4 w;
        w.x = cvtpk_s(s[kb][b8 + 0], s[kb][b8 + 1]); w.y = cvtpk_s(s[kb][b8 + 2], s[kb][b8 + 3]); w.z = cvtpk_s(s[kb][b8 + 4], s[kb][b8 + 5]); w.w = cvtpk_s(s[kb][b8 + 6], s[kb][b8 + 7]);
        pf[ks] = __builtin_bit_cast(bf16x8, w); }
    const unsigned blk = (lane >> 4) & 1, q4 = (lane & 15) >> 2, p4 = lane & 3;
#pragma unroll
    for (int c = 0; c < 4; ++c)
#pragma unroll
        for (int ks = 0; ks < 4; ++ks) {
            ALAS const unsigned char* a0 = vbuf + off_b(16 * ks + 8 * h + q4, 4 * c + 2 * blk + (p4 >> 1)) + 8 * (p4 & 1);
            ALAS const unsigned char* a1 = vbuf + off_b(16 * ks + 8 * h + 4 + q4, 4 * c + 2 * blk + (p4 >> 1)) + 8 * (p4 & 1);
            const s16x4 lo = vtr(a0), hi = vtr(a1);
            const bf16x8 vf = (bf16x8){lo[0], lo[1], lo[2], lo[3], hi[0], hi[1], hi[2], hi[3]};
            o[c] = __builtin_amdgcn_mfma_f32_32x32x16_bf16(vf, pf[ks], o[c], 0, 0, 0);
        }
}

struct Tensors { const bf16* q; const bf16* k; const bf16* v; bf16* o; const float* lf; const float* rel_bias; };

template <int MODE>
__device__ __forceinline__ void attn_item(ALAS unsigned char* lds, const Tensors& T, int b, int hd, int blk) {
    int tid_l = threadIdx.x; asm volatile("" : "+v"(tid_l));
    const int tid = tid_l, lane = tid & 63, w = __builtin_amdgcn_readfirstlane(tid >> 6), r = lane & 31, h = lane >> 5;
    if (MODE == 0) {
        ALAS float* bt = (ALAS float*)(lds + OFF_BIAS);
        for (int i = tid; i < 513; i += 512) bt[i] = T.rel_bias[hd * 513 + i] * LOG2E;
    } else {
        ALAS float* negF = (ALAS float*)(lds + OFF_NEGF); ALAS float* wsum = (ALAS float*)(lds + OFF_MISC + 64);
        float v[4];
#pragma unroll
        for (int e = 0; e < 4; ++e) v[e] = T.lf[((size_t)(b * SEQ + 4 * tid + e)) * 8 + hd];
        v[1] += v[0]; v[2] += v[1]; v[3] += v[2];
        const float tot = v[3]; float x = tot;
#pragma unroll
        for (int o_ = 1; o_ < 64; o_ <<= 1) { const float y = __shfl_up(x, o_); if (lane >= o_) x += y; }
        if (lane == 63) wsum[w] = x;
        __syncthreads();
        float offs = x - tot;
        for (int j = 0; j < w; ++j) offs += wsum[j];
#pragma unroll
        for (int e = 0; e < 4; ++e) negF[4 * tid + e] = -(v[e] + offs) * LOG2E;
    }
    const int qt = 4 * blk + (w >> 1);
    const int t_lo = (MODE == 0) ? (4 * blk - 8 > 0 ? 4 * blk - 8 : 0) : 0, t_hi = 4 * blk + 3;
    const int w_lo = (MODE == 0) ? qt - 8 : 0, w_hi = qt;
    const int tokq = b * SEQ + 64 * qt + 32 * (w & 1) + r;
    bf16x8 qf[8];
#pragma unroll
    for (int ks = 0; ks < 8; ++ks) qf[ks] = *(const bf16x8*)(T.q + (size_t)tokq * ROWP + hd * HD + 16 * ks + 8 * h);
    f32x16 o[4];
#pragma unroll
    for (int c = 0; c < 4; ++c)
#pragma unroll
        for (int i = 0; i < 16; ++i) o[c][i] = 0.f;
    float m_run = -1e30f, l_run = 0.f;
    const bf16* Kg = T.k + hd * HD; const bf16* Vg = T.v + hd * HD;
    TileRegs R;
    tile_gload(R, Kg, Vg, b * SEQ + 64 * t_lo, tid);
    tile_lstore(R, lds + OFF_K, lds + OFF_V, tid);
    __syncthreads();
    int cur = 0;
    for (int t = t_lo; t <= t_hi; ++t) {
        const bool more = t < t_hi;
        if (more) tile_gload(R, Kg, Vg, b * SEQ + 64 * (t + 1), tid);
        if (t >= w_lo && t <= w_hi) {
            const int tq = 64 * qt + 32 * (w & 1) + r;
            tile_compute<MODE>(o, m_run, l_run, qf, lds, lds + OFF_K + cur * 16384, lds + OFF_V + cur * 16384, lane,
                               tq - 64 * t - 8 * h, (qt - t) >= 5, 64 * t + 8 * h, t == qt, tq - 64 * t - 8 * h);
        }
        if (more) tile_lstore(R, lds + OFF_K + (cur ^ 1) * 16384, lds + OFF_V + (cur ^ 1) * 16384, tid);
        __syncthreads();
        cur ^= 1;
    }
    float l_tot = l_run; { auto rr = __builtin_amdgcn_permlane32_swap(__float_as_uint(l_run), __float_as_uint(l_run), false, false); l_tot = __uint_as_float(rr[0]) + __uint_as_float(rr[1]); }
    const float inv = 1.0f / l_tot;
    ALAS unsigned char* stg = lds + w * 8704;
#pragma unroll
    for (int c = 0; c < 4; ++c)
#pragma unroll
        for (int g = 0; g < 4; ++g) { u32x2 wv; wv.x = cvtpk_s(o[c][4 * g] * inv, o[c][4 * g + 1] * inv); wv.y = cvtpk_s(o[c][4 * g + 2] * inv, o[c][4 * g + 3] * inv);
            *(ALAS u32x2*)(stg + r * 272 + (32 * c + 8 * g + 4 * h) * 2) = wv; }
    asm volatile("s_waitcnt lgkmcnt(0)" ::: "memory");
    const int tok0 = b * SEQ + 64 * qt + 32 * (w & 1);
#pragma unroll
    for (int j = 0; j < 8; ++j) { const int row = (lane >> 4) + 4 * j, ch = lane & 15;
        const u32x4 v = *(ALAS const u32x4*)(stg + row * 272 + ch * 16);
        *(u32x4*)(T.o + (size_t)(tok0 + row) * 2048 + hd * HD + ch * 8) = v; }
}
}
typedef unsigned short bf16;
typedef float f32x4 __attribute__((ext_vector_type(4)));
typedef unsigned v4u __attribute__((ext_vector_type(4)));
typedef unsigned v2u __attribute__((ext_vector_type(2)));
constexpr int NWAVES = 8, NTHR = 512;
constexpr int M = 8192, D = 2048, FF = 5632, NGU = 2 * FF, DIN = 6152, NQKV = 6144, DPLE = 256, SEQ = 2048, NHB = 8;
constexpr size_t MiB = 1u << 20;
constexpr size_t WS_CTL = 0;
constexpr size_t CTL_CNT = 0;
constexpr size_t CTL_SS = 4096;
constexpr size_t CTL_LF = CTL_SS + 5 * (size_t)M * 4;
constexpr size_t CTL_WF = CTL_LF + (size_t)M * 8 * 4;
static_assert(CTL_WF + 8 * (size_t)D * 4 <= MiB, "control region");
constexpr size_t WS_WGU1 = 1 * MiB, WS_WD1 = WS_WGU1 + 44 * MiB, WS_WIN = WS_WD1 + 22 * MiB, WS_WOUT = WS_WIN + 24 * MiB, WS_WGU2 = WS_WOUT + 8 * MiB,
                 WS_WD2 = WS_WGU2 + 44 * MiB, WS_WG = WS_WD2 + 22 * MiB, WS_WP = WS_WG + 8 * MiB, WS_PB = WS_WP + 1 * MiB  , WS_AB = WS_PB + 4 * MiB  ,
                 WS_R1 = WS_AB + 32 * MiB  , WS_H = WS_R1 + 128 * MiB  , WS_END = WS_H + 64 * MiB;
constexpr size_t QKV_T = (size_t)M * 1024;
constexpr int LDS_BYTES = 147456;

__device__ __forceinline__ unsigned f2bf(float f) { unsigned u = __builtin_bit_cast(unsigned, f); return (u + 0x7fffu + ((u >> 16) & 1u)) >> 16; }
__device__ __forceinline__ unsigned pk2(float lo, float hi) { typedef float f2_t __attribute__((ext_vector_type(2))); typedef __bf16 b2_t __attribute__((ext_vector_type(2))); f2_t v = {lo, hi}; b2_t b = __builtin_convertvector(v, b2_t); return __builtin_bit_cast(unsigned, b); }
__device__ __forceinline__ float wave_sum(float v) {
#pragma unroll
    for (int o = 1; o < 64; o <<= 1) v += __shfl_xor(v, o);
    return v;
}
struct ConvRegs { f32x4 v[16]; };
constexpr int LDS_G = 8 * 16896;
__device__ __forceinline__ void conv_load(ConvRegs& R, const float* __restrict__ W, int ldw, int k0, int n0, int lane) {
#pragma unroll
    for (int it = 0; it < 8; ++it) { const int kk = 8 * it + (lane >> 3); const float* src = W + (size_t)(k0 + kk) * ldw + n0 + 4 * (lane & 7);
        R.v[it] = __builtin_nontemporal_load((const f32x4*)src); R.v[8 + it] = __builtin_nontemporal_load((const f32x4*)(src + 32)); }
}
template <bool HAS_G, bool TILED> __device__ __forceinline__ void conv_store(const ConvRegs& R, const LAS float* gl, bf16* WT, int K, int k0, int drowA, int drowB, LAS float* scr, int lane) {
#pragma unroll
    for (int it = 0; it < 8; ++it) { const int kk = 8 * it + (lane >> 3); const float gg = HAS_G ? gl[k0 + kk] : 1.0f; LAS float* s = scr + kk * 33 + 4 * (lane & 7);
        s[0] = R.v[it][0] * gg; s[1] = R.v[it][1] * gg; s[2] = R.v[it][2] * gg; s[3] = R.v[it][3] * gg;
        s[2112 + 0] = R.v[8 + it][0] * gg; s[2112 + 1] = R.v[8 + it][1] * gg; s[2112 + 2] = R.v[8 + it][2] * gg; s[2112 + 3] = R.v[8 + it][3] * gg; }
    asm volatile("s_waitcnt lgkmcnt(0)" ::: "memory");
    const int c = lane & 7;
#pragma unroll
    for (int hf = 0; hf < 2; ++hf)
#pragma unroll
        for (int j = 0; j < 4; ++j) { const int n = (lane >> 3) + 8 * j; const LAS float* s = scr + hf * 2112 + (8 * c) * 33 + n;
            v4u o; o.x = pk2(s[0 * 33], s[1 * 33]); o.y = pk2(s[2 * 33], s[3 * 33]); o.z = pk2(s[4 * 33], s[5 * 33]); o.w = pk2(s[6 * 33], s[7 * 33]);
            const int row = (hf ? drowB : drowA) + n;
            if (TILED) *(v4u*)(WT + ((size_t)(row >> 8) * (K >> 6) + (k0 >> 6)) * 16384 + (size_t)(row & 255) * 64 + 8 * c) = o;
            else *(v4u*)(WT + (size_t)row * K + k0 + 8 * c) = o; }
    asm volatile("s_waitcnt lgkmcnt(0)" ::: "memory");
}
__device__ __forceinline__ int gu_row(int n0) { const int hi = n0 >= FF, n = n0 - (hi ? FF : 0); return 256 * (n >> 7) + (n & 127) + 128 * hi; }
template <bool HAS_G, bool gu, bool PIPE, bool TILED = false> __device__ __forceinline__ void conv_matrix(const float* W, int ldw, const float* g, bf16* WT, int K, int ncols, int wv, int nwv, LAS float* scr, int lane, LAS unsigned char* lds) {
    const LAS float* gl = (const LAS float*)(lds + LDS_G);
    if (HAS_G) { __syncthreads(); for (int i = threadIdx.x; i < K; i += NTHR) ((LAS float*)(lds + LDS_G))[i] = g[i]; __syncthreads(); }
    const int nb = ncols / 64, total = (K / 64) * nb, last = total - 1;
    ConvRegs RA, RB;
    int it = wv;
    if (!PIPE) {
        if (it < total) conv_load(RA, W, ldw, 64 * (it / nb), 64 * (it % nb), lane);
        while (it < total) {
            const int itB = it + nwv, itA2 = itB + nwv;
            if (itB < total) conv_load(RB, W, ldw, 64 * (itB / nb), 64 * (itB % nb), lane);
            { const int n0 = 64 * (it % nb); conv_store<HAS_G, TILED>(RA, gl, WT, K, 64 * (it / nb), gu ? gu_row(n0) : n0, gu ? gu_row(n0 + 32) : n0 + 32, scr, lane); }
            if (itA2 < total) conv_load(RA, W, ldw, 64 * (itA2 / nb), 64 * (itA2 % nb), lane);
            if (itB < total) { const int n0 = 64 * (itB % nb); conv_store<HAS_G, TILED>(RB, gl, WT, K, 64 * (itB / nb), gu ? gu_row(n0) : n0, gu ? gu_row(n0 + 32) : n0 + 32, scr, lane); }
            it = itA2;
        }
        return;
    }
    if (it >= total) return;
    conv_load(RA, W, ldw, 64 * (it / nb), 64 * (it % nb), lane);
    while (it < total) {
        const int itB = (it + nwv < last) ? it + nwv : last, itA2 = (it + 2 * nwv < last) ? it + 2 * nwv : last;
        conv_load(RB, W, ldw, 64 * (itB / nb), 64 * (itB % nb), lane);
        { const int n0 = 64 * (it % nb); conv_store<HAS_G, TILED>(RA, gl, WT, K, 64 * (it / nb), gu ? gu_row(n0) : n0, gu ? gu_row(n0 + 32) : n0 + 32, scr, lane); }
        conv_load(RA, W, ldw, 64 * (itA2 / nb), 64 * (itA2 % nb), lane);
        { const int n0 = 64 * (itB % nb); conv_store<HAS_G, TILED>(RB, gl, WT, K, 64 * (itB / nb), gu ? gu_row(n0) : n0, gu ? gu_row(n0 + 32) : n0 + 32, scr, lane); }
        it += 2 * nwv;
    }
}


constexpr size_t CTL_BAR = 512 * 1024;
static_assert(CTL_WF + 8 * (size_t)D * 4 <= CTL_BAR && CTL_BAR + XCD_BAR_WORDS * 4 <= MiB, "control region");
constexpr size_t CTL_PCNT = CTL_BAR + 16384;
static_assert(CTL_PCNT + 32 * 256 <= MiB, "control region");
constexpr int LDS_XB = LDS_BYTES - 64;
#ifndef USE_TILED
#define USE_TILED false
#endif
#ifndef PHMASK
#define PHMASK 0x3ff
#endif
#define PH_ON(k) (((PHMASK) >> (k)) & 1)
struct Args { const float* in[17]; float* out; unsigned char* ws; };
typedef const __attribute__((address_space(4))) unsigned char* kargp_t;
__device__ __forceinline__ unsigned long long karg64(int i) { kargp_t p = (kargp_t)__builtin_amdgcn_kernarg_segment_ptr(); asm volatile("" : "+s"(p)); return *(const __attribute__((address_space(4))) unsigned long long*)(p + 8 * i); }
#define GAS1 __attribute__((address_space(1)))
#define ARG_IN(i) ((const float*)(const GAS1 float*)karg64(i))
#define ARG_OUT ((float*)(GAS1 float*)karg64(17))
#define ARG_WS ((unsigned char*)(GAS1 unsigned char*)karg64(18))

__global__ void __launch_bounds__(NTHR, 2) fwd_kernel(Args a) {
    extern __shared__ __attribute__((aligned(16))) unsigned char lds_raw[];
    LAS unsigned char* lds = (LAS unsigned char*)lds_raw;
    cg::grid_group grid = cg::this_grid();
    const int G = gridDim.x, bx = blockIdx.x, NGW = G * NWAVES;
    const int G1 = (G == 256) ? 235 : G - (G / 12 > 0 ? G / 12 : 1);
    if (threadIdx.x == 0) { ((volatile LAS unsigned*)(lds + LDS_XB))[0] = 0u; ((volatile LAS unsigned*)(lds + LDS_XB))[1] = 0u; }
    const XcdBarrier xbar = xcd_barrier_post((unsigned*)(ARG_WS + CTL_BAR), (volatile LAS unsigned*)(lds + LDS_XB));
#define TID_DECL int tid_l = threadIdx.x; asm volatile("" : "+v"(tid_l)); const int tid = tid_l, lane = tid & 63, wave = __builtin_amdgcn_readfirstlane(tid >> 6), gw = bx * NWAVES + wave; (void)lane; (void)gw;
#define P_SS(i) ((float*)(ws + CTL_SS) + (size_t)(i) * M)
#define P_LF ((float*)(ws + CTL_LF))
#define P_WF ((float*)(ws + CTL_WF))
#define P_CNT ((unsigned*)(ws + CTL_CNT))
#define P_BF(off) ((bf16*)(ws + (off)))
#define P_ACT P_BF(WS_R1)
#define P_QKV P_BF(WS_R1)
#define P_OB P_BF(WS_R1 + 96 * MiB)
#define P_AB P_BF(WS_AB)
#define P_H ((float*)(ws + WS_H))

    {
    if constexpr (PH_ON(0)) {
        unsigned char* const ws = ARG_WS;
        TID_DECL
        LAS float* scr = (LAS float*)(lds + wave * 16896);
        conv_matrix<true, true, false>(ARG_IN(3), NGU, ARG_IN(2), P_BF(WS_WGU1), D, NGU, gw, NGW, scr, lane, lds);
        for (int m = gw; m < M; m += 2 * NGW) {
            const int m2 = (m + NGW < M) ? m + NGW : m;
            const f32x4* xa = (const f32x4*)(ARG_IN(0) + (size_t)m * D) + lane; const f32x4* xb_ = (const f32x4*)(ARG_IN(0) + (size_t)m2 * D) + lane; f32x4 va[8], vb[8];
#pragma unroll
            for (int j = 0; j < 8; ++j) va[j] = __builtin_nontemporal_load(xa + 64 * j);
#pragma unroll
            for (int j = 0; j < 8; ++j) vb[j] = __builtin_nontemporal_load(xb_ + 64 * j);
            float sa = 0.f, sb = 0.f;
#pragma unroll
            for (int j = 0; j < 8; ++j) { sa += (va[j][0] * va[j][0] + va[j][1] * va[j][1]) + (va[j][2] * va[j][2] + va[j][3] * va[j][3]); sb += (vb[j][0] * vb[j][0] + vb[j][1] * vb[j][1]) + (vb[j][2] * vb[j][2] + vb[j][3] * vb[j][3]); }
            sa = wave_sum(sa); sb = wave_sum(sb); if (lane == 0) { P_SS(0)[m] = sa; P_SS(0)[m2] = sb; }
            v2u* oa = (v2u*)(P_AB + (size_t)m * D) + lane; v2u* ob_ = (v2u*)(P_AB + (size_t)m2 * D) + lane;
#pragma unroll
            for (int j = 0; j < 8; ++j) { v2u o; o.x = pk2(va[j][0], va[j][1]); o.y = pk2(va[j][2], va[j][3]); oa[64 * j] = o; }
#pragma unroll
            for (int j = 0; j < 8; ++j) { v2u o; o.x = pk2(vb[j][0], vb[j][1]); o.y = pk2(vb[j][2], vb[j][3]); ob_[64 * j] = o; }
        }
        for (int i = bx * NTHR + tid; i < M * DPLE / 4; i += G * NTHR) { const f32x4 v = ((const f32x4*)ARG_IN(1))[i]; v2u o; o.x = pk2(v[0], v[1]); o.y = pk2(v[2], v[3]); ((v2u*)P_BF(WS_PB))[i] = o; }
        for (int i = bx * NTHR + tid; i < 4 * M; i += G * NTHR) P_SS(1)[i] = 0.f;
        if (bx == 0 && tid == 0) { P_CNT[0] = 0u; P_CNT[64] = 0u; }
        if (bx == 1) for (int i = tid; i < 32 * 64; i += NTHR) ((unsigned*)(ws + CTL_PCNT))[i] = 0u;
        for (int i = bx * NTHR + tid; i < 8 * D; i += G * NTHR) { const int j = i / D, k = i % D; P_WF[i] = ARG_IN(5)[k] * ARG_IN(6)[(size_t)k * DIN + NQKV + j]; }
    }
    }
    if (ARG_WS == nullptr) grid.sync();
    xcd_barrier(xbar);

    {
    if constexpr (PH_ON(1)) {
        unsigned char* const ws = ARG_WS;
        if (bx < G1) { pg8::Gemm g{P_AB, P_BF(WS_WGU1), M, NGU, D}; pg8::StaticOrder S; S.init(M, NGU, G1, bx);
          pg8::EpiSwiglu E{P_ACT, P_SS(0)};
          pg8::gemm_phase<pg8::EpiSwiglu, pg8::StaticOrder, true, true>(lds, g, S, E); }
        else {
            TID_DECL
            LAS float* scr = (LAS float*)(lds + wave * 16896); const int wv = (bx - G1) * NWAVES + wave, nwv = (G - G1) * NWAVES;
            conv_matrix<false, false, true, USE_TILED>(ARG_IN(4), D, nullptr, P_BF(WS_WD1), FF, D, wv, nwv, scr, lane, lds);
            conv_matrix<false, false, true>(ARG_IN(15), D, nullptr, P_BF(WS_WP), DPLE, D, wv, nwv, scr, lane, lds);
            conv_matrix<true, false, true>(ARG_IN(6), DIN, ARG_IN(5), P_BF(WS_WIN), D, NQKV, wv, nwv, scr, lane, lds);
            conv_matrix<false, false, true>(ARG_IN(9), D, nullptr, P_BF(WS_WOUT), D, D, wv, nwv, scr, lane, lds);
        }
    }
    }
    xcd_barrier(xbar);
    if constexpr (PH_ON(2)) {
        unsigned char* const ws = ARG_WS;
        pg8::Gemm g{P_ACT, P_BF(WS_WD1), M, D, FF}; pg8::StaticOrder S; S.init(M, D, G, bx);
        pg8::EpiResid<true> E{nullptr, P_AB, P_SS(1), 0.5f, xbar};
        pg8::gemm_phase<pg8::EpiResid<true>, pg8::StaticOrder, false, true, USE_TILED>(lds, g, S, E);
    }
    {
    if constexpr (PH_ON(3)) {
        unsigned char* const ws = ARG_WS;
        TID_DECL
        pg8::Gemm g{P_AB, P_BF(WS_WIN), M, NQKV, D}; pg8::StaticOrder S; S.init(M, NQKV, G, bx);
        pg8::EpiQKV E{P_QKV, P_SS(1), 0.08838834764831845f * 1.4426950408889634f, QKV_T};
        pg8::gemm_phase<pg8::EpiQKV, pg8::StaticOrder, true, true>(lds, g, S, E);
        for (int m = gw; m < M; m += 2 * NGW) {
            const int m2 = (m + NGW < M) ? m + NGW : m;
            const v2u* hra = (const v2u*)(P_AB + (size_t)m * D) + lane; const v2u* hrb = (const v2u*)(P_AB + (size_t)m2 * D) + lane; f32x4 va[8], vb[8];
#pragma unroll
            for (int j = 0; j < 8; ++j) { const v2u w = hra[64 * j]; va[j] = (f32x4){__uint_as_float(w.x << 16), __uint_as_float(w.x & 0xffff0000u), __uint_as_float(w.y << 16), __uint_as_float(w.y & 0xffff0000u)}; }
#pragma unroll
            for (int j = 0; j < 8; ++j) { const v2u w = hrb[64 * j]; vb[j] = (f32x4){__uint_as_float(w.x << 16), __uint_as_float(w.x & 0xffff0000u), __uint_as_float(w.y << 16), __uint_as_float(w.y & 0xffff0000u)}; }
            float sa[8], sb[8];
#pragma unroll
            for (int jj = 0; jj < 8; ++jj) { const f32x4* wr_ = (const f32x4*)(P_WF + (size_t)jj * D) + lane; float a = 0.f, b = 0.f;
#pragma unroll
                for (int j = 0; j < 8; ++j) { const f32x4 wv = wr_[64 * j];
                    a += (va[j][0] * wv[0] + va[j][1] * wv[1]) + (va[j][2] * wv[2] + va[j][3] * wv[3]); b += (vb[j][0] * wv[0] + vb[j][1] * wv[1]) + (vb[j][2] * wv[2] + vb[j][3] * wv[3]); }
                sa[jj] = a; sb[jj] = b; }
            const bool u5 = lane >= 32, u4 = (lane >> 4) & 1, u3 = (lane >> 3) & 1;
#define FRED(s, out) { float b4[4], c2[2]; _Pragma("unroll") for (int k = 0; k < 4; ++k) { const float snd = u5 ? s[k] : s[k + 4]; b4[k] = (u5 ? s[k + 4] : s[k]) + __shfl_xor(snd, 32); } \
                _Pragma("unroll") for (int k = 0; k < 2; ++k) { const float snd = u4 ? b4[k] : b4[k + 2]; c2[k] = (u4 ? b4[k + 2] : b4[k]) + __shfl_xor(snd, 16); } \
                { const float snd = u3 ? c2[0] : c2[1]; out = (u3 ? c2[1] : c2[0]) + __shfl_xor(snd, 8); } out += __shfl_xor(out, 4); out += __shfl_xor(out, 2); out += __shfl_xor(out, 1); }
            float da, db; FRED(sa, da) FRED(sb, db)
#undef FRED
            if ((lane & 7) == 0) { const int jj = lane >> 3; const float bf = ARG_IN(7)[jj];
                const float za = da * pg8::rs_of(P_SS(1), m) + bf, zb = db * pg8::rs_of(P_SS(1), m2) + bf;
                P_LF[(size_t)m * 8 + jj] = fminf(za, 0.f) - log1pf(__expf(-fabsf(za))); P_LF[(size_t)m2 * 8 + jj] = fminf(zb, 0.f) - log1pf(__expf(-fabsf(zb))); }
        }
    }
    xcd_barrier(xbar);
    }
    if constexpr (PH_ON(4)) {
        unsigned char* const ws = ARG_WS;
        TID_DECL
        const int GA = G - 56;
        if (bx >= GA) {
            LAS float* scr = (LAS float*)(lds + wave * 16896); const int wv = (bx - GA) * NWAVES + wave, nwv = (G - GA) * NWAVES;
            conv_matrix<true, true, true>(ARG_IN(11), NGU, ARG_IN(10), P_BF(WS_WGU2), D, NGU, wv, nwv, scr, lane, lds);
            conv_matrix<true, false, true>(ARG_IN(14), D, ARG_IN(13), P_BF(WS_WG), D, D, wv, nwv, scr, lane, lds);
            __syncthreads();
        }
        {
        LAS unsigned* slot = (LAS unsigned*)(lds + att::OFF_MISC);
        att::Tensors TA{P_QKV, P_QKV + QKV_T, P_QKV + 2 * QKV_T, P_OB, P_LF, ARG_IN(8)};
        att::Tensors TB{P_QKV + 3 * QKV_T, P_QKV + 4 * QKV_T, P_QKV + 5 * QKV_T, P_OB + 1024, P_LF, ARG_IN(8)};
        { const int rep = 0;
        for (;;) {
            if (tid == 0) slot[0] = atomicAdd(P_CNT + 64 * rep, 1u);
            __syncthreads();
            const int item = (int)slot[0];
            __syncthreads();
            if (item >= 512) break;
            int mode, blk_, bh;
            bh = item % 32; { const int grp = item / 32;
              if (grp < 5) { mode = 1; blk_ = 7 - grp; }
              else if (grp < 11) { mode = 0; blk_ = 12 - grp; }
              else if (grp == 11) { mode = 1; blk_ = 2; }
              else if (grp == 12) { mode = 0; blk_ = 1; }
              else if (grp == 13) { mode = 1; blk_ = 1; }
              else if (grp == 14) { mode = 0; blk_ = 0; }
              else { mode = 1; blk_ = 0; } }
            if (mode) att::attn_item<1>(lds, TB, bh >> 3, bh & 7, blk_); else att::attn_item<0>(lds, TA, bh >> 3, bh & 7, blk_);
        }
        }
        }
    }
    xcd_barrier(xbar);
    if constexpr (PH_ON(5)) {
        unsigned char* const ws = ARG_WS;
        pg8::Gemm g{P_OB, P_BF(WS_WOUT), M, D, D}; pg8::StaticOrder S; S.init(M, D, G, bx);
        pg8::EpiResid<true> E{nullptr, P_AB, P_SS(2), 1.0f, xbar};
        pg8::gemm_phase<pg8::EpiResid<true>, pg8::StaticOrder, false, true>(lds, g, S, E);
    }
    {
    if constexpr (PH_ON(6)) {
        unsigned char* const ws = ARG_WS;
        if (bx < G1) { pg8::Gemm g{P_AB, P_BF(WS_WGU2), M, NGU, D}; pg8::StaticOrder S; S.init(M, NGU, G1, bx);
          pg8::EpiSwiglu E{P_ACT, P_SS(2)};
          pg8::gemm_phase<pg8::EpiSwiglu, pg8::StaticOrder, true, true>(lds, g, S, E); }
        else {
            { int Kpp = DPLE; asm volatile("" : "+s"(Kpp));
              pg8::Gemm g2{P_BF(WS_PB), P_BF(WS_WP), M, D, Kpp}; pg8::StaticOrder S2; S2.init(M, D, G - G1, bx - G1); pg8::EpiBf16Plain E2{P_OB};
              pg8::gemm_phase<pg8::EpiBf16Plain, pg8::StaticOrder, true, true>(lds, g2, S2, E2); }
            TID_DECL
            LAS float* scr = (LAS float*)(lds + wave * 16896); const int wv = (bx - G1) * NWAVES + wave, nwv = (G - G1) * NWAVES;
            conv_matrix<false, false, true, USE_TILED>(ARG_IN(12), D, nullptr, P_BF(WS_WD2), FF, D, wv, nwv, scr, lane, lds);
        }
    }
    xcd_barrier(xbar);
    }
    if constexpr (PH_ON(7)) {
        unsigned char* const ws = ARG_WS;
        pg8::Gemm g{P_ACT, P_BF(WS_WD2), M, D, FF}; pg8::StaticOrder S; S.init(M, D, G, bx);
        pg8::EpiResid<true> E{nullptr, P_AB, P_SS(3), 0.5f, xbar};
        pg8::gemm_phase<pg8::EpiResid<true>, pg8::StaticOrder, false, true, USE_TILED>(lds, g, S, E);
    }
    if constexpr (PH_ON(8)) {
        unsigned char* const ws = ARG_WS;
        pg8::Gemm g{P_AB, P_BF(WS_WG), M, D, D}; pg8::StaticOrder S; S.init(M, D, G, bx);
        pg8::EpiPleNorm E{P_AB, ARG_OUT, P_SS(3), P_SS(4), ARG_IN(16), (unsigned*)(ws + CTL_PCNT), P_OB};
        pg8::gemm_phase<pg8::EpiPleNorm, pg8::StaticOrder, false, true>(lds, g, S, E);
    }
}

extern "C" void kernel_launch(void* const* d_in, const int* in_sizes, int n_in, void* d_out, int out_size, void* d_ws, size_t ws_size, hipStream_t stream) {
    static int grid = 0;
    if (grid == 0) {
        if (n_in != 17 || out_size != M * D || ws_size < WS_END) { fprintf(stderr, "kernel_launch: unexpected problem (n_in %d, out %d, ws %zu, need %zu)\n", n_in, out_size, ws_size, (size_t)WS_END); grid = -1; return; }
        int dev = 0, cus = 0, per_cu = 0;
        hipGetDevice(&dev); hipDeviceGetAttribute(&cus, hipDeviceAttributeMultiprocessorCount, dev);
        if (hipFuncSetAttribute((const void*)fwd_kernel, hipFuncAttributeMaxDynamicSharedMemorySize, LDS_BYTES) != hipSuccess) { fprintf(stderr, "kernel_launch: hipFuncSetAttribute failed\n"); grid = -1; return; }
        if (hipOccupancyMaxActiveBlocksPerMultiprocessor(&per_cu, (const void*)fwd_kernel, NTHR, LDS_BYTES) != hipSuccess || per_cu < 1) { fprintf(stderr, "kernel_launch: occupancy query says %d\n", per_cu); per_cu = 1; }
        (void)hipGetLastError();
        if (cus != 256) { fprintf(stderr, "kernel_launch: built for a 256-CU device (got %d CUs); nothing launched\n", cus); grid = -1; return; }
        grid = cus;
    }
    if (grid < 0) return;
    Args a{};
    for (int i = 0; i < 17; ++i) a.in[i] = (const float*)d_in[i];
    a.out = (float*)d_out; a.ws = (unsigned char*)d_ws;
    void* args[] = {&a};
    if (hipMemsetAsync((char*)d_ws + CTL_BAR, 0, XCD_BAR_WORDS * 4, stream) != hipSuccess) { fprintf(stderr, "kernel_launch: hipMemsetAsync failed\n"); return; }
    hipError_t e = hipLaunchCooperativeKernel((const void*)fwd_kernel, dim3(grid), dim3(NTHR), args, LDS_BYTES, stream);
    if (e != hipSuccess) fprintf(stderr, "cooperative launch failed: %s (grid %d)\n", hipGetErrorString(e), grid);
}
```

```cpp
#include <hip/hip_runtime.h>
#include <hip/hip_cooperative_groups.h>
#include <cstdio>
#include <cstdint>
namespace cg = cooperative_groups;
#define LAS __attribute__((address_space(3)))
#define XB_TMO      128
#define XB_XCNT(j)  (256  + 64 * (j))
#define XB_XSUB(j)  (1280 + 64 * (j))
#define XB_XGEN(j)  (2304 + 64 * (j))
#define XB_TOP      3328
#define XB_TOPGEN   3392
#define XCD_BAR_WORDS 3456
#define XB_SPIN_CAP (1u << 18)

__device__ __forceinline__ unsigned xb_ld(unsigned* p)              { return __hip_atomic_load(p, __ATOMIC_RELAXED, __HIP_MEMORY_SCOPE_AGENT); }
__device__ __forceinline__ unsigned xb_add(unsigned* p, unsigned v) { return __hip_atomic_fetch_add(p, v, __ATOMIC_RELAXED, __HIP_MEMORY_SCOPE_AGENT); }
__device__ __forceinline__ unsigned xb_xcc_id() { return (unsigned)__builtin_amdgcn_s_getreg((3 << 11) | 20) & 0xFu; }
#define XB_SPIN(cond, bar) do { unsigned _sp = 0; while (cond) { __builtin_amdgcn_s_sleep(1); \
    if ((++_sp & 255u) == 0u) { if (xb_ld(&(bar)[XB_TMO])) break; if (_sp > XB_SPIN_CAP) { atomicAdd(&(bar)[XB_TMO], 1u); break; } } } } while (0)

struct XcdBarrier {
    unsigned* bar; unsigned x;
    volatile LAS unsigned* st;
};

__device__ __forceinline__ XcdBarrier xcd_barrier_post(unsigned* bar, volatile LAS unsigned* st) {
    XcdBarrier b; b.bar = bar; b.x = xb_xcc_id(); b.st = st;
    if (threadIdx.x == 0) (void)xb_add(&bar[XB_XCNT(b.x)], 1u);
    return b;
}
__device__ __forceinline__ void xcd_barrier_complete(unsigned* bar, unsigned x, unsigned& nloc, unsigned& nx) {
    const unsigned G = gridDim.x * gridDim.y * gridDim.z;
    unsigned sum, cnt, mine, sp = 0u;
    for (;;) {
        sum = 0u; cnt = 0u; mine = 0u;
#pragma unroll
        for (unsigned j = 0; j < 16; ++j) { const unsigned c = xb_ld(&bar[XB_XCNT(j)]); sum += c; cnt += (c > 0u) ? 1u : 0u; mine = (j == x) ? c : mine; }
        if (sum == G) break;
        __builtin_amdgcn_s_sleep(1);
        if ((++sp & 255u) == 0u) { if (xb_ld(&bar[XB_TMO])) break; if (sp > XB_SPIN_CAP) { atomicAdd(&bar[XB_TMO], 1u); break; } }
    }
    nloc = mine > 0u ? mine : 1u; nx = cnt > 0u ? cnt : 1u;
}

__device__ __forceinline__ void xcd_barrier(const XcdBarrier& b) {
    asm volatile("s_waitcnt vmcnt(0)" ::: "memory");
    __syncthreads();
    if (threadIdx.x == 0) {
        unsigned* bar = b.bar;
        __builtin_amdgcn_s_waitcnt(0);
        unsigned nloc = b.st[0], nx = b.st[1];
        if (nloc == 0u) { xcd_barrier_complete(bar, b.x, nloc, nx); b.st[0] = nloc; b.st[1] = nx; }
        const unsigned old = xb_add(&bar[XB_XSUB(b.x)], 1u);
        const unsigned gen = old / nloc;
        if (old + 1u == (gen + 1u) * nloc) {
            __builtin_amdgcn_fence(__ATOMIC_RELEASE, "agent");
            asm volatile("s_waitcnt vmcnt(0)" ::: "memory");
            const unsigned og = xb_add(&bar[XB_TOP], 1u);
            const unsigned tg = og / nx;
            if (og + 1u == (tg + 1u) * nx) xb_add(&bar[XB_TOPGEN], 1u);
            else XB_SPIN(xb_ld(&bar[XB_TOPGEN]) == tg, bar);
            __builtin_amdgcn_fence(__ATOMIC_ACQUIRE, "agent");
            xb_add(&bar[XB_XGEN(b.x)], 1u);
            asm volatile("s_waitcnt vmcnt(0)" ::: "memory");
        } else {
            XB_SPIN(xb_ld(&bar[XB_XGEN(b.x)]) == gen, bar);
            __builtin_amdgcn_fence(__ATOMIC_ACQUIRE, "agent");
            asm volatile("s_waitcnt vmcnt(0)" ::: "memory");
        }
    }
    __syncthreads();
}

namespace pg8 {
#define PG8_LAS __attribute__((address_space(3)))
typedef unsigned short bf16_t;
typedef short bf16x8 __attribute__((ext_vector_type(8)));
typedef float f32x4 __attribute__((ext_vector_type(4)));
typedef unsigned u32x4 __attribute__((ext_vector_type(4)));
constexpr int BM = 256, BK = 64, HALF = 128, HTB = HALF * BK * 2  , STAGE_BYTES = 8 * HTB, NXCD = 8, WGM = 8;

__host__ __device__ __forceinline__ int lds_byte(int r, int c) { const int st = (r >> 4) * 2 + (c >> 5), rr = r & 15, cc = c & 31, ob = rr * 64 + cc * 2; return st * 1024 + (ob ^ (((ob >> 9) & 1) << 5)); }
__host__ __device__ __forceinline__ void stage_rc(int b, int& R, int& C) { const int st = b / 1024, sb = b % 1024, swz = sb ^ (((sb >> 9) & 1) << 5); R = (st >> 1) * 16 + swz / 64; C = (st & 1) * 32 + (swz % 64) / 2; }
__host__ __device__ __forceinline__ int perm32(int rho) { const int n = rho >> 4, i = rho & 15; return 8 * (i >> 2) + 4 * n + (i & 3); }

struct Unit { int pm, pn; };
struct Gemm { const bf16_t* A; const bf16_t* Bt; int M, N, K; };

struct StaticOrder {
    int nM, nN, nwg, G, c;
    __host__ __device__ void init(int M, int N, int G_, int c_) { nM = M / BM; nN = N / BM; nwg = nM * nN; G = G_; c = c_; }
    __host__ __device__ bool next(int i, Unit& u) const {
        const long L = (long)i * G + c; if (L >= nwg) return false;
        int wgid = (int)L; { const int q = nwg / NXCD, r = nwg % NXCD, xcd = wgid % NXCD, off = wgid / NXCD; wgid = (xcd < r ? xcd * (q + 1) : r * (q + 1) + (xcd - r) * q) + off; }
        const int nig = WGM * nN, gid = wgid / nig, fm = gid * WGM, gsz = (nM - fm) < WGM ? (nM - fm) : WGM;
        u.pm = fm + ((wgid % nig) % gsz); u.pn = (wgid % nig) / gsz; return true;
    }
    __device__ __forceinline__ void a_ready(const Unit&) const {}
    __device__ __forceinline__ void done(const Unit&) const {}
};

__device__ __forceinline__ unsigned cvt_pk_bf16(float lo, float hi) { unsigned r; asm volatile("v_cvt_pk_bf16_f32 %0, %1, %2" : "=v"(r) : "v"(lo), "v"(hi)); return r; }
typedef float f32x2 __attribute__((ext_vector_type(2)));
#ifndef USE_TILED
#define USE_TILED false
#endif
constexpr float RMS_EPS = 1e-6f;
constexpr int DM = 2048, DFF = 5632;
__device__ __forceinline__ float rs_of(const float* ss, int row) { return __builtin_amdgcn_rsqf(ss[row] * (1.0f / 2048.0f) + RMS_EPS); }
__device__ __forceinline__ float silu_f(float a) { return a * __builtin_amdgcn_rcpf(1.0f + __builtin_amdgcn_exp2f(-1.4426950408889634f * a)); }
__device__ __forceinline__ float sigm_f(float a) { return __builtin_amdgcn_rcpf(1.0f + __builtin_amdgcn_exp2f(-1.4426950408889634f * a)); }
__device__ __forceinline__ u32x4 pack8(const f32x4 v0, const f32x4 v1) { u32x4 w; w.x = cvt_pk_bf16(v0[0], v0[1]); w.y = cvt_pk_bf16(v0[2], v0[3]); w.z = cvt_pk_bf16(v1[0], v1[1]); w.w = cvt_pk_bf16(v1[2], v1[3]); return w; }

struct EpiSwiglu {
    static constexpr bool PERM = true, AFTER_DRAIN = false;
    static constexpr bool PRELOAD = true;
    bf16_t* O; const float* ss;
    __device__ __forceinline__ void preload(const Unit& u, int wr, int fr, float (&pre)[8]) const {
#pragma unroll
        for (int i = 0; i < 8; ++i) pre[i] = ss[u.pm * BM + wr * 64 + fr + (i >> 2) * HALF + (i & 3) * 16];
    }
    __device__ __forceinline__ void operator()(const f32x4 (&acc)[2][2][4][2], const Unit& u, int wr, int wc, int fr, int fq, const float (&pre)[8]) const {
        const int row0 = u.pm * BM + wr * 64 + fr, col0 = u.pn * 128 + wc * 32 + 8 * fq;
        float rsv[2][4];
#pragma unroll
        for (int ai = 0; ai < 2; ++ai)
#pragma unroll
            for (int m = 0; m < 4; ++m) rsv[ai][m] = pre[4 * ai + m];
#pragma unroll
        for (int ai = 0; ai < 2; ++ai)
#pragma unroll
            for (int m = 0; m < 4; ++m) {
                const int r = row0 + ai * HALF + m * 16; const float rs = __builtin_amdgcn_rsqf(rsv[ai][m] * (1.0f / 2048.0f) + RMS_EPS);
                f32x4 v[2];
                const float k1 = -1.4426950408889634f * rs, rs2 = rs * rs;
#pragma unroll
                for (int n = 0; n < 2; ++n) { const f32x4 a = acc[ai][0][m][n], b = acc[ai][1][m][n];
#pragma unroll
                    for (int q = 0; q < 4; ++q) v[n][q] = (a[q] * b[q]) * rs2 * __builtin_amdgcn_rcpf(1.0f + __builtin_amdgcn_exp2f(k1 * a[q])); }
                if (USE_TILED) *(u32x4*)(O + ((size_t)(r >> 8) * (DFF / 64) + (col0 >> 6)) * 16384 + (size_t)(r & 255) * 64 + (col0 & 63)) = pack8(v[0], v[1]);
                else *(u32x4*)(O + (size_t)r * DFF + col0) = pack8(v[0], v[1]);
            }
    }
};
template <bool IN_BF16> struct EpiResid {
    static constexpr bool PERM = true, AFTER_DRAIN = true;
    const float* hin; bf16_t* hb; float* ss; float scale; ::XcdBarrier xbar;
    __device__ __forceinline__ void fused(f32x4 (&acc)[2][2][4][2], const Unit& u, int wr, int wc, int fr, int fq, PG8_LAS unsigned char*, int, int) const {
        const int row0 = u.pm * BM + wr * 64 + fr, col0 = u.pn * BM + wc * 32 + 8 * fq;
        f32x4 xv[4][2][2][2];
#define EPIRESID_LOAD(k) _Pragma("unroll") for (int mm = 0; mm < 2; ++mm) _Pragma("unroll") for (int bj = 0; bj < 2; ++bj) { \
            const size_t off_ = (size_t)(row0 + ((k) >> 1) * HALF + (2 * ((k) & 1) + mm) * 16) * DM + col0 + bj * HALF; \
            if (IN_BF16) { const u32x4 w_ = *(const u32x4*)(hb + off_); \
                xv[k][mm][bj][0] = (f32x4){__uint_as_float(w_.x << 16), __uint_as_float(w_.x & 0xffff0000u), __uint_as_float(w_.y << 16), __uint_as_float(w_.y & 0xffff0000u)}; \
                xv[k][mm][bj][1] = (f32x4){__uint_as_float(w_.z << 16), __uint_as_float(w_.z & 0xffff0000u), __uint_as_float(w_.w << 16), __uint_as_float(w_.w & 0xffff0000u)}; } \
            else { xv[k][mm][bj][0] = *(const f32x4*)(hin + off_); xv[k][mm][bj][1] = *(const f32x4*)(hin + off_ + 4); } }
        EPIRESID_LOAD(0)
#pragma unroll
        for (int k = 0; k < 4; ++k) {
            if (k == 0) { EPIRESID_LOAD(1) } else if (k == 1) { EPIRESID_LOAD(2) } else if (k == 2) { EPIRESID_LOAD(3) }
            asm volatile("" ::: "memory");
            const int ai = k >> 1;
#pragma unroll
            for (int mm = 0; mm < 2; ++mm) { const int m = 2 * (k & 1) + mm, r = row0 + ai * HALF + m * 16; float sq = 0.f;
#pragma unroll
                for (int bj = 0; bj < 2; ++bj) { const size_t off = (size_t)r * DM + col0 + bj * HALF;
                    const f32x4 a = xv[k][mm][bj][0] + acc[ai][bj][m][0] * scale, b = xv[k][mm][bj][1] + acc[ai][bj][m][1] * scale;
                    *(u32x4*)(hb + off) = pack8(a, b);
                    sq += (a[0] * a[0] + a[1] * a[1]) + (a[2] * a[2] + a[3] * a[3]) + (b[0] * b[0] + b[1] * b[1]) + (b[2] * b[2] + b[3] * b[3]); }
                sq += __shfl_xor(sq, 16); sq += __shfl_xor(sq, 32);
                if (fq == 0) unsafeAtomicAdd(ss + r, sq); }
            asm volatile("" ::: "memory");
        }
#undef EPIRESID_LOAD
        ::xcd_barrier(xbar);
    }
};
struct EpiQKV {
    static constexpr bool PERM = true, AFTER_DRAIN = false;
    static constexpr bool PRELOAD = true;
    bf16_t* base; const float* ss; float qscale; size_t tstride;
    __device__ __forceinline__ void preload(const Unit& u, int wr, int fr, float (&pre)[8]) const {
#pragma unroll
        for (int i = 0; i < 8; ++i) pre[i] = ss[u.pm * BM + wr * 64 + fr + (i >> 2) * HALF + (i & 3) * 16];
    }
    __device__ __forceinline__ void operator()(const f32x4 (&acc)[2][2][4][2], const Unit& u, int wr, int wc, int fr, int fq, const float (&pre)[8]) const {
        const int t = u.pn >> 2; const float sc = (t == 0 || t == 3) ? qscale : 1.0f;
        const int row0 = u.pm * BM + wr * 64 + fr, col0 = (u.pn & 3) * BM + wc * 32 + 8 * fq; bf16_t* O = base + (size_t)t * tstride;
        float rsv[2][4];
#pragma unroll
        for (int ai = 0; ai < 2; ++ai)
#pragma unroll
            for (int m = 0; m < 4; ++m) rsv[ai][m] = pre[4 * ai + m];
#pragma unroll
        for (int ai = 0; ai < 2; ++ai)
#pragma unroll
            for (int m = 0; m < 4; ++m) {
                const int r = row0 + ai * HALF + m * 16; const float rs = __builtin_amdgcn_rsqf(rsv[ai][m] * (1.0f / 2048.0f) + RMS_EPS) * sc;
#pragma unroll
                for (int bj = 0; bj < 2; ++bj) *(u32x4*)(O + (size_t)r * 1024 + col0 + bj * HALF) = pack8(acc[ai][bj][m][0] * rs, acc[ai][bj][m][1] * rs);
            }
    }
};
struct EpiF32 {
    static constexpr bool PERM = true, AFTER_DRAIN = false;
    float* O;
    __device__ __forceinline__ void operator()(const f32x4 (&acc)[2][2][4][2], const Unit& u, int wr, int wc, int fr, int fq) const {
        const int row0 = u.pm * BM + wr * 64 + fr, col0 = u.pn * BM + wc * 32 + 8 * fq;
#pragma unroll
        for (int ai = 0; ai < 2; ++ai)
#pragma unroll
            for (int m = 0; m < 4; ++m)
            {
#pragma unroll
              for (int bj = 0; bj < 2; ++bj) { float* o = O + (size_t)(row0 + ai * HALF + m * 16) * DM + col0 + bj * HALF; *(f32x4*)o = acc[ai][bj][m][0]; *(f32x4*)(o + 4) = acc[ai][bj][m][1]; } }
    }
};
struct EpiBf16Plain {
    static constexpr bool PERM = true, AFTER_DRAIN = false;
    bf16_t* O;
    __device__ __forceinline__ void operator()(const f32x4 (&acc)[2][2][4][2], const Unit& u, int wr, int wc, int fr, int fq) const {
        const int row0 = u.pm * BM + wr * 64 + fr, col0 = u.pn * BM + wc * 32 + 8 * fq;
#pragma unroll
        for (int ai = 0; ai < 2; ++ai)
#pragma unroll
            for (int m = 0; m < 4; ++m)
#pragma unroll
                for (int bj = 0; bj < 2; ++bj) *(u32x4*)(O + (size_t)(row0 + ai * HALF + m * 16) * DM + col0 + bj * HALF) = pack8(acc[ai][bj][m][0], acc[ai][bj][m][1]);
    }
};
struct EpiPle {
    static constexpr bool PERM = true, AFTER_DRAIN = false;
    const float* hin; float* out; const float* ss3; float* ss4;
    __device__ __forceinline__ void operator()(const f32x4 (&acc)[2][2][4][2], const Unit& u, int wr, int wc, int fr, int fq) const {
        const int row0 = u.pm * BM + wr * 64 + fr, col0 = u.pn * BM + wc * 32 + 8 * fq;
#pragma unroll
        for (int ai = 0; ai < 2; ++ai)
#pragma unroll
            for (int m = 0; m < 4; ++m) {
                const int r = row0 + ai * HALF + m * 16; const float rs = rs_of(ss3, r); float sq = 0.f;
#pragma unroll
                for (int bj = 0; bj < 2; ++bj) { const size_t off = (size_t)r * DM + col0 + bj * HALF;
                    const f32x4 x0 = *(const f32x4*)(hin + off), x1 = *(const f32x4*)(hin + off + 4), p0 = *(const f32x4*)(out + off), p1 = *(const f32x4*)(out + off + 4);
                    const f32x4 a0 = acc[ai][bj][m][0] * rs, a1 = acc[ai][bj][m][1] * rs;
                    const f32x4 g0 = (f32x4){sigm_f(a0[0]), sigm_f(a0[1]), sigm_f(a0[2]), sigm_f(a0[3])}, g1 = (f32x4){sigm_f(a1[0]), sigm_f(a1[1]), sigm_f(a1[2]), sigm_f(a1[3])};
                    const f32x4 y0 = x0 + g0 * p0, y1 = x1 + g1 * p1;
                    *(f32x4*)(out + off) = y0; *(f32x4*)(out + off + 4) = y1;
                    sq += (y0[0] * y0[0] + y0[1] * y0[1]) + (y0[2] * y0[2] + y0[3] * y0[3]) + (y1[0] * y1[0] + y1[1] * y1[1]) + (y1[2] * y1[2] + y1[3] * y1[3]); }
                sq += __shfl_xor(sq, 16); sq += __shfl_xor(sq, 32);
                if (fq == 0) unsafeAtomicAdd(ss4 + r, sq);
            }
    }
};

struct EpiPleNorm {
    static constexpr bool PERM = true, AFTER_DRAIN = true;
    const bf16_t* hbin; float* out; const float* ss3; float* ss4; const float* gfin; unsigned* pcnt; const bf16_t* ppb;
    __device__ __forceinline__ void fused(f32x4 (&acc)[2][2][4][2], const Unit& u, int wr, int wc, int fr, int fq, PG8_LAS unsigned char*, int, int lane) const {
        const int row0 = u.pm * BM + wr * 64 + fr, col0 = u.pn * BM + wc * 32 + 8 * fq;
        float rsv[2][4];
#pragma unroll
        for (int ai = 0; ai < 2; ++ai)
#pragma unroll
            for (int m = 0; m < 4; ++m) rsv[ai][m] = ss3[row0 + ai * HALF + m * 16];
#pragma unroll
        for (int ai = 0; ai < 2; ++ai)
#pragma unroll
            for (int mh = 0; mh < 2; ++mh) {
                f32x4 xv[2][2][2]; u32x4 pw[2][2];
#pragma unroll
                for (int mm = 0; mm < 2; ++mm)
#pragma unroll
                    for (int bj = 0; bj < 2; ++bj) { const size_t off = (size_t)(row0 + ai * HALF + (2 * mh + mm) * 16) * DM + col0 + bj * HALF;
                        const u32x4 w_ = *(const u32x4*)(hbin + off);
                        xv[mm][bj][0] = (f32x4){__uint_as_float(w_.x << 16), __uint_as_float(w_.x & 0xffff0000u), __uint_as_float(w_.y << 16), __uint_as_float(w_.y & 0xffff0000u)};
                        xv[mm][bj][1] = (f32x4){__uint_as_float(w_.z << 16), __uint_as_float(w_.z & 0xffff0000u), __uint_as_float(w_.w << 16), __uint_as_float(w_.w & 0xffff0000u)};
                        pw[mm][bj] = *(const u32x4*)(ppb + off); }
#pragma unroll
                for (int mm = 0; mm < 2; ++mm) { const int m = 2 * mh + mm, r = row0 + ai * HALF + m * 16; const float rs = __builtin_amdgcn_rsqf(rsv[ai][m] * (1.0f / 2048.0f) + RMS_EPS); float sq = 0.f;
#pragma unroll
                    for (int bj = 0; bj < 2; ++bj) {
                        const f32x4 a0 = acc[ai][bj][m][0] * rs, a1 = acc[ai][bj][m][1] * rs;
                        const f32x4 g0 = (f32x4){sigm_f(a0[0]), sigm_f(a0[1]), sigm_f(a0[2]), sigm_f(a0[3])}, g1 = (f32x4){sigm_f(a1[0]), sigm_f(a1[1]), sigm_f(a1[2]), sigm_f(a1[3])};
                        const u32x4 w = pw[mm][bj];
                        const f32x4 p0 = (f32x4){__uint_as_float(w.x << 16), __uint_as_float(w.x & 0xffff0000u), __uint_as_float(w.y << 16), __uint_as_float(w.y & 0xffff0000u)}, p1 = (f32x4){__uint_as_float(w.z << 16), __uint_as_float(w.z & 0xffff0000u), __uint_as_float(w.w << 16), __uint_as_float(w.w & 0xffff0000u)};
                        const f32x4 y0 = xv[mm][bj][0] + g0 * p0, y1 = xv[mm][bj][1] + g1 * p1;
                        acc[ai][bj][m][0] = y0; acc[ai][bj][m][1] = y1;
                        sq += (y0[0] * y0[0] + y0[1] * y0[1]) + (y0[2] * y0[2] + y0[3] * y0[3]) + (y1[0] * y1[0] + y1[1] * y1[1]) + (y1[2] * y1[2] + y1[3] * y1[3]); }
                    sq += __shfl_xor(sq, 16); sq += __shfl_xor(sq, 32);
                    if (fq == 0) unsafeAtomicAdd(ss4 + r, sq); }
            }
        asm volatile("s_waitcnt vmcnt(0)" ::: "memory");
        unsigned* c = pcnt + 64 * u.pm;
        if (lane == 0) __hip_atomic_fetch_add(c, 1u, __ATOMIC_RELAXED, __HIP_MEMORY_SCOPE_AGENT);
        if (wr == 0 && wc == 0) { unsigned sp = 0; while ((unsigned)__builtin_amdgcn_readfirstlane(__hip_atomic_load(c, __ATOMIC_RELAXED, __HIP_MEMORY_SCOPE_AGENT)) < 64u) { __builtin_amdgcn_s_sleep(4); if (++sp > (1u << 21)) break; } }
        asm volatile("s_waitcnt vmcnt(0) lgkmcnt(0)" ::: "memory"); __builtin_amdgcn_s_barrier(); asm volatile("" ::: "memory");
        f32x4 gv[2][2];
#pragma unroll
        for (int bj = 0; bj < 2; ++bj) { gv[bj][0] = *(const f32x4*)(gfin + col0 + bj * HALF); gv[bj][1] = *(const f32x4*)(gfin + col0 + bj * HALF + 4); }
        float s4[2][4];
#pragma unroll
        for (int ai = 0; ai < 2; ++ai)
#pragma unroll
            for (int m = 0; m < 4; ++m) s4[ai][m] = __hip_atomic_load(ss4 + row0 + ai * HALF + m * 16, __ATOMIC_RELAXED, __HIP_MEMORY_SCOPE_AGENT);
#pragma unroll
        for (int ai = 0; ai < 2; ++ai)
#pragma unroll
            for (int m = 0; m < 4; ++m) {
                const int r = row0 + ai * HALF + m * 16;
                const float rs = __builtin_amdgcn_rsqf(s4[ai][m] * (1.0f / 2048.0f) + RMS_EPS);
#pragma unroll
                for (int bj = 0; bj < 2; ++bj) { float* o = out + (size_t)r * DM + col0 + bj * HALF;
                    *(f32x4*)o = acc[ai][bj][m][0] * rs * gv[bj][0]; *(f32x4*)(o + 4) = acc[ai][bj][m][1] * rs * gv[bj][1]; }
            }
    }
};
template <class E_> struct has_preload { template <class T> static constexpr auto test(int) -> decltype(T::PRELOAD, true) { return T::PRELOAD; } template <class> static constexpr bool test(...) { return false; } static constexpr bool value = test<E_>(0); };
template <class Epi, class Sched, bool ALIGN_EPI = false, bool SP2 = false, bool TILED = false  >
__device__ __forceinline__ void gemm_phase(PG8_LAS unsigned char* lds, const Gemm g, const Sched& S, const Epi& E) {
    int tid_l = threadIdx.x; asm volatile("" : "+v"(tid_l));
    const int tid = tid_l, wid = __builtin_amdgcn_readfirstlane(tid >> 6), lane = tid & 63, wr = wid >> 2, wc = wid & 3, fr = lane & 15, fq = lane >> 4;
    const int K = g.K, nt = K / BK;
    unsigned voffA[2], voffB[2];
#pragma unroll
    for (int i = 0; i < 2; ++i) { int R, C; stage_rc(tid * 16 + i * 8192, R, C); const int Rb = Epi::PERM ? ((R & ~31) + perm32(R & 31)) : R;
        voffA[i] = (unsigned)(R * (TILED ? BK : K) + C) * 2u; voffB[i] = (unsigned)(Rb * (TILED ? BK : K) + C) * 2u; }
    const size_t kstep = TILED ? (size_t)(BM * BK * 2) : (size_t)(BK * 2);
    const size_t hstep = TILED ? (size_t)(HALF * BK * 2) : (size_t)HALF * K * 2;
    const size_t tstep = (size_t)BM * K * 2;
    const unsigned ldsw = (unsigned)wid * 1024u;
    const int aoff = lds_byte(wr * 64 + fr, fq * 8), boff = lds_byte(wc * 32 + fr, fq * 8);
#define PG8_SA(b, h) (((b) * 2 + (h)) * HTB)
#define PG8_SB(b, h) ((4 + (b) * 2 + (h)) * HTB)
#define PG8_STAGE(bufoff, gbase, voff) do { _Pragma("unroll") for (int _i = 0; _i < 2; ++_i) \
        __builtin_amdgcn_global_load_lds((const unsigned*)((const char*)(gbase) + (voff)[_i]), (PG8_LAS unsigned*)(lds + (bufoff) + ldsw + _i * 8192), 16, 0, 0); } while (0)
#define PG8_LDA(dst, b, h) do { _Pragma("unroll") for (int m = 0; m < 4; ++m) _Pragma("unroll") for (int k = 0; k < 2; ++k) dst[m][k] = *(const PG8_LAS bf16x8*)(lds + PG8_SA(b, h) + aoff + m * 2048 + k * 1024); } while (0)
#define PG8_LDB(dst, b, h) do { _Pragma("unroll") for (int n = 0; n < 2; ++n) _Pragma("unroll") for (int k = 0; k < 2; ++k) dst[n][k] = *(const PG8_LAS bf16x8*)(lds + PG8_SB(b, h) + boff + n * 2048 + k * 1024); } while (0)
#define PG8_MMA(ai, bj, At, Bt) do { __builtin_amdgcn_s_setprio(1); _Pragma("unroll") for (int m = 0; m < 4; ++m) _Pragma("unroll") for (int n = 0; n < 2; ++n) _Pragma("unroll") for (int k = 0; k < 2; ++k) \
        acc[ai][bj][m][n] = __builtin_amdgcn_mfma_f32_16x16x32_bf16(Bt[n][k], At[m][k], acc[ai][bj][m][n], 0, 0, 0); __builtin_amdgcn_s_setprio(0); } while (0)
#define PG8_WAIT_V(n) asm volatile("s_waitcnt vmcnt(" #n ")" ::: "memory")
#define PG8_WAIT_L(n) asm volatile("s_waitcnt lgkmcnt(" #n ")" ::: "memory")
#define PG8_BAR __builtin_amdgcn_s_barrier()
#define PG8_SCHED __builtin_amdgcn_sched_barrier(0)
    Unit cur, nxt; int ui = 0;
    if (!S.next(0, cur)) return;
    f32x4 acc[2][2][4][2];
#pragma unroll
    for (int a = 0; a < 2; ++a)
#pragma unroll
        for (int b = 0; b < 2; ++b)
#pragma unroll
            for (int m = 0; m < 4; ++m)
#pragma unroll
                for (int n = 0; n < 2; ++n) acc[a][b][m][n] = (f32x4){0.f, 0.f, 0.f, 0.f};
    bf16x8 At[4][2], B0[2][2], B1[2][2];
    const char* cA = (const char*)g.A + (size_t)cur.pm * tstep; const char* cB = (const char*)g.Bt + (size_t)cur.pn * tstep;
    S.a_ready(cur);
    float pre[8];
    if constexpr (has_preload<Epi>::value) E.preload(cur, wr, fr, pre);
    if constexpr (SP2) {
        PG8_STAGE(PG8_SB(0, 0), cB, voffB); PG8_STAGE(PG8_SB(0, 1), cB + hstep, voffB); PG8_STAGE(PG8_SA(0, 0), cA, voffA); PG8_STAGE(PG8_SA(0, 1), cA + hstep, voffA);
        if (wr == 1) PG8_BAR;
        PG8_WAIT_V(2); PG8_BAR;
        PG8_STAGE(PG8_SB(1, 0), cB + kstep, voffB); PG8_STAGE(PG8_SA(1, 0), cA + kstep, voffA); PG8_STAGE(PG8_SB(1, 1), cB + hstep + kstep, voffB);
        PG8_WAIT_V(6); PG8_BAR;
    } else {
        PG8_STAGE(PG8_SB(0, 0), cB, voffB); PG8_STAGE(PG8_SA(0, 0), cA, voffA); PG8_STAGE(PG8_SB(0, 1), cB + hstep, voffB); PG8_STAGE(PG8_SA(0, 1), cA + hstep, voffA);
        if (wr == 1) PG8_BAR;
        PG8_WAIT_V(4); PG8_BAR;
        PG8_STAGE(PG8_SB(1, 0), cB + kstep, voffB); PG8_STAGE(PG8_SA(1, 0), cA + kstep, voffA); PG8_STAGE(PG8_SB(1, 1), cB + hstep + kstep, voffB);
        PG8_WAIT_V(6); PG8_BAR;
    }
    for (;;) {
        const bool has_next = S.next(ui + 1, nxt);
        const char* nA = has_next ? (const char*)g.A + (size_t)nxt.pm * tstep : cA; const char* nB = has_next ? (const char*)g.Bt + (size_t)nxt.pn * tstep : cB;
        for (int t = 0; t < nt; t += 2) {
            const bool last = (t == nt - 2);
            const char* a1 = cA + (size_t)(t + 1) * kstep;
            const char* a2 = last ? nA : cA + (size_t)(t + 2) * kstep; const char* b2 = last ? nB : cB + (size_t)(t + 2) * kstep;
            const char* a3 = a2 + kstep; const char* b3 = b2 + kstep;
            if (last && has_next) S.a_ready(nxt);
            if constexpr (SP2) {
            PG8_LDB(B0, 0, 0); PG8_LDB(B1, 0, 1); PG8_SCHED; PG8_LDA(At, 0, 0); PG8_STAGE(PG8_SA(1, 1), a1 + hstep, voffA);
            PG8_WAIT_V(8); PG8_WAIT_L(0); PG8_BAR; PG8_MMA(0, 0, At, B0); PG8_MMA(0, 1, At, B1); PG8_BAR; PG8_SCHED;
            PG8_LDA(At, 0, 1); PG8_STAGE(PG8_SB(0, 0), b2, voffB); PG8_STAGE(PG8_SB(0, 1), b2 + hstep, voffB); PG8_STAGE(PG8_SA(0, 0), a2, voffA);
            PG8_WAIT_V(8); PG8_WAIT_L(0); PG8_BAR; PG8_MMA(1, 0, At, B0); PG8_MMA(1, 1, At, B1); PG8_BAR; PG8_SCHED;
            PG8_LDB(B0, 1, 0); PG8_LDB(B1, 1, 1); PG8_SCHED; PG8_LDA(At, 1, 0); PG8_STAGE(PG8_SA(0, 1), a2 + hstep, voffA);
            PG8_WAIT_V(8); PG8_WAIT_L(0); PG8_BAR; PG8_MMA(0, 0, At, B0); PG8_MMA(0, 1, At, B1); PG8_BAR; PG8_SCHED;
            PG8_LDA(At, 1, 1); PG8_STAGE(PG8_SB(1, 0), b3, voffB); PG8_STAGE(PG8_SB(1, 1), b3 + hstep, voffB); PG8_STAGE(PG8_SA(1, 0), a3, voffA);
            PG8_WAIT_V(8); PG8_WAIT_L(0); PG8_BAR; PG8_MMA(1, 0, At, B0); PG8_MMA(1, 1, At, B1); PG8_BAR; PG8_SCHED;
            } else {
            PG8_LDB(B0, 0, 0); PG8_SCHED; PG8_LDA(At, 0, 0); PG8_STAGE(PG8_SA(1, 1), a1 + hstep, voffA);
            PG8_WAIT_L(8); PG8_BAR; PG8_WAIT_L(0); PG8_MMA(0, 0, At, B0); PG8_BAR; PG8_SCHED;
            PG8_LDB(B1, 0, 1); PG8_STAGE(PG8_SB(0, 0), b2, voffB);
            PG8_BAR; PG8_WAIT_L(0); PG8_MMA(0, 1, At, B1); PG8_BAR;
            PG8_LDA(At, 0, 1); PG8_STAGE(PG8_SA(0, 0), a2, voffA);
            PG8_BAR; PG8_WAIT_L(0); PG8_MMA(1, 0, At, B0); PG8_BAR; PG8_SCHED;
            PG8_STAGE(PG8_SB(0, 1), b2 + hstep, voffB);
            PG8_WAIT_V(6); PG8_BAR; PG8_MMA(1, 1, At, B1); PG8_BAR;
            PG8_LDB(B0, 1, 0); PG8_SCHED; PG8_LDA(At, 1, 0); PG8_STAGE(PG8_SA(0, 1), a2 + hstep, voffA);
            PG8_WAIT_L(8); PG8_BAR; PG8_WAIT_L(0); PG8_MMA(0, 0, At, B0); PG8_BAR; PG8_SCHED;
            PG8_LDB(B1, 1, 1); PG8_STAGE(PG8_SB(1, 0), b3, voffB);
            PG8_BAR; PG8_WAIT_L(0); PG8_MMA(0, 1, At, B1); PG8_BAR;
            PG8_LDA(At, 1, 1); PG8_STAGE(PG8_SA(1, 0), a3, voffA);
            PG8_BAR; PG8_WAIT_L(0); PG8_MMA(1, 0, At, B0); PG8_BAR; PG8_SCHED;
            PG8_STAGE(PG8_SB(1, 1), b3 + hstep, voffB);
            PG8_WAIT_V(6); PG8_BAR; PG8_MMA(1, 1, At, B1); PG8_BAR;
            }
        }
        if constexpr (ALIGN_EPI) { if (wr == 0) PG8_BAR; }
        if constexpr (!Epi::AFTER_DRAIN) { if constexpr (has_preload<Epi>::value) E(acc, cur, wr, wc, fr, fq, pre); else E(acc, cur, wr, wc, fr, fq); S.done(cur); }
        if (!has_next) break;
#pragma unroll
        for (int a = 0; a < 2; ++a)
#pragma unroll
            for (int b = 0; b < 2; ++b)
#pragma unroll
                for (int m = 0; m < 4; ++m)
#pragma unroll
                    for (int n = 0; n < 2; ++n) acc[a][b][m][n] = (f32x4){0.f, 0.f, 0.f, 0.f};
        cur = nxt; cA = nA; cB = nB; ++ui;
        if constexpr (has_preload<Epi>::value) E.preload(cur, wr, fr, pre);
        if constexpr (ALIGN_EPI) { if (wr == 1) PG8_BAR; }
    }
    PG8_WAIT_V(0);
    if constexpr (!ALIGN_EPI) { if (wr == 0) PG8_BAR; }
    PG8_BAR;
    if constexpr (Epi::AFTER_DRAIN) { E.fused(acc, cur, wr, wc, fr, fq, lds, wid, lane); S.done(cur); }
#undef PG8_SA
#undef PG8_SB
#undef PG8_STAGE
#undef PG8_LDA
#undef PG8_LDB
#undef PG8_MMA
#undef PG8_WAIT_V
#undef PG8_WAIT_L
#undef PG8_BAR
#undef PG8_SCHED
}
}
namespace att {
#define ALAS __attribute__((address_space(3)))
typedef unsigned short bf16;
typedef short bf16x8 __attribute__((ext_vector_type(8)));
typedef short s16x4 __attribute__((ext_vector_type(4)));
typedef float f32x16 __attribute__((ext_vector_type(16)));
typedef float f32x4 __attribute__((ext_vector_type(4)));
typedef unsigned u32x4 __attribute__((ext_vector_type(4)));
typedef unsigned u32x2 __attribute__((ext_vector_type(2)));
typedef float f32x2_t __attribute__((ext_vector_type(2))); typedef __bf16 bf16x2_t __attribute__((ext_vector_type(2)));
constexpr int SEQ = 2048, NB = 4, NH = 8, HD = 128, ROWP = 1024;
constexpr int OFF_K = 0, OFF_V = 32768, OFF_NEGF = 65536, OFF_BIAS = 65536 + 8192, OFF_MISC = OFF_BIAS + 2304;
constexpr float LOG2E = 1.4426950408889634f;
__device__ __forceinline__ unsigned off_b(unsigned row, unsigned ch) { return 256u * row + 16u * (ch ^ (((row & 3u) << 2) | ((row >> 2) & 3u))); }
__device__ __forceinline__ unsigned cvtpk_s(float lo, float hi) { f32x2_t v = {lo, hi}; bf16x2_t b = __builtin_convertvector(v, bf16x2_t); return __builtin_bit_cast(unsigned, b); }
__device__ __forceinline__ float fadd_s(float x, float y) { float r = x + y; asm("" : "+v"(r)); return r; }
__device__ __forceinline__ float fsub_s(float x, float y) { float r = x - y; asm("" : "+v"(r)); return r; }
__device__ __forceinline__ float fmul_s(float x, float y) { float r = x * y; asm("" : "+v"(r)); return r; }
__device__ __forceinline__ s16x4 vtr(ALAS const unsigned char* p) { return __builtin_bit_cast(s16x4, __builtin_amdgcn_ds_read_tr16_b64_v4i16((ALAS s16x4*)p)); }

struct TileRegs { u32x4 k[2], v[2]; };
__device__ __forceinline__ void tile_gload(TileRegs& R, const bf16* Kg, const bf16* Vg, int tok0, int tid) {
#pragma unroll
    for (int i = 0; i < 2; ++i) { const int id = tid + 512 * i, row = id >> 4, ch = id & 15; const size_t o = (size_t)(tok0 + row) * ROWP + ch * 8;
        R.k[i] = *(const u32x4*)(Kg + o); R.v[i] = *(const u32x4*)(Vg + o); }
}
__device__ __forceinline__ void tile_lstore(const TileRegs& R, ALAS unsigned char* kbuf, ALAS unsigned char* vbuf, int tid) {
#pragma unroll
    for (int i = 0; i < 2; ++i) { const int id = tid + 512 * i, row = id >> 4, ch = id & 15; const unsigned o = off_b(row, ch);
        *(ALAS u32x4*)(kbuf + o) = R.k[i]; *(ALAS u32x4*)(vbuf + o) = R.v[i]; }
}

template <int MODE>
__device__ __forceinline__ void tile_compute(f32x16 (&o)[4], float& m_run, float& l_run, const bf16x8 (&qf)[8], ALAS const unsigned char* lds, ALAS const unsigned char* kbuf, ALAS const unsigned char* vbuf,
                                             int lane, int rel0  , bool cst  , int key0  , bool diag, int tloc  ) {
    const int r = lane & 31, h = lane >> 5;
    const int kap = (r & 0x13) | ((r & 4) << 1) | ((r & 8) >> 1);
    f32x16 s[2];
    if (MODE == 1) {
        ALAS const float* nf = (ALAS const float*)(lds + OFF_NEGF) + key0;
#pragma unroll
        for (int kb = 0; kb < 2; ++kb)
#pragma unroll
            for (int g = 0; g < 4; ++g) { const f32x4 f = *(ALAS const f32x4*)(nf + 32 * kb + 4 * (g & 1) + 16 * (g >> 1));
#pragma unroll
                for (int e = 0; e < 4; ++e) s[kb][4 * g + e] = f[e]; }
    } else {
        const float c = cst ? ((ALAS const float*)(lds + OFF_BIAS))[512] : 0.f;
#pragma unroll
        for (int i = 0; i < 16; ++i) { s[0][i] = c; s[1][i] = c; }
    }
#pragma unroll
    for (int ks = 0; ks < 8; ++ks) {
        const bf16x8 k0 = *(ALAS const bf16x8*)(kbuf + off_b(kap, 2 * ks + h));
        const bf16x8 k1 = *(ALAS const bf16x8*)(kbuf + 8192 + off_b(kap, 2 * ks + h));
        s[0] = __builtin_amdgcn_mfma_f32_32x32x16_bf16(k0, qf[ks], s[0], 0, 0, 0);
        s[1] = __builtin_amdgcn_mfma_f32_32x32x16_bf16(k1, qf[ks], s[1], 0, 0, 0);
    }
    if (MODE == 0) {
        if (!cst) { ALAS const float* bt = (ALAS const float*)(lds + OFF_BIAS);
#pragma unroll
            for (int kb = 0; kb < 2; ++kb)
#pragma unroll
                for (int i = 0; i < 16; ++i) { int rel = rel0 - 32 * kb - (i & 7) - 16 * (i >> 3); rel = rel < 256 ? rel : 256; rel = rel > -256 ? rel : -256; s[kb][i] = fadd_s(s[kb][i], bt[rel + 256]); }
        }
    } else if (diag) {
#pragma unroll
        for (int kb = 0; kb < 2; ++kb)
#pragma unroll
            for (int i = 0; i < 16; ++i) if (32 * kb + (i & 7) + 16 * (i >> 3) > tloc) s[kb][i] = -INFINITY;
    }
    float mx = s[0][0];
#pragma unroll
    for (int i = 1; i < 16; ++i) mx = fmaxf(mx, s[0][i]);
#pragma unroll
    for (int i = 0; i < 16; ++i) mx = fmaxf(mx, s[1][i]);
    { auto rr = __builtin_amdgcn_permlane32_swap(__float_as_uint(mx), __float_as_uint(mx), false, false); mx = fmaxf(__uint_as_float(rr[0]), __uint_as_float(rr[1])); }
    constexpr float RESC_THR = 10.0f;
    if (__builtin_amdgcn_ballot_w64(mx > m_run + RESC_THR) != 0ull) {
        const float m_new = fmaxf(m_run, mx), alpha = __builtin_amdgcn_exp2f(m_run - m_new);
        m_run = m_new; l_run *= alpha;
#pragma unroll
        for (int c = 0; c < 4; ++c)
#pragma unroll
            for (int i = 0; i < 16; ++i) o[c][i] = fmul_s(o[c][i], alpha);
    }
    float ps = 0.f;
#pragma unroll
    for (int kb = 0; kb < 2; ++kb)
#pragma unroll
        for (int i = 0; i < 16; ++i) { const float p = __builtin_amdgcn_exp2f(fsub_s(s[kb][i], m_run)); s[kb][i] = p; ps = fadd_s(ps, p); }
    l_run += ps;
    bf16x8 pf[4];
#pragma unroll
    for (int ks = 0; ks < 4; ++ks) { const int kb = ks >> 1, b8 = 8 * (ks & 1); u32x4 w;
        w.x = cvtpk_s(s[kb][b8 + 0], s[kb][b8 + 1]); w.y = cvtpk_s(s[kb][b8 + 2], s[kb][b8 + 3]); w.z = cvtpk_s(s[kb][b8 + 4], s[kb][b8 + 5]); w.w = cvtpk_s(s[kb][b8 + 6], s[kb][b8 + 7]);
        pf[ks] = __builtin_bit_cast(bf16x8, w); }
    const unsigned blk = (lane >> 4) & 1, q4 = (lane & 15) >> 2, p4 = lane & 3;
#pragma unroll
    for (int c = 0; c < 4; ++c)
#pragma unroll
        for (int ks = 0; ks < 4; ++ks) {
            ALAS const unsigned char* a0 = vbuf + off_b(16 * ks + 8 * h + q4, 4 * c + 2 * blk + (p4 >> 1)) + 8 * (p4 & 1);
            ALAS const unsigned char* a1 = vbuf + off_b(16 * ks + 8 * h + 4 + q4, 4 * c + 2 * blk + (p4 >> 1)) + 8 * (p4 & 1);
            const s16x4 lo = vtr(a0), hi = vtr(a1);
            const bf16x8 vf = (bf16x8){lo[0], lo[1], lo[2], lo[3], hi[0], hi[1], hi[2], hi[3]};
            o[c] = __builtin_amdgcn_mfma_f32_32x32x16_bf16(vf, pf[ks], o[c], 0, 0, 0);
        }
}

struct Tensors { const bf16* q; const bf16* k; const bf16* v; bf16* o; const float* lf; const float* rel_bias; };

template <int MODE>
__device__ __forceinline__ void attn_item(ALAS unsigned char* lds, const Tensors& T, int b, int hd, int blk) {
    int tid_l = threadIdx.x; asm volatile("" : "+v"(tid_l));
    const int tid = tid_l, lane = tid & 63, w = __builtin_amdgcn_readfirstlane(tid >> 6), r = lane & 31, h = lane >> 5;
    if (MODE == 0) {
        ALAS float* bt = (ALAS float*)(lds + OFF_BIAS);
        for (int i = tid; i < 513; i += 512) bt[i] = T.rel_bias[hd * 513 + i] * LOG2E;
    } else {
        ALAS float* negF = (ALAS float*)(lds + OFF_NEGF); ALAS float* wsum = (ALAS float*)(lds + OFF_MISC + 64);
        float v[4];
#pragma unroll
        for (int e = 0; e < 4; ++e) v[e] = T.lf[((size_t)(b * SEQ + 4 * tid + e)) * 8 + hd];
        v[1] += v[0]; v[2] += v[1]; v[3] += v[2];
        const float tot = v[3]; float x = tot;
#pragma unroll
        for (int o_ = 1; o_ < 64; o_ <<= 1) { const float y = __shfl_up(x, o_); if (lane >= o_) x += y; }
        if (lane == 63) wsum[w] = x;
        __syncthreads();
        float offs = x - tot;
        for (int j = 0; j < w; ++j) offs += wsum[j];
#pragma unroll
        for (int e = 0; e < 4; ++e) negF[4 * tid + e] = -(v[e] + offs) * LOG2E;
    }
    const int qt = 4 * blk + (w >> 1);
    const int t_lo = (MODE == 0) ? (4 * blk - 8 > 0 ? 4 * blk - 8 : 0) : 0, t_hi = 4 * blk + 3;
    const int w_lo = (MODE == 0) ? qt - 8 : 0, w_hi = qt;
    const int tokq = b * SEQ + 64 * qt + 32 * (w & 1) + r;
    bf16x8 qf[8];
#pragma unroll
    for (int ks = 0; ks < 8; ++ks) qf[ks] = *(const bf16x8*)(T.q + (size_t)tokq * ROWP + hd * HD + 16 * ks + 8 * h);
    f32x16 o[4];
#pragma unroll
    for (int c = 0; c < 4; ++c)
#pragma unroll
        for (int i = 0; i < 16; ++i) o[c][i] = 0.f;
    float m_run = -1e30f, l_run = 0.f;
    const bf16* Kg = T.k + hd * HD; const bf16* Vg = T.v + hd * HD;
    TileRegs R;
    tile_gload(R, Kg, Vg, b * SEQ + 64 * t_lo, tid);
    tile_lstore(R, lds + OFF_K, lds + OFF_V, tid);
    __syncthreads();
    int cur = 0;
    for (int t = t_lo; t <= t_hi; ++t) {
        const bool more = t < t_hi;
        if (more) tile_gload(R, Kg, Vg, b * SEQ + 64 * (t + 1), tid);
        if (t >= w_lo && t <= w_hi) {
            const int tq = 64 * qt + 32 * (w & 1) + r;
            tile_compute<MODE>(o, m_run, l_run, qf, lds, lds + OFF_K + cur * 16384, lds + OFF_V + cur * 16384, lane,
                               tq - 64 * t - 8 * h, (qt - t) >= 5, 64 * t + 8 * h, t == qt, tq - 64 * t - 8 * h);
        }
        if (more) tile_lstore(R, lds + OFF_K + (cur ^ 1) * 16384, lds + OFF_V + (cur ^ 1) * 16384, tid);
        __syncthreads();
        cur ^= 1;
    }
    float l_tot = l_run; { auto rr = __builtin_amdgcn_permlane32_swap(__float_as_uint(l_run), __float_as_uint(l_run), false, false); l_tot = __uint_as_float(rr[0]) + __uint_as_float(rr[1]); }
    const float inv = 1.0f / l_tot;
    ALAS unsigned char* stg = lds + w * 8704;
#pragma unroll
    for (int c = 0; c < 4; ++c)
#pragma unroll
        for (int g = 0; g < 4; ++g) { u32x2 wv; wv.x = cvtpk_s(o[c][4 * g] * inv, o[c][4 * g + 1] * inv); wv.y = cvtpk_s(o[c][4 * g + 2] * inv, o[c][4 * g + 3] * inv);
            *(ALAS u32x2*)(stg + r * 272 + (32 * c + 8 * g + 4 * h) * 2) = wv; }
    asm volatile("s_waitcnt lgkmcnt(0)" ::: "memory");
    const int tok0 = b * SEQ + 64 * qt + 32 * (w & 1);
#pragma unroll
    for (int j = 0; j < 8; ++j) { const int row = (lane >> 4) + 4 * j, ch = lane & 15;
        const u32x4 v = *(ALAS const u32x4*)(stg + row * 272 + ch * 16);
        *(u32x4*)(T.o + (size_t)(tok0 + row) * 2048 + hd * HD + ch * 8) = v; }
}
}
typedef unsigned short bf16;
typedef float f32x4 __attribute__((ext_vector_type(4)));
typedef unsigned v4u __attribute__((ext_vector_type(4)));
typedef unsigned v2u __attribute__((ext_vector_type(2)));
constexpr int NWAVES = 8, NTHR = 512;
constexpr int M = 8192, D = 2048, FF = 5632, NGU = 2 * FF, DIN = 6152, NQKV = 6144, DPLE = 256, SEQ = 2048, NHB = 8;
constexpr size_t MiB = 1u << 20;
constexpr size_t WS_CTL = 0;
constexpr size_t CTL_CNT = 0;
constexpr size_t CTL_SS = 4096;
constexpr size_t CTL_LF = CTL_SS + 5 * (size_t)M * 4;
constexpr size_t CTL_WF = CTL_LF + (size_t)M * 8 * 4;
static_assert(CTL_WF + 8 * (size_t)D * 4 <= MiB, "control region");
constexpr size_t WS_WGU1 = 1 * MiB, WS_WD1 = WS_WGU1 + 44 * MiB, WS_WIN = WS_WD1 + 22 * MiB, WS_WOUT = WS_WIN + 24 * MiB, WS_WGU2 = WS_WOUT + 8 * MiB,
                 WS_WD2 = WS_WGU2 + 44 * MiB, WS_WG = WS_WD2 + 22 * MiB, WS_WP = WS_WG + 8 * MiB, WS_PB = WS_WP + 1 * MiB  , WS_AB = WS_PB + 4 * MiB  ,
                 WS_R1 = WS_AB + 32 * MiB  , WS_H = WS_R1 + 128 * MiB  , WS_END = WS_H + 64 * MiB;
constexpr size_t QKV_T = (size_t)M * 1024;
constexpr int LDS_BYTES = 147456;

__device__ __forceinline__ unsigned f2bf(float f) { unsigned u = __builtin_bit_cast(unsigned, f); return (u + 0x7fffu + ((u >> 16) & 1u)) >> 16; }
__device__ __forceinline__ unsigned pk2(float lo, float hi) { typedef float f2_t __attribute__((ext_vector_type(2))); typedef __bf16 b2_t __attribute__((ext_vector_type(2))); f2_t v = {lo, hi}; b2_t b = __builtin_convertvector(v, b2_t); return __builtin_bit_cast(unsigned, b); }
__device__ __forceinline__ float wave_sum(float v) {
#pragma unroll
    for (int o = 1; o < 64; o <<= 1) v += __shfl_xor(v, o);
    return v;
}
struct ConvRegs { f32x4 v[16]; };
constexpr int LDS_G = 8 * 16896;
__device__ __forceinline__ void conv_load(ConvRegs& R, const float* __restrict__ W, int ldw, int k0, int n0, int lane) {
#pragma unroll
    for (int it = 0; it < 8; ++it) { const int kk = 8 * it + (lane >> 3); const float* src = W + (size_t)(k0 + kk) * ldw + n0 + 4 * (lane & 7);
        R.v[it] = __builtin_nontemporal_load((const f32x4*)src); R.v[8 + it] = __builtin_nontemporal_load((const f32x4*)(src + 32)); }
}
template <bool HAS_G, bool TILED> __device__ __forceinline__ void conv_store(const ConvRegs& R, const LAS float* gl, bf16* WT, int K, int k0, int drowA, int drowB, LAS float* scr, int lane) {
#pragma unroll
    for (int it = 0; it < 8; ++it) { const int kk = 8 * it + (lane >> 3); const float gg = HAS_G ? gl[k0 + kk] : 1.0f; LAS float* s = scr + kk * 33 + 4 * (lane & 7);
        s[0] = R.v[it][0] * gg; s[1] = R.v[it][1] * gg; s[2] = R.v[it][2] * gg; s[3] = R.v[it][3] * gg;
        s[2112 + 0] = R.v[8 + it][0] * gg; s[2112 + 1] = R.v[8 + it][1] * gg; s[2112 + 2] = R.v[8 + it][2] * gg; s[2112 + 3] = R.v[8 + it][3] * gg; }
    asm volatile("s_waitcnt lgkmcnt(0)" ::: "memory");
    const int c = lane & 7;
#pragma unroll
    for (int hf = 0; hf < 2; ++hf)
#pragma unroll
        for (int j = 0; j < 4; ++j) { const int n = (lane >> 3) + 8 * j; const LAS float* s = scr + hf * 2112 + (8 * c) * 33 + n;
            v4u o; o.x = pk2(s[0 * 33], s[1 * 33]); o.y = pk2(s[2 * 33], s[3 * 33]); o.z = pk2(s[4 * 33], s[5 * 33]); o.w = pk2(s[6 * 33], s[7 * 33]);
            const int row = (hf ? drowB : drowA) + n;
            if (TILED) *(v4u*)(WT + ((size_t)(row >> 8) * (K >> 6) + (k0 >> 6)) * 16384 + (size_t)(row & 255) * 64 + 8 * c) = o;
            else *(v4u*)(WT + (size_t)row * K + k0 + 8 * c) = o; }
    asm volatile("s_waitcnt lgkmcnt(0)" ::: "memory");
}
__device__ __forceinline__ int gu_row(int n0) { const int hi = n0 >= FF, n = n0 - (hi ? FF : 0); return 256 * (n >> 7) + (n & 127) + 128 * hi; }
template <bool HAS_G, bool gu, bool PIPE, bool TILED = false> __device__ __forceinline__ void conv_matrix(const float* W, int ldw, const float* g, bf16* WT, int K, int ncols, int wv, int nwv, LAS float* scr, int lane, LAS unsigned char* lds) {
    const LAS float* gl = (const LAS float*)(lds + LDS_G);
    if (HAS_G) { __syncthreads(); for (int i = threadIdx.x; i < K; i += NTHR) ((LAS float*)(lds + LDS_G))[i] = g[i]; __syncthreads(); }
    const int nb = ncols / 64, total = (K / 64) * nb, last = total - 1;
    ConvRegs RA, RB;
    int it = wv;
    if (!PIPE) {
        if (it < total) conv_load(RA, W, ldw, 64 * (it / nb), 64 * (it % nb), lane);
        while (it < total) {
            const int itB = it + nwv, itA2 = itB + nwv;
            if (itB < total) conv_load(RB, W, ldw, 64 * (itB / nb), 64 * (itB % nb), lane);
            { const int n0 = 64 * (it % nb); conv_store<HAS_G, TILED>(RA, gl, WT, K, 64 * (it / nb), gu ? gu_row(n0) : n0, gu ? gu_row(n0 + 32) : n0 + 32, scr, lane); }
            if (itA2 < total) conv_load(RA, W, ldw, 64 * (itA2 / nb), 64 * (itA2 % nb), lane);
            if (itB < total) { const int n0 = 64 * (itB % nb); conv_store<HAS_G, TILED>(RB, gl, WT, K, 64 * (itB / nb), gu ? gu_row(n0) : n0, gu ? gu_row(n0 + 32) : n0 + 32, scr, lane); }
            it = itA2;
        }
        return;
    }
    if (it >= total) return;
    conv_load(RA, W, ldw, 64 * (it / nb), 64 * (it % nb), lane);
    while (it < total) {
        const int itB = (it + nwv < last) ? it + nwv : last, itA2 = (it + 2 * nwv < last) ? it + 2 * nwv : last;
        conv_load(RB, W, ldw, 64 * (itB / nb), 64 * (itB % nb), lane);
        { const int n0 = 64 * (it % nb); conv_store<HAS_G, TILED>(RA, gl, WT, K, 64 * (it / nb), gu ? gu_row(n0) : n0, gu ? gu_row(n0 + 32) : n0 + 32, scr, lane); }
        conv_load(RA, W, ldw, 64 * (itA2 / nb), 64 * (itA2 % nb), lane);
        { const int n0 = 64 * (itB % nb); conv_store<HAS_G, TILED>(RB, gl, WT, K, 64 * (itB / nb), gu ? gu_row(n0) : n0, gu ? gu_row(n0 + 32) : n0 + 32, scr, lane); }
        it += 2 * nwv;
    }
}


constexpr size_t CTL_BAR = 512 * 1024;
static_assert(CTL_WF + 8 * (size_t)D * 4 <= CTL_BAR && CTL_BAR + XCD_BAR_WORDS * 4 <= MiB, "control region");
constexpr size_t CTL_PCNT = CTL_BAR + 16384;
static_assert(CTL_PCNT + 32 * 256 <= MiB, "control region");
constexpr int LDS_XB = LDS_BYTES - 64;
#ifndef USE_TILED
#define USE_TILED false
#endif
#ifndef PHMASK
#define PHMASK 0x3ff
#endif
#define PH_ON(k) (((PHMASK) >> (k)) & 1)
struct Args { const float* in[17]; float* out; unsigned char* ws; };
typedef const __attribute__((address_space(4))) unsigned char* kargp_t;
__device__ __forceinline__ unsigned long long karg64(int i) { kargp_t p = (kargp_t)__builtin_amdgcn_kernarg_segment_ptr(); asm volatile("" : "+s"(p)); return *(const __attribute__((address_space(4))) unsigned long long*)(p + 8 * i); }
#define GAS1 __attribute__((address_space(1)))
#define ARG_IN(i) ((const float*)(const GAS1 float*)karg64(i))
#define ARG_OUT ((float*)(GAS1 float*)karg64(17))
#define ARG_WS ((unsigned char*)(GAS1 unsigned char*)karg64(18))

__global__ void __launch_bounds__(NTHR, 2) fwd_kernel(Args a) {
    extern __shared__ __attribute__((aligned(16))) unsigned char lds_raw[];
    LAS unsigned char* lds = (LAS unsigned char*)lds_raw;
    cg::grid_group grid = cg::this_grid();
    const int G = gridDim.x, bx = blockIdx.x, NGW = G * NWAVES;
    const int G1 = (G == 256) ? 235 : G - (G / 12 > 0 ? G / 12 : 1);
    if (threadIdx.x == 0) { ((volatile LAS unsigned*)(lds + LDS_XB))[0] = 0u; ((volatile LAS unsigned*)(lds + LDS_XB))[1] = 0u; }
    const XcdBarrier xbar = xcd_barrier_post((unsigned*)(ARG_WS + CTL_BAR), (volatile LAS unsigned*)(lds + LDS_XB));
#define TID_DECL int tid_l = threadIdx.x; asm volatile("" : "+v"(tid_l)); const int tid = tid_l, lane = tid & 63, wave = __builtin_amdgcn_readfirstlane(tid >> 6), gw = bx * NWAVES + wave; (void)lane; (void)gw;
#define P_SS(i) ((float*)(ws + CTL_SS) + (size_t)(i) * M)
#define P_LF ((float*)(ws + CTL_LF))
#define P_WF ((float*)(ws + CTL_WF))
#define P_CNT ((unsigned*)(ws + CTL_CNT))
#define P_BF(off) ((bf16*)(ws + (off)))
#define P_ACT P_BF(WS_R1)
#define P_QKV P_BF(WS_R1)
#define P_OB P_BF(WS_R1 + 96 * MiB)
#define P_AB P_BF(WS_AB)
#define P_H ((float*)(ws + WS_H))

    {
    if constexpr (PH_ON(0)) {
        unsigned char* const ws = ARG_WS;
        TID_DECL
        LAS float* scr = (LAS float*)(lds + wave * 16896);
        conv_matrix<true, true, false>(ARG_IN(3), NGU, ARG_IN(2), P_BF(WS_WGU1), D, NGU, gw, NGW, scr, lane, lds);
        for (int m = gw; m < M; m += 2 * NGW) {
            const int m2 = (m + NGW < M) ? m + NGW : m;
            const f32x4* xa = (const f32x4*)(ARG_IN(0) + (size_t)m * D) + lane; const f32x4* xb_ = (const f32x4*)(ARG_IN(0) + (size_t)m2 * D) + lane; f32x4 va[8], vb[8];
#pragma unroll
            for (int j = 0; j < 8; ++j) va[j] = __builtin_nontemporal_load(xa + 64 * j);
#pragma unroll
            for (int j = 0; j < 8; ++j) vb[j] = __builtin_nontemporal_load(xb_ + 64 * j);
            float sa = 0.f, sb = 0.f;
#pragma unroll
            for (int j = 0; j < 8; ++j) { sa += (va[j][0] * va[j][0] + va[j][1] * va[j][1]) + (va[j][2] * va[j][2] + va[j][3] * va[j][3]); sb += (vb[j][0] * vb[j][0] + vb[j][1] * vb[j][1]) + (vb[j][2] * vb[j][2] + vb[j][3] * vb[j][3]); }
            sa = wave_sum(sa); sb = wave_sum(sb); if (lane == 0) { P_SS(0)[m] = sa; P_SS(0)[m2] = sb; }
            v2u* oa = (v2u*)(P_AB + (size_t)m * D) + lane; v2u* ob_ = (v2u*)(P_AB + (size_t)m2 * D) + lane;
#pragma unroll
            for (int j = 0; j < 8; ++j) { v2u o; o.x = pk2(va[j][0], va[j][1]); o.y = pk2(va[j][2], va[j][3]); oa[64 * j] = o; }
#pragma unroll
            for (int j = 0; j < 8; ++j) { v2u o; o.x = pk2(vb[j][0], vb[j][1]); o.y = pk2(vb[j][2], vb[j][3]); ob_[64 * j] = o; }
        }
        for (int i = bx * NTHR + tid; i < M * DPLE / 4; i += G * NTHR) { const f32x4 v = ((const f32x4*)ARG_IN(1))[i]; v2u o; o.x = pk2(v[0], v[1]); o.y = pk2(v[2], v[3]); ((v2u*)P_BF(WS_PB))[i] = o; }
        for (int i = bx * NTHR + tid; i < 4 * M; i += G * NTHR) P_SS(1)[i] = 0.f;
        if (bx == 0 && tid == 0) { P_CNT[0] = 0u; P_CNT[64] = 0u; }
        if (bx == 1) for (int i = tid; i < 32 * 64; i += NTHR) ((unsigned*)(ws + CTL_PCNT))[i] = 0u;
        for (int i = bx * NTHR + tid; i < 8 * D; i += G * NTHR) { const int j = i / D, k = i % D; P_WF[i] = ARG_IN(5)[k] * ARG_IN(6)[(size_t)k * DIN + NQKV + j]; }
    }
    }
    if (ARG_WS == nullptr) grid.sync();
    xcd_barrier(xbar);

    {
    if constexpr (PH_ON(1)) {
        unsigned char* const ws = ARG_WS;
        if (bx < G1) { pg8::Gemm g{P_AB, P_BF(WS_WGU1), M, NGU, D}; pg8::StaticOrder S; S.init(M, NGU, G1, bx);
          pg8::EpiSwiglu E{P_ACT, P_SS(0)};
          pg8::gemm_phase<pg8::EpiSwiglu, pg8::StaticOrder, true, true>(lds, g, S, E); }
        else {
            TID_DECL
            LAS float* scr = (LAS float*)(lds + wave * 16896); const int wv = (bx - G1) * NWAVES + wave, nwv = (G - G1) * NWAVES;
            conv_matrix<false, false, true, USE_TILED>(ARG_IN(4), D, nullptr, P_BF(WS_WD1), FF, D, wv, nwv, scr, lane, lds);
            conv_matrix<false, false, true>(ARG_IN(15), D, nullptr, P_BF(WS_WP), DPLE, D, wv, nwv, scr, lane, lds);
            conv_matrix<true, false, true>(ARG_IN(6), DIN, ARG_IN(5), P_BF(WS_WIN), D, NQKV, wv, nwv, scr, lane, lds);
            conv_matrix<false, false, true>(ARG_IN(9), D, nullptr, P_BF(WS_WOUT), D, D, wv, nwv, scr, lane, lds);
        }
    }
    }
    xcd_barrier(xbar);
    if constexpr (PH_ON(2)) {
        unsigned char* const ws = ARG_WS;
        pg8::Gemm g{P_ACT, P_BF(WS_WD1), M, D, FF}; pg8::StaticOrder S; S.init(M, D, G, bx);
        pg8::EpiResid<true> E{nullptr, P_AB, P_SS(1), 0.5f, xbar};
        pg8::gemm_phase<pg8::EpiResid<true>, pg8::StaticOrder, false, true, USE_TILED>(lds, g, S, E);
    }
    {
    if constexpr (PH_ON(3)) {
        unsigned char* const ws = ARG_WS;
        TID_DECL
        pg8::Gemm g{P_AB, P_BF(WS_WIN), M, NQKV, D}; pg8::StaticOrder S; S.init(M, NQKV, G, bx);
        pg8::EpiQKV E{P_QKV, P_SS(1), 0.08838834764831845f * 1.4426950408889634f, QKV_T};
        pg8::gemm_phase<pg8::EpiQKV, pg8::StaticOrder, true, true>(lds, g, S, E);
        for (int m = gw; m < M; m += 2 * NGW) {
            const int m2 = (m + NGW < M) ? m + NGW : m;
            const v2u* hra = (const v2u*)(P_AB + (size_t)m * D) + lane; const v2u* hrb = (const v2u*)(P_AB + (size_t)m2 * D) + lane; f32x4 va[8], vb[8];
#pragma unroll
            for (int j = 0; j < 8; ++j) { const v2u w = hra[64 * j]; va[j] = (f32x4){__uint_as_float(w.x << 16), __uint_as_float(w.x & 0xffff0000u), __uint_as_float(w.y << 16), __uint_as_float(w.y & 0xffff0000u)}; }
#pragma unroll
            for (int j = 0; j < 8; ++j) { const v2u w = hrb[64 * j]; vb[j] = (f32x4){__uint_as_float(w.x << 16), __uint_as_float(w.x & 0xffff0000u), __uint_as_float(w.y << 16), __uint_as_float(w.y & 0xffff0000u)}; }
            float sa[8], sb[8];
#pragma unroll
            for (int jj = 0; jj < 8; ++jj) { const f32x4* wr_ = (const f32x4*)(P_WF + (size_t)jj * D) + lane; float a = 0.f, b = 0.f;
#pragma unroll
                for (int j = 0; j < 8; ++j) { const f32x4 wv = wr_[64 * j];
                    a += (va[j][0] * wv[0] + va[j][1] * wv[1]) + (va[j][2] * wv[2] + va[j][3] * wv[3]); b += (vb[j][0] * wv[0] + vb[j][1] * wv[1]) + (vb[j][2] * wv[2] + vb[j][3] * wv[3]); }
                sa[jj] = a; sb[jj] = b; }
            const bool u5 = lane >= 32, u4 = (lane >> 4) & 1, u3 = (lane >> 3) & 1;
#define FRED(s, out) { float b4[4], c2[2]; _Pragma("unroll") for (int k = 0; k < 4; ++k) { const float snd = u5 ? s[k] : s[k + 4]; b4[k] = (u5 ? s[k + 4] : s[k]) + __shfl_xor(snd, 32); } \
                _Pragma("unroll") for (int k = 0; k < 2; ++k) { const float snd = u4 ? b4[k] : b4[k + 2]; c2[k] = (u4 ? b4[k + 2] : b4[k]) + __shfl_xor(snd, 16); } \
                { const float snd = u3 ? c2[0] : c2[1]; out = (u3 ? c2[1] : c2[0]) + __shfl_xor(snd, 8); } out += __shfl_xor(out, 4); out += __shfl_xor(out, 2); out += __shfl_xor(out, 1); }
            float da, db; FRED(sa, da) FRED(sb, db)
#undef FRED
            if ((lane & 7) == 0) { const int jj = lane >> 3; const float bf = ARG_IN(7)[jj];
                const float za = da * pg8::rs_of(P_SS(1), m) + bf, zb = db * pg8::rs_of(P_SS(1), m2) + bf;
                P_LF[(size_t)m * 8 + jj] = fminf(za, 0.f) - log1pf(__expf(-fabsf(za))); P_LF[(size_t)m2 * 8 + jj] = fminf(zb, 0.f) - log1pf(__expf(-fabsf(zb))); }
        }
    }
    xcd_barrier(xbar);
    }
    if constexpr (PH_ON(4)) {
        unsigned char* const ws = ARG_WS;
        TID_DECL
        const int GA = G - 56;
        if (bx >= GA) {
            LAS float* scr = (LAS float*)(lds + wave * 16896); const int wv = (bx - GA) * NWAVES + wave, nwv = (G - GA) * NWAVES;
            conv_matrix<true, true, true>(ARG_IN(11), NGU, ARG_IN(10), P_BF(WS_WGU2), D, NGU, wv, nwv, scr, lane, lds);
            __syncthreads();
        }
        {
        LAS unsigned* slot = (LAS unsigned*)(lds + att::OFF_MISC);
        att::Tensors TA{P_QKV, P_QKV + QKV_T, P_QKV + 2 * QKV_T, P_OB, P_LF, ARG_IN(8)};
        att::Tensors TB{P_QKV + 3 * QKV_T, P_QKV + 4 * QKV_T, P_QKV + 5 * QKV_T, P_OB + 1024, P_LF, ARG_IN(8)};
        { const int rep = 0;
        for (;;) {
            if (tid == 0) slot[0] = atomicAdd(P_CNT + 64 * rep, 1u);
            __syncthreads();
            const int item = (int)slot[0];
            __syncthreads();
            if (item >= 512) break;
            int mode, blk_, bh;
            bh = item % 32; { const int grp = item / 32;
              if (grp < 5) { mode = 1; blk_ = 7 - grp; }
              else if (grp < 11) { mode = 0; blk_ = 12 - grp; }
              else if (grp == 11) { mode = 1; blk_ = 2; }
              else if (grp == 12) { mode = 0; blk_ = 1; }
              else if (grp == 13) { mode = 1; blk_ = 1; }
              else if (grp == 14) { mode = 0; blk_ = 0; }
              else { mode = 1; blk_ = 0; } }
            if (mode) att::attn_item<1>(lds, TB, bh >> 3, bh & 7, blk_); else att::attn_item<0>(lds, TA, bh >> 3, bh & 7, blk_);
        }
        }
        }
    }
    xcd_barrier(xbar);
    if constexpr (PH_ON(5)) {
        unsigned char* const ws = ARG_WS;
        pg8::Gemm g{P_OB, P_BF(WS_WOUT), M, D, D}; pg8::StaticOrder S; S.init(M, D, G, bx);
        pg8::EpiResid<true> E{nullptr, P_AB, P_SS(2), 1.0f, xbar};
        pg8::gemm_phase<pg8::EpiResid<true>, pg8::StaticOrder, false, true>(lds, g, S, E);
    }
    {
    if constexpr (PH_ON(6)) {
        unsigned char* const ws = ARG_WS;
        if (bx < G1) { pg8::Gemm g{P_AB, P_BF(WS_WGU2), M, NGU, D}; pg8::StaticOrder S; S.init(M, NGU, G1, bx);
          pg8::EpiSwiglu E{P_ACT, P_SS(2)};
          pg8::gemm_phase<pg8::EpiSwiglu, pg8::StaticOrder, true, true>(lds, g, S, E); }
        else {
            { int Kpp = DPLE; asm volatile("" : "+s"(Kpp));
              pg8::Gemm g2{P_BF(WS_PB), P_BF(WS_WP), M, D, Kpp}; pg8::StaticOrder S2; S2.init(M, D, G - G1, bx - G1); pg8::EpiBf16Plain E2{P_OB};
              pg8::gemm_phase<pg8::EpiBf16Plain, pg8::StaticOrder, true, true>(lds, g2, S2, E2); }
            TID_DECL
            LAS float* scr = (LAS float*)(lds + wave * 16896); const int wv = (bx - G1) * NWAVES + wave, nwv = (G - G1) * NWAVES;
            conv_matrix<false, false, true, USE_TILED>(ARG_IN(12), D, nullptr, P_BF(WS_WD2), FF, D, wv, nwv, scr, lane, lds);
            conv_matrix<true, false, true>(ARG_IN(14), D, ARG_IN(13), P_BF(WS_WG), D, D, wv, nwv, scr, lane, lds);
        }
    }
    xcd_barrier(xbar);
    }
    if constexpr (PH_ON(7)) {
        unsigned char* const ws = ARG_WS;
        pg8::Gemm g{P_ACT, P_BF(WS_WD2), M, D, FF}; pg8::StaticOrder S; S.init(M, D, G, bx);
        pg8::EpiResid<true> E{nullptr, P_AB, P_SS(3), 0.5f, xbar};
        pg8::gemm_phase<pg8::EpiResid<true>, pg8::StaticOrder, false, true, USE_TILED>(lds, g, S, E);
    }
    if constexpr (PH_ON(8)) {
        unsigned char* const ws = ARG_WS;
        pg8::Gemm g{P_AB, P_BF(WS_WG), M, D, D}; pg8::StaticOrder S; S.init(M, D, G, bx);
        pg8::EpiPleNorm E{P_AB, ARG_OUT, P_SS(3), P_SS(4), ARG_IN(16), (unsigned*)(ws + CTL_PCNT), P_OB};
        pg8::gemm_phase<pg8::EpiPleNorm, pg8::StaticOrder, false, true>(lds, g, S, E);
    }
}

extern "C" void kernel_launch(void* const* d_in, const int* in_sizes, int n_in, void* d_out, int out_size, void* d_ws, size_t ws_size, hipStream_t stream) {
    static int grid = 0;
    if (grid == 0) {
        if (n_in != 17 || out_size != M * D || ws_size < WS_END) { fprintf(stderr, "kernel_launch: unexpected problem (n_in %d, out %d, ws %zu, need %zu)\n", n_in, out_size, ws_size, (size_t)WS_END); grid = -1; return; }
        int dev = 0, cus = 0, per_cu = 0;
        hipGetDevice(&dev); hipDeviceGetAttribute(&cus, hipDeviceAttributeMultiprocessorCount, dev);
        if (hipFuncSetAttribute((const void*)fwd_kernel, hipFuncAttributeMaxDynamicSharedMemorySize, LDS_BYTES) != hipSuccess) { fprintf(stderr, "kernel_launch: hipFuncSetAttribute failed\n"); grid = -1; return; }
        if (hipOccupancyMaxActiveBlocksPerMultiprocessor(&per_cu, (const void*)fwd_kernel, NTHR, LDS_BYTES) != hipSuccess || per_cu < 1) { fprintf(stderr, "kernel_launch: occupancy query says %d\n", per_cu); per_cu = 1; }
        (void)hipGetLastError();
        if (cus != 256) { fprintf(stderr, "kernel_launch: built for a 256-CU device (got %d CUs); nothing launched\n", cus); grid = -1; return; }
        grid = cus;
    }
    if (grid < 0) return;
    Args a{};
    for (int i = 0; i < 17; ++i) a.in[i] = (const float*)d_in[i];
    a.out = (float*)d_out; a.ws = (unsigned char*)d_ws;
    void* args[] = {&a};
    if (hipMemsetAsync((char*)d_ws + CTL_BAR, 0, XCD_BAR_WORDS * 4, stream) != hipSuccess) { fprintf(stderr, "kernel_launch: hipMemsetAsync failed\n"); return; }
    hipError_t e = hipLaunchCooperativeKernel((const void*)fwd_kernel, dim3(grid), dim3(NTHR), args, LDS_BYTES, stream);
    if (e != hipSuccess) fprintf(stderr, "cooperative launch failed: %s (grid %d)\n", hipGetErrorString(e), grid);
}
```

```cpp
#include <hip/hip_runtime.h>
#include <hip/hip_cooperative_groups.h>
#include <cstdio>
#include <cstdint>
namespace cg = cooperative_groups;
#define LAS __attribute__((address_space(3)))
#define XB_TMO      128
#define XB_XCNT(j)  (256  + 64 * (j))
#define XB_XSUB(j)  (1280 + 64 * (j))
#define XB_XGEN(j)  (2304 + 64 * (j))
#define XB_TOP      3328
#define XB_TOPGEN   3392
#define XCD_BAR_WORDS 3456
#define XB_SPIN_CAP (1u << 18)

__device__ __forceinline__ unsigned xb_ld(unsigned* p)              { return __hip_atomic_load(p, __ATOMIC_RELAXED, __HIP_MEMORY_SCOPE_AGENT); }
__device__ __forceinline__ unsigned xb_add(unsigned* p, unsigned v) { return __hip_atomic_fetch_add(p, v, __ATOMIC_RELAXED, __HIP_MEMORY_SCOPE_AGENT); }
__device__ __forceinline__ unsigned xb_xcc_id() { return (unsigned)__builtin_amdgcn_s_getreg((3 << 11) | 20) & 0xFu; }
#define XB_SPIN(cond, bar) do { unsigned _sp = 0; while (cond) { __builtin_amdgcn_s_sleep(1); \
    if ((++_sp & 255u) == 0u) { if (xb_ld(&(bar)[XB_TMO])) break; if (_sp > XB_SPIN_CAP) { atomicAdd(&(bar)[XB_TMO], 1u); break; } } } } while (0)

struct XcdBarrier {
    unsigned* bar; unsigned x;
    volatile LAS unsigned* st;
};

__device__ __forceinline__ XcdBarrier xcd_barrier_post(unsigned* bar, volatile LAS unsigned* st) {
    XcdBarrier b; b.bar = bar; b.x = xb_xcc_id(); b.st = st;
    if (threadIdx.x == 0) (void)xb_add(&bar[XB_XCNT(b.x)], 1u);
    return b;
}
__device__ __forceinline__ void xcd_barrier_complete(unsigned* bar, unsigned x, unsigned& nloc, unsigned& nx) {
    const unsigned G = gridDim.x * gridDim.y * gridDim.z;
    unsigned sum, cnt, mine, sp = 0u;
    for (;;) {
        sum = 0u; cnt = 0u; mine = 0u;
#pragma unroll
        for (unsigned j = 0; j < 16; ++j) { const unsigned c = xb_ld(&bar[XB_XCNT(j)]); sum += c; cnt += (c > 0u) ? 1u : 0u; mine = (j == x) ? c : mine; }
        if (sum == G) break;
        __builtin_amdgcn_s_sleep(1);
        if ((++sp & 255u) == 0u) { if (xb_ld(&bar[XB_TMO])) break; if (sp > XB_SPIN_CAP) { atomicAdd(&bar[XB_TMO], 1u); break; } }
    }
    nloc = mine > 0u ? mine : 1u; nx = cnt > 0u ? cnt : 1u;
}

__device__ __forceinline__ void xcd_barrier(const XcdBarrier& b) {
    asm volatile("s_waitcnt vmcnt(0)" ::: "memory");
    __syncthreads();
    if (threadIdx.x == 0) {
        unsigned* bar = b.bar;
        __builtin_amdgcn_s_waitcnt(0);
        unsigned nloc = b.st[0], nx = b.st[1];
        if (nloc == 0u) { xcd_barrier_complete(bar, b.x, nloc, nx); b.st[0] = nloc; b.st[1] = nx; }
        const unsigned old = xb_add(&bar[XB_XSUB(b.x)], 1u);
        const unsigned gen = old / nloc;
        if (old + 1u == (gen + 1u) * nloc) {
            __builtin_amdgcn_fence(__ATOMIC_RELEASE, "agent");
            asm volatile("s_waitcnt vmcnt(0)" ::: "memory");
            const unsigned og = xb_add(&bar[XB_TOP], 1u);
            const unsigned tg = og / nx;
            if (og + 1u == (tg + 1u) * nx) xb_add(&bar[XB_TOPGEN], 1u);
            else XB_SPIN(xb_ld(&bar[XB_TOPGEN]) == tg, bar);
            __builtin_amdgcn_fence(__ATOMIC_ACQUIRE, "agent");
            xb_add(&bar[XB_XGEN(b.x)], 1u);
            asm volatile("s_waitcnt vmcnt(0)" ::: "memory");
        } else {
            XB_SPIN(xb_ld(&bar[XB_XGEN(b.x)]) == gen, bar);
            __builtin_amdgcn_fence(__ATOMIC_ACQUIRE, "agent");
            asm volatile("s_waitcnt vmcnt(0)" ::: "memory");
        }
    }
    __syncthreads();
}

namespace pg8 {
#define PG8_LAS __attribute__((address_space(3)))
typedef unsigned short bf16_t;
typedef short bf16x8 __attribute__((ext_vector_type(8)));
typedef float f32x4 __attribute__((ext_vector_type(4)));
typedef unsigned u32x4 __attribute__((ext_vector_type(4)));
constexpr int BM = 256, BK = 64, HALF = 128, HTB = HALF * BK * 2  , STAGE_BYTES = 8 * HTB, NXCD = 8, WGM = 8;

__host__ __device__ __forceinline__ int lds_byte(int r, int c) { const int st = (r >> 4) * 2 + (c >> 5), rr = r & 15, cc = c & 31, ob = rr * 64 + cc * 2; return st * 1024 + (ob ^ (((ob >> 9) & 1) << 5)); }
__host__ __device__ __forceinline__ void stage_rc(int b, int& R, int& C) { const int st = b / 1024, sb = b % 1024, swz = sb ^ (((sb >> 9) & 1) << 5); R = (st >> 1) * 16 + swz / 64; C = (st & 1) * 32 + (swz % 64) / 2; }
__host__ __device__ __forceinline__ int perm32(int rho) { const int n = rho >> 4, i = rho & 15; return 8 * (i >> 2) + 4 * n + (i & 3); }

struct Unit { int pm, pn; };
struct Gemm { const bf16_t* A; const bf16_t* Bt; int M, N, K; };

struct StaticOrder {
    int nM, nN, nwg, G, c;
    __host__ __device__ void init(int M, int N, int G_, int c_) { nM = M / BM; nN = N / BM; nwg = nM * nN; G = G_; c = c_; }
    __host__ __device__ bool next(int i, Unit& u) const {
        const long L = (long)i * G + c; if (L >= nwg) return false;
        int wgid = (int)L; { const int q = nwg / NXCD, r = nwg % NXCD, xcd = wgid % NXCD, off = wgid / NXCD; wgid = (xcd < r ? xcd * (q + 1) : r * (q + 1) + (xcd - r) * q) + off; }
        const int nig = WGM * nN, gid = wgid / nig, fm = gid * WGM, gsz = (nM - fm) < WGM ? (nM - fm) : WGM;
        u.pm = fm + ((wgid % nig) % gsz); u.pn = (wgid % nig) / gsz; return true;
    }
    __device__ __forceinline__ void a_ready(const Unit&) const {}
    __device__ __forceinline__ void done(const Unit&) const {}
};

__device__ __forceinline__ unsigned cvt_pk_bf16(float lo, float hi) { unsigned r; asm volatile("v_cvt_pk_bf16_f32 %0, %1, %2" : "=v"(r) : "v"(lo), "v"(hi)); return r; }
typedef float f32x2 __attribute__((ext_vector_type(2)));
#ifndef USE_TILED
#define USE_TILED false
#endif
constexpr float RMS_EPS = 1e-6f;
constexpr int DM = 2048, DFF = 5632;
__device__ __forceinline__ float rs_of(const float* ss, int row) { return __builtin_amdgcn_rsqf(ss[row] * (1.0f / 2048.0f) + RMS_EPS); }
__device__ __forceinline__ float silu_f(float a) { return a * __builtin_amdgcn_rcpf(1.0f + __builtin_amdgcn_exp2f(-1.4426950408889634f * a)); }
__device__ __forceinline__ float sigm_f(float a) { return __builtin_amdgcn_rcpf(1.0f + __builtin_amdgcn_exp2f(-1.4426950408889634f * a)); }
__device__ __forceinline__ u32x4 pack8(const f32x4 v0, const f32x4 v1) { u32x4 w; w.x = cvt_pk_bf16(v0[0], v0[1]); w.y = cvt_pk_bf16(v0[2], v0[3]); w.z = cvt_pk_bf16(v1[0], v1[1]); w.w = cvt_pk_bf16(v1[2], v1[3]); return w; }

struct EpiSwiglu {
    static constexpr bool PERM = true, AFTER_DRAIN = false;
    static constexpr bool PRELOAD = true;
    bf16_t* O; const float* ss;
    __device__ __forceinline__ void preload(const Unit& u, int wr, int fr, float (&pre)[8]) const {
#pragma unroll
        for (int i = 0; i < 8; ++i) pre[i] = ss[u.pm * BM + wr * 64 + fr + (i >> 2) * HALF + (i & 3) * 16];
    }
    __device__ __forceinline__ void operator()(const f32x4 (&acc)[2][2][4][2], const Unit& u, int wr, int wc, int fr, int fq, const float (&pre)[8]) const {
        const int row0 = u.pm * BM + wr * 64 + fr, col0 = u.pn * 128 + wc * 32 + 8 * fq;
        float rsv[2][4];
#pragma unroll
        for (int ai = 0; ai < 2; ++ai)
#pragma unroll
            for (int m = 0; m < 4; ++m) rsv[ai][m] = pre[4 * ai + m];
#pragma unroll
        for (int ai = 0; ai < 2; ++ai)
#pragma unroll
            for (int m = 0; m < 4; ++m) {
                const int r = row0 + ai * HALF + m * 16; const float rs = __builtin_amdgcn_rsqf(rsv[ai][m] * (1.0f / 2048.0f) + RMS_EPS);
                f32x4 v[2];
                const float k1 = -1.4426950408889634f * rs, rs2 = rs * rs;
#pragma unroll
                for (int n = 0; n < 2; ++n) { const f32x4 a = acc[ai][0][m][n], b = acc[ai][1][m][n];
#pragma unroll
                    for (int q = 0; q < 4; ++q) v[n][q] = (a[q] * b[q]) * rs2 * __builtin_amdgcn_rcpf(1.0f + __builtin_amdgcn_exp2f(k1 * a[q])); }
                if (USE_TILED) *(u32x4*)(O + ((size_t)(r >> 8) * (DFF / 64) + (col0 >> 6)) * 16384 + (size_t)(r & 255) * 64 + (col0 & 63)) = pack8(v[0], v[1]);
                else *(u32x4*)(O + (size_t)r * DFF + col0) = pack8(v[0], v[1]);
            }
    }
};
template <bool IN_BF16> struct EpiResid {
    static constexpr bool PERM = true, AFTER_DRAIN = true;
    const float* hin; bf16_t* hb; float* ss; float scale; ::XcdBarrier xbar;
    __device__ __forceinline__ void fused(f32x4 (&acc)[2][2][4][2], const Unit& u, int wr, int wc, int fr, int fq, PG8_LAS unsigned char*, int, int) const {
        const int row0 = u.pm * BM + wr * 64 + fr, col0 = u.pn * BM + wc * 32 + 8 * fq;
        f32x4 xv[4][2][2][2];
#define EPIRESID_LOAD(k) _Pragma("unroll") for (int mm = 0; mm < 2; ++mm) _Pragma("unroll") for (int bj = 0; bj < 2; ++bj) { \
            const size_t off_ = (size_t)(row0 + ((k) >> 1) * HALF + (2 * ((k) & 1) + mm) * 16) * DM + col0 + bj * HALF; \
            if (IN_BF16) { const u32x4 w_ = *(const u32x4*)(hb + off_); \
                xv[k][mm][bj][0] = (f32x4){__uint_as_float(w_.x << 16), __uint_as_float(w_.x & 0xffff0000u), __uint_as_float(w_.y << 16), __uint_as_float(w_.y & 0xffff0000u)}; \
                xv[k][mm][bj][1] = (f32x4){__uint_as_float(w_.z << 16), __uint_as_float(w_.z & 0xffff0000u), __uint_as_float(w_.w << 16), __uint_as_float(w_.w & 0xffff0000u)}; } \
            else { xv[k][mm][bj][0] = *(const f32x4*)(hin + off_); xv[k][mm][bj][1] = *(const f32x4*)(hin + off_ + 4); } }
        EPIRESID_LOAD(0)
#pragma unroll
        for (int k = 0; k < 4; ++k) {
            if (k == 0) { EPIRESID_LOAD(1) } else if (k == 1) { EPIRESID_LOAD(2) } else if (k == 2) { EPIRESID_LOAD(3) }
            asm volatile("" ::: "memory");
            const int ai = k >> 1;
#pragma unroll
            for (int mm = 0; mm < 2; ++mm) { const int m = 2 * (k & 1) + mm, r = row0 + ai * HALF + m * 16; float sq = 0.f;
#pragma unroll
                for (int bj = 0; bj < 2; ++bj) { const size_t off = (size_t)r * DM + col0 + bj * HALF;
                    const f32x4 a = xv[k][mm][bj][0] + acc[ai][bj][m][0] * scale, b = xv[k][mm][bj][1] + acc[ai][bj][m][1] * scale;
                    *(u32x4*)(hb + off) = pack8(a, b);
                    sq += (a[0] * a[0] + a[1] * a[1]) + (a[2] * a[2] + a[3] * a[3]) + (b[0] * b[0] + b[1] * b[1]) + (b[2] * b[2] + b[3] * b[3]); }
                sq += __shfl_xor(sq, 16); sq += __shfl_xor(sq, 32);
                if (fq == 0) unsafeAtomicAdd(ss + r, sq); }
            asm volatile("" ::: "memory");
        }
#undef EPIRESID_LOAD
        ::xcd_barrier(xbar);
    }
};
struct EpiQKV {
    static constexpr bool PERM = true, AFTER_DRAIN = false;
    static constexpr bool PRELOAD = true;
    bf16_t* base; const float* ss; float qscale; size_t tstride;
    __device__ __forceinline__ void preload(const Unit& u, int wr, int fr, float (&pre)[8]) const {
#pragma unroll
        for (int i = 0; i < 8; ++i) pre[i] = ss[u.pm * BM + wr * 64 + fr + (i >> 2) * HALF + (i & 3) * 16];
    }
    __device__ __forceinline__ void operator()(const f32x4 (&acc)[2][2][4][2], const Unit& u, int wr, int wc, int fr, int fq, const float (&pre)[8]) const {
        const int t = u.pn >> 2; const float sc = (t == 0 || t == 3) ? qscale : 1.0f;
        const int row0 = u.pm * BM + wr * 64 + fr, col0 = (u.pn & 3) * BM + wc * 32 + 8 * fq; bf16_t* O = base + (size_t)t * tstride;
        float rsv[2][4];
#pragma unroll
        for (int ai = 0; ai < 2; ++ai)
#pragma unroll
            for (int m = 0; m < 4; ++m) rsv[ai][m] = pre[4 * ai + m];
#pragma unroll
        for (int ai = 0; ai < 2; ++ai)
#pragma unroll
            for (int m = 0; m < 4; ++m) {
                const int r = row0 + ai * HALF + m * 16; const float rs = __builtin_amdgcn_rsqf(rsv[ai][m] * (1.0f / 2048.0f) + RMS_EPS) * sc;
#pragma unroll
                for (int bj = 0; bj < 2; ++bj) *(u32x4*)(O + (size_t)r * 1024 + col0 + bj * HALF) = pack8(acc[ai][bj][m][0] * rs, acc[ai][bj][m][1] * rs);
            }
    }
};
struct EpiF32 {
    static constexpr bool PERM = true, AFTER_DRAIN = false;
    float* O;
    __device__ __forceinline__ void operator()(const f32x4 (&acc)[2][2][4][2], const Unit& u, int wr, int wc, int fr, int fq) const {
        const int row0 = u.pm * BM + wr * 64 + fr, col0 = u.pn * BM + wc * 32 + 8 * fq;
#pragma unroll
        for (int ai = 0; ai < 2; ++ai)
#pragma unroll
            for (int m = 0; m < 4; ++m)
            {
#pragma unroll
              for (int bj = 0; bj < 2; ++bj) { float* o = O + (size_t)(row0 + ai * HALF + m * 16) * DM + col0 + bj * HALF; *(f32x4*)o = acc[ai][bj][m][0]; *(f32x4*)(o + 4) = acc[ai][bj][m][1]; } }
    }
};
struct EpiBf16Plain {
    static constexpr bool PERM = true, AFTER_DRAIN = false;
    bf16_t* O;
    __device__ __forceinline__ void operator()(const f32x4 (&acc)[2][2][4][2], const Unit& u, int wr, int wc, int fr, int fq) const {
        const int row0 = u.pm * BM + wr * 64 + fr, col0 = u.pn * BM + wc * 32 + 8 * fq;
#pragma unroll
        for (int ai = 0; ai < 2; ++ai)
#pragma unroll
            for (int m = 0; m < 4; ++m)
#pragma unroll
                for (int bj = 0; bj < 2; ++bj) *(u32x4*)(O + (size_t)(row0 + ai * HALF + m * 16) * DM + col0 + bj * HALF) = pack8(acc[ai][bj][m][0], acc[ai][bj][m][1]);
    }
};
struct EpiPle {
    static constexpr bool PERM = true, AFTER_DRAIN = false;
    const float* hin; float* out; const float* ss3; float* ss4;
    __device__ __forceinline__ void operator()(const f32x4 (&acc)[2][2][4][2], const Unit& u, int wr, int wc, int fr, int fq) const {
        const int row0 = u.pm * BM + wr * 64 + fr, col0 = u.pn * BM + wc * 32 + 8 * fq;
#pragma unroll
        for (int ai = 0; ai < 2; ++ai)
#pragma unroll
            for (int m = 0; m < 4; ++m) {
                const int r = row0 + ai * HALF + m * 16; const float rs = rs_of(ss3, r); float sq = 0.f;
#pragma unroll
                for (int bj = 0; bj < 2; ++bj) { const size_t off = (size_t)r * DM + col0 + bj * HALF;
                    const f32x4 x0 = *(const f32x4*)(hin + off), x1 = *(const f32x4*)(hin + off + 4), p0 = *(const f32x4*)(out + off), p1 = *(const f32x4*)(out + off + 4);
                    const f32x4 a0 = acc[ai][bj][m][0] * rs, a1 = acc[ai][bj][m][1] * rs;
                    const f32x4 g0 = (f32x4){sigm_f(a0[0]), sigm_f(a0[1]), sigm_f(a0[2]), sigm_f(a0[3])}, g1 = (f32x4){sigm_f(a1[0]), sigm_f(a1[1]), sigm_f(a1[2]), sigm_f(a1[3])};
                    const f32x4 y0 = x0 + g0 * p0, y1 = x1 + g1 * p1;
                    *(f32x4*)(out + off) = y0; *(f32x4*)(out + off + 4) = y1;
                    sq += (y0[0] * y0[0] + y0[1] * y0[1]) + (y0[2] * y0[2] + y0[3] * y0[3]) + (y1[0] * y1[0] + y1[1] * y1[1]) + (y1[2] * y1[2] + y1[3] * y1[3]); }
                sq += __shfl_xor(sq, 16); sq += __shfl_xor(sq, 32);
                if (fq == 0) unsafeAtomicAdd(ss4 + r, sq);
            }
    }
};

struct EpiPleNorm {
    static constexpr bool PERM = true, AFTER_DRAIN = true;
    const bf16_t* hbin; float* out; const float* ss3; float* ss4; const float* gfin; unsigned* pcnt; const bf16_t* ppb;
    __device__ __forceinline__ void fused(f32x4 (&acc)[2][2][4][2], const Unit& u, int wr, int wc, int fr, int fq, PG8_LAS unsigned char*, int, int lane) const {
        const int row0 = u.pm * BM + wr * 64 + fr, col0 = u.pn * BM + wc * 32 + 8 * fq;
        float rsv[2][4];
#pragma unroll
        for (int ai = 0; ai < 2; ++ai)
#pragma unroll
            for (int m = 0; m < 4; ++m) rsv[ai][m] = ss3[row0 + ai * HALF + m * 16];
#pragma unroll
        for (int ai = 0; ai < 2; ++ai)
#pragma unroll
            for (int mh = 0; mh < 2; ++mh) {
                f32x4 xv[2][2][2]; u32x4 pw[2][2];
#pragma unroll
                for (int mm = 0; mm < 2; ++mm)
#pragma unroll
                    for (int bj = 0; bj < 2; ++bj) { const size_t off = (size_t)(row0 + ai * HALF + (2 * mh + mm) * 16) * DM + col0 + bj * HALF;
                        const u32x4 w_ = *(const u32x4*)(hbin + off);
                        xv[mm][bj][0] = (f32x4){__uint_as_float(w_.x << 16), __uint_as_float(w_.x & 0xffff0000u), __uint_as_float(w_.y << 16), __uint_as_float(w_.y & 0xffff0000u)};
                        xv[mm][bj][1] = (f32x4){__uint_as_float(w_.z << 16), __uint_as_float(w_.z & 0xffff0000u), __uint_as_float(w_.w << 16), __uint_as_float(w_.w & 0xffff0000u)};
                        pw[mm][bj] = *(const u32x4*)(ppb + off); }
#pragma unroll
                for (int mm = 0; mm < 2; ++mm) { const int m = 2 * mh + mm, r = row0 + ai * HALF + m * 16; const float rs = __builtin_amdgcn_rsqf(rsv[ai][m] * (1.0f / 2048.0f) + RMS_EPS); float sq = 0.f;
#pragma unroll
                    for (int bj = 0; bj < 2; ++bj) {
                        const f32x4 a0 = acc[ai][bj][m][0] * rs, a1 = acc[ai][bj][m][1] * rs;
                        const f32x4 g0 = (f32x4){sigm_f(a0[0]), sigm_f(a0[1]), sigm_f(a0[2]), sigm_f(a0[3])}, g1 = (f32x4){sigm_f(a1[0]), sigm_f(a1[1]), sigm_f(a1[2]), sigm_f(a1[3])};
                        const u32x4 w = pw[mm][bj];
                        const f32x4 p0 = (f32x4){__uint_as_float(w.x << 16), __uint_as_float(w.x & 0xffff0000u), __uint_as_float(w.y << 16), __uint_as_float(w.y & 0xffff0000u)}, p1 = (f32x4){__uint_as_float(w.z << 16), __uint_as_float(w.z & 0xffff0000u), __uint_as_float(w.w << 16), __uint_as_float(w.w & 0xffff0000u)};
                        const f32x4 y0 = xv[mm][bj][0] + g0 * p0, y1 = xv[mm][bj][1] + g1 * p1;
                        acc[ai][bj][m][0] = y0; acc[ai][bj][m][1] = y1;
                        sq += (y0[0] * y0[0] + y0[1] * y0[1]) + (y0[2] * y0[2] + y0[3] * y0[3]) + (y1[0] * y1[0] + y1[1] * y1[1]) + (y1[2] * y1[2] + y1[3] * y1[3]); }
                    sq += __shfl_xor(sq, 16); sq += __shfl_xor(sq, 32);
                    if (fq == 0) unsafeAtomicAdd(ss4 + r, sq); }
            }
        asm volatile("s_waitcnt vmcnt(0)" ::: "memory");
        unsigned* c = pcnt + 64 * u.pm;
        if (lane == 0) __hip_atomic_fetch_add(c, 1u, __ATOMIC_RELAXED, __HIP_MEMORY_SCOPE_AGENT);
        if (wr == 0 && wc == 0) { unsigned sp = 0; while ((unsigned)__builtin_amdgcn_readfirstlane(__hip_atomic_load(c, __ATOMIC_RELAXED, __HIP_MEMORY_SCOPE_AGENT)) < 64u) { __builtin_amdgcn_s_sleep(4); if (++sp > (1u << 21)) break; } }
        asm volatile("s_waitcnt vmcnt(0) lgkmcnt(0)" ::: "memory"); __builtin_amdgcn_s_barrier(); asm volatile("" ::: "memory");
        f32x4 gv[2][2];
#pragma unroll
        for (int bj = 0; bj < 2; ++bj) { gv[bj][0] = *(const f32x4*)(gfin + col0 + bj * HALF); gv[bj][1] = *(const f32x4*)(gfin + col0 + bj * HALF + 4); }
        float s4[2][4];
#pragma unroll
        for (int ai = 0; ai < 2; ++ai)
#pragma unroll
            for (int m = 0; m < 4; ++m) s4[ai][m] = __hip_atomic_load(ss4 + row0 + ai * HALF + m * 16, __ATOMIC_RELAXED, __HIP_MEMORY_SCOPE_AGENT);
#pragma unroll
        for (int ai = 0; ai < 2; ++ai)
#pragma unroll
            for (int m = 0; m < 4; ++m) {
                const int r = row0 + ai * HALF + m * 16;
                const float rs = __builtin_amdgcn_rsqf(s4[ai][m] * (1.0f / 2048.0f) + RMS_EPS);
#pragma unroll
                for (int bj = 0; bj < 2; ++bj) { float* o = out + (size_t)r * DM + col0 + bj * HALF;
                    *(f32x4*)o = acc[ai][bj][m][0] * rs * gv[bj][0]; *(f32x4*)(o + 4) = acc[ai][bj][m][1] * rs * gv[bj][1]; }
            }
    }
};
template <class E_> struct has_preload { template <class T> static constexpr auto test(int) -> decltype(T::PRELOAD, true) { return T::PRELOAD; } template <class> static constexpr bool test(...) { return false; } static constexpr bool value = test<E_>(0); };
template <class Epi, class Sched, bool ALIGN_EPI = false, bool SP2 = false, bool TILED = false  >
__device__ __forceinline__ void gemm_phase(PG8_LAS unsigned char* lds, const Gemm g, const Sched& S, const Epi& E) {
    int tid_l = threadIdx.x; asm volatile("" : "+v"(tid_l));
    const int tid = tid_l, wid = __builtin_amdgcn_readfirstlane(tid >> 6), lane = tid & 63, wr = wid >> 2, wc = wid & 3, fr = lane & 15, fq = lane >> 4;
    const int K = g.K, nt = K / BK;
    unsigned voffA[2], voffB[2];
#pragma unroll
    for (int i = 0; i < 2; ++i) { int R, C; stage_rc(tid * 16 + i * 8192, R, C); const int Rb = Epi::PERM ? ((R & ~31) + perm32(R & 31)) : R;
        voffA[i] = (unsigned)(R * (TILED ? BK : K) + C) * 2u; voffB[i] = (unsigned)(Rb * (TILED ? BK : K) + C) * 2u; }
    const size_t kstep = TILED ? (size_t)(BM * BK * 2) : (size_t)(BK * 2);
    const size_t hstep = TILED ? (size_t)(HALF * BK * 2) : (size_t)HALF * K * 2;
    const size_t tstep = (size_t)BM * K * 2;
    const unsigned ldsw = (unsigned)wid * 1024u;
    const int aoff = lds_byte(wr * 64 + fr, fq * 8), boff = lds_byte(wc * 32 + fr, fq * 8);
#define PG8_SA(b, h) (((b) * 2 + (h)) * HTB)
#define PG8_SB(b, h) ((4 + (b) * 2 + (h)) * HTB)
#define PG8_STAGE(bufoff, gbase, voff) do { _Pragma("unroll") for (int _i = 0; _i < 2; ++_i) \
        __builtin_amdgcn_global_load_lds((const unsigned*)((const char*)(gbase) + (voff)[_i]), (PG8_LAS unsigned*)(lds + (bufoff) + ldsw + _i * 8192), 16, 0, 0); } while (0)
#define PG8_LDA(dst, b, h) do { _Pragma("unroll") for (int m = 0; m < 4; ++m) _Pragma("unroll") for (int k = 0; k < 2; ++k) dst[m][k] = *(const PG8_LAS bf16x8*)(lds + PG8_SA(b, h) + aoff + m * 2048 + k * 1024); } while (0)
#define PG8_LDB(dst, b, h) do { _Pragma("unroll") for (int n = 0; n < 2; ++n) _Pragma("unroll") for (int k = 0; k < 2; ++k) dst[n][k] = *(const PG8_LAS bf16x8*)(lds + PG8_SB(b, h) + boff + n * 2048 + k * 1024); } while (0)
#define PG8_MMA(ai, bj, At, Bt) do { __builtin_amdgcn_s_setprio(1); _Pragma("unroll") for (int m = 0; m < 4; ++m) _Pragma("unroll") for (int n = 0; n < 2; ++n) _Pragma("unroll") for (int k = 0; k < 2; ++k) \
        acc[ai][bj][m][n] = __builtin_amdgcn_mfma_f32_16x16x32_bf16(Bt[n][k], At[m][k], acc[ai][bj][m][n], 0, 0, 0); __builtin_amdgcn_s_setprio(0); } while (0)
#define PG8_WAIT_V(n) asm volatile("s_waitcnt vmcnt(" #n ")" ::: "memory")
#define PG8_WAIT_L(n) asm volatile("s_waitcnt lgkmcnt(" #n ")" ::: "memory")
#define PG8_BAR __builtin_amdgcn_s_barrier()
#define PG8_SCHED __builtin_amdgcn_sched_barrier(0)
    Unit cur, nxt; int ui = 0;
    if (!S.next(0, cur)) return;
    f32x4 acc[2][2][4][2];
#pragma unroll
    for (int a = 0; a < 2; ++a)
#pragma unroll
        for (int b = 0; b < 2; ++b)
#pragma unroll
            for (int m = 0; m < 4; ++m)
#pragma unroll
                for (int n = 0; n < 2; ++n) acc[a][b][m][n] = (f32x4){0.f, 0.f, 0.f, 0.f};
    bf16x8 At[4][2], B0[2][2], B1[2][2];
    const char* cA = (const char*)g.A + (size_t)cur.pm * tstep; const char* cB = (const char*)g.Bt + (size_t)cur.pn * tstep;
    S.a_ready(cur);
    float pre[8];
    if constexpr (has_preload<Epi>::value) E.preload(cur, wr, fr, pre);
    if constexpr (SP2) {
        PG8_STAGE(PG8_SB(0, 0), cB, voffB); PG8_STAGE(PG8_SB(0, 1), cB + hstep, voffB); PG8_STAGE(PG8_SA(0, 0), cA, voffA); PG8_STAGE(PG8_SA(0, 1), cA + hstep, voffA);
        if (wr == 1) PG8_BAR;
        PG8_WAIT_V(2); PG8_BAR;
        PG8_STAGE(PG8_SB(1, 0), cB + kstep, voffB); PG8_STAGE(PG8_SA(1, 0), cA + kstep, voffA); PG8_STAGE(PG8_SB(1, 1), cB + hstep + kstep, voffB);
        PG8_WAIT_V(6); PG8_BAR;
    } else {
        PG8_STAGE(PG8_SB(0, 0), cB, voffB); PG8_STAGE(PG8_SA(0, 0), cA, voffA); PG8_STAGE(PG8_SB(0, 1), cB + hstep, voffB); PG8_STAGE(PG8_SA(0, 1), cA + hstep, voffA);
        if (wr == 1) PG8_BAR;
        PG8_WAIT_V(4); PG8_BAR;
        PG8_STAGE(PG8_SB(1, 0), cB + kstep, voffB); PG8_STAGE(PG8_SA(1, 0), cA + kstep, voffA); PG8_STAGE(PG8_SB(1, 1), cB + hstep + kstep, voffB);
        PG8_WAIT_V(6); PG8_BAR;
    }
    for (;;) {
        const bool has_next = S.next(ui + 1, nxt);
        const char* nA = has_next ? (const char*)g.A + (size_t)nxt.pm * tstep : cA; const char* nB = has_next ? (const char*)g.Bt + (size_t)nxt.pn * tstep : cB;
        for (int t = 0; t < nt; t += 2) {
            const bool last = (t == nt - 2);
            const char* a1 = cA + (size_t)(t + 1) * kstep;
            const char* a2 = last ? nA : cA + (size_t)(t + 2) * kstep; const char* b2 = last ? nB : cB + (size_t)(t + 2) * kstep;
            const char* a3 = a2 + kstep; const char* b3 = b2 + kstep;
            if (last && has_next) S.a_ready(nxt);
            if constexpr (SP2) {
            PG8_LDB(B0, 0, 0); PG8_LDB(B1, 0, 1); PG8_SCHED; PG8_LDA(At, 0, 0); PG8_STAGE(PG8_SA(1, 1), a1 + hstep, voffA);
            PG8_WAIT_V(8); PG8_WAIT_L(0); PG8_BAR; PG8_MMA(0, 0, At, B0); PG8_MMA(0, 1, At, B1); PG8_BAR; PG8_SCHED;
            PG8_LDA(At, 0, 1); PG8_STAGE(PG8_SB(0, 0), b2, voffB); PG8_STAGE(PG8_SB(0, 1), b2 + hstep, voffB); PG8_STAGE(PG8_SA(0, 0), a2, voffA);
            PG8_WAIT_V(8); PG8_WAIT_L(0); PG8_BAR; PG8_MMA(1, 0, At, B0); PG8_MMA(1, 1, At, B1); PG8_BAR; PG8_SCHED;
            PG8_LDB(B0, 1, 0); PG8_LDB(B1, 1, 1); PG8_SCHED; PG8_LDA(At, 1, 0); PG8_STAGE(PG8_SA(0, 1), a2 + hstep, voffA);
            PG8_WAIT_V(8); PG8_WAIT_L(0); PG8_BAR; PG8_MMA(0, 0, At, B0); PG8_MMA(0, 1, At, B1); PG8_BAR; PG8_SCHED;
            PG8_LDA(At, 1, 1); PG8_STAGE(PG8_SB(1, 0), b3, voffB); PG8_STAGE(PG8_SB(1, 1), b3 + hstep, voffB); PG8_STAGE(PG8_SA(1, 0), a3, voffA);
            PG8_WAIT_V(8); PG8_WAIT_L(0); PG8_BAR; PG8_MMA(1, 0, At, B0); PG8_MMA(1, 1, At, B1); PG8_BAR; PG8_SCHED;
            } else {
            PG8_LDB(B0, 0, 0); PG8_SCHED; PG8_LDA(At, 0, 0); PG8_STAGE(PG8_SA(1, 1), a1 + hstep, voffA);
            PG8_WAIT_L(8); PG8_BAR; PG8_WAIT_L(0); PG8_MMA(0, 0, At, B0); PG8_BAR; PG8_SCHED;
            PG8_LDB(B1, 0, 1); PG8_STAGE(PG8_SB(0, 0), b2, voffB);
            PG8_BAR; PG8_WAIT_L(0); PG8_MMA(0, 1, At, B1); PG8_BAR;
            PG8_LDA(At, 0, 1); PG8_STAGE(PG8_SA(0, 0), a2, voffA);
            PG8_BAR; PG8_WAIT_L(0); PG8_MMA(1, 0, At, B0); PG8_BAR; PG8_SCHED;
            PG8_STAGE(PG8_SB(0, 1), b2 + hstep, voffB);
            PG8_WAIT_V(6); PG8_BAR; PG8_MMA(1, 1, At, B1); PG8_BAR;
            PG8_LDB(B0, 1, 0); PG8_SCHED; PG8_LDA(At, 1, 0); PG8_STAGE(PG8_SA(0, 1), a2 + hstep, voffA);
            PG8_WAIT_L(8); PG8_BAR; PG8_WAIT_L(0); PG8_MMA(0, 0, At, B0); PG8_BAR; PG8_SCHED;
            PG8_LDB(B1, 1, 1); PG8_STAGE(PG8_SB(1, 0), b3, voffB);
            PG8_BAR; PG8_WAIT_L(0); PG8_MMA(0, 1, At, B1); PG8_BAR;
            PG8_LDA(At, 1, 1); PG8_STAGE(PG8_SA(1, 0), a3, voffA);
            PG8_BAR; PG8_WAIT_L(0); PG8_MMA(1, 0, At, B0); PG8_BAR; PG8_SCHED;
            PG8_STAGE(PG8_SB(1, 1), b3 + hstep, voffB);
            PG8_WAIT_V(6); PG8_BAR; PG8_MMA(1, 1, At, B1); PG8_BAR;
            }
        }
        if constexpr (ALIGN_EPI) { if (wr == 0) PG8_BAR; }
        if constexpr (!Epi::AFTER_DRAIN) { if constexpr (has_preload<Epi>::value) E(acc, cur, wr, wc, fr, fq, pre); else E(acc, cur, wr, wc, fr, fq); S.done(cur); }
        if (!has_next) break;
#pragma unroll
        for (int a = 0; a < 2; ++a)
#pragma unroll
            for (int b = 0; b < 2; ++b)
#pragma unroll
                for (int m = 0; m < 4; ++m)
#pragma unroll
                    for (int n = 0; n < 2; ++n) acc[a][b][m][n] = (f32x4){0.f, 0.f, 0.f, 0.f};
        cur = nxt; cA = nA; cB = nB; ++ui;
        if constexpr (has_preload<Epi>::value) E.preload(cur, wr, fr, pre);
        if constexpr (ALIGN_EPI) { if (wr == 1) PG8_BAR; }
    }
    PG8_WAIT_V(0);
    if constexpr (!ALIGN_EPI) { if (wr == 0) PG8_BAR; }
    PG8_BAR;
    if constexpr (Epi::AFTER_DRAIN) { E.fused(acc, cur, wr, wc, fr, fq, lds, wid, lane); S.done(cur); }
#undef PG8_SA
#undef PG8_SB
#undef PG8_STAGE
#undef PG8_LDA
#undef PG8_LDB
#undef PG8_MMA
#undef PG8_WAIT_V
#undef PG8_WAIT_L
#undef PG8_BAR
#undef PG8_SCHED
}
}
namespace att {
#define ALAS __attribute__((address_space(3)))
typedef unsigned short bf16;
typedef short bf16x8 __attribute__((ext_vector_type(8)));
typedef short s16x4 __attribute__((ext_vector_type(4)));
typedef float f32x16 __attribute__((ext_vector_type(16)));
typedef float f32x4 __attribute__((ext_vector_type(4)));
typedef unsigned u32x4 __attribute__((ext_vector_type(4)));
typedef unsigned u32x2 __attribute__((ext_vector_type(2)));
typedef float f32x2_t __attribute__((ext_vector_type(2))); typedef __bf16 bf16x2_t __attribute__((ext_vector_type(2)));
constexpr int SEQ = 2048, NB = 4, NH = 8, HD = 128, ROWP = 1024;
constexpr int OFF_K = 0, OFF_V = 32768, OFF_NEGF = 65536, OFF_BIAS = 65536 + 8192, OFF_MISC = OFF_BIAS + 2304;
constexpr float LOG2E = 1.4426950408889634f;
__device__ __forceinline__ unsigned off_b(unsigned row, unsigned ch) { return 256u * row + 16u * (ch ^ (((row & 3u) << 2) | ((row >> 2) & 3u))); }
__device__ __forceinline__ unsigned cvtpk_s(float lo, float hi) { f32x2_t v = {lo, hi}; bf16x2_t b = __builtin_convertvector(v, bf16x2_t); return __builtin_bit_cast(unsigned, b); }
__device__ __forceinline__ float fadd_s(float x, float y) { float r = x + y; asm("" : "+v"(r)); return r; }
__device__ __forceinline__ float fsub_s(float x, float y) { float r = x - y; asm("" : "+v"(r)); return r; }
__device__ __forceinline__ float fmul_s(float x, float y) { float r = x * y; asm("" : "+v"(r)); return r; }
__device__ __forceinline__ s16x4 vtr(ALAS const unsigned char* p) { return __builtin_bit_cast(s16x4, __builtin_amdgcn_ds_read_tr16_b64_v4i16((ALAS s16x4*)p)); }

struct TileRegs { u32x4 k[2], v[2]; };
__device__ __forceinline__ void tile_gload(TileRegs& R, const bf16* Kg, const bf16* Vg, int tok0, int tid) {
#pragma unroll
    for (int i = 0; i < 2; ++i) { const int id = tid + 512 * i, row = id >> 4, ch = id & 15; const size_t o = (size_t)(tok0 + row) * ROWP + ch * 8;
        R.k[i] = *(const u32x4*)(Kg + o); R.v[i] = *(const u32x4*)(Vg + o); }
}
__device__ __forceinline__ void tile_lstore(const TileRegs& R, ALAS unsigned char* kbuf, ALAS unsigned char* vbuf, int tid) {
#pragma unroll
    for (int i = 0; i < 2; ++i) { const int id = tid + 512 * i, row = id >> 4, ch = id & 15; const unsigned o = off_b(row, ch);
        *(ALAS u32x4*)(kbuf + o) = R.k[i]; *(ALAS u32x4*)(vbuf + o) = R.v[i]; }
}

template <int MODE>
__device__ __forceinline__ void tile_compute(f32x16 (&o)[4], float& m_run, float& l_run, const bf16x8 (&qf)[8], ALAS const unsigned char* lds, ALAS const unsigned char* kbuf, ALAS const unsigned char* vbuf,
                                             int lane, int rel0  , bool cst  , int key0  , bool diag, int tloc  ) {
    const int r = lane & 31, h = lane >> 5;
    const int kap = (r & 0x13) | ((r & 4) << 1) | ((r & 8) >> 1);
    f32x16 s[2];
    if (MODE == 1) {
        ALAS const float* nf = (ALAS const float*)(lds + OFF_NEGF) + key0;
#pragma unroll
        for (int kb = 0; kb < 2; ++kb)
#pragma unroll
            for (int g = 0; g < 4; ++g) { const f32x4 f = *(ALAS const f32x4*)(nf + 32 * kb + 4 * (g & 1) + 16 * (g >> 1));
#pragma unroll
                for (int e = 0; e < 4; ++e) s[kb][4 * g + e] = f[e]; }
    } else {
        const float c = cst ? ((ALAS const float*)(lds + OFF_BIAS))[512] : 0.f;
#pragma unroll
        for (int i = 0; i < 16; ++i) { s[0][i] = c; s[1][i] = c; }
    }
#pragma unroll
    for (int ks = 0; ks < 8; ++ks) {
        const bf16x8 k0 = *(ALAS const bf16x8*)(kbuf + off_b(kap, 2 * ks + h));
        const bf16x8 k1 = *(ALAS const bf16x8*)(kbuf + 8192 + off_b(kap, 2 * ks + h));
        s[0] = __builtin_amdgcn_mfma_f32_32x32x16_bf16(k0, qf[ks], s[0], 0, 0, 0);
        s[1] = __builtin_amdgcn_mfma_f32_32x32x16_bf16(k1, qf[ks], s[1], 0, 0, 0);
    }
    if (MODE == 0) {
        if (!cst) { ALAS const float* bt = (ALAS const float*)(lds + OFF_BIAS);
#pragma unroll
            for (int kb = 0; kb < 2; ++kb)
#pragma unroll
                for (int i = 0; i < 16; ++i) { int rel = rel0 - 32 * kb - (i & 7) - 16 * (i >> 3); rel = rel < 256 ? rel : 256; rel = rel > -256 ? rel : -256; s[kb][i] = fadd_s(s[kb][i], bt[rel + 256]); }
        }
    } else if (diag) {
#pragma unroll
        for (int kb = 0; kb < 2; ++kb)
#pragma unroll
            for (int i = 0; i < 16; ++i) if (32 * kb + (i & 7) + 16 * (i >> 3) > tloc) s[kb][i] = -INFINITY;
    }
    float mx = s[0][0];
#pragma unroll
    for (int i = 1; i < 16; ++i) mx = fmaxf(mx, s[0][i]);
#pragma unroll
    for (int i = 0; i < 16; ++i) mx = fmaxf(mx, s[1][i]);
    { auto rr = __builtin_amdgcn_permlane32_swap(__float_as_uint(mx), __float_as_uint(mx), false, false); mx = fmaxf(__uint_as_float(rr[0]), __uint_as_float(rr[1])); }
    constexpr float RESC_THR = 10.0f;
    if (__builtin_amdgcn_ballot_w64(mx > m_run + RESC_THR) != 0ull) {
        const float m_new = fmaxf(m_run, mx), alpha = __builtin_amdgcn_exp2f(m_run - m_new);
        m_run = m_new; l_run *= alpha;
#pragma unroll
        for (int c = 0; c < 4; ++c)
#pragma unroll
            for (int i = 0; i < 16; ++i) o[c][i] = fmul_s(o[c][i], alpha);
    }
    float ps = 0.f;
#pragma unroll
    for (int kb = 0; kb < 2; ++kb)
#pragma unroll
        for (int i = 0; i < 16; ++i) { const float p = __builtin_amdgcn_exp2f(fsub_s(s[kb][i], m_run)); s[kb][i] = p; ps = fadd_s(ps, p); }
    l_run += ps;
    bf16x8 pf[4];
#pragma unroll
    for (int ks = 0; ks < 4; ++ks) { const int kb = ks >> 1, b8 = 8 * (ks & 1); u32x4 w;
        w.x = cvtpk_s(s[kb][b8 + 0], s[kb][b8 + 1]); w.y = cvtpk_s(s[kb][b8 + 2], s[kb][b8 + 3]); w.z = cvtpk_s(s[kb][b8 + 4], s[kb][b8 + 5]); w.w = cvtpk_s(s[kb][b8 + 6], s[kb][b8 + 7]);
        pf[ks] = __builtin_bit_cast(bf16x8, w); }
    const unsigned blk = (lane >> 4) & 1, q4 = (lane & 15) >> 2, p4 = lane & 3;
#pragma unroll
    for (int c = 0; c < 4; ++c)
#pragma unroll
        for (int ks = 0; ks < 4; ++ks) {
            ALAS const unsigned char* a0 = vbuf + off_b(16 * ks + 8 * h + q4, 4 * c + 2 * blk + (p4 >> 1)) + 8 * (p4 & 1);
            ALAS const unsigned char* a1 = vbuf + off_b(16 * ks + 8 * h + 4 + q4, 4 * c + 2 * blk + (p4 >> 1)) + 8 * (p4 & 1);
            const s16x4 lo = vtr(a0), hi = vtr(a1);
            const bf16x8 vf = (bf16x8){lo[0], lo[1], lo[2], lo[3], hi[0], hi[1], hi[2], hi[3]};
            o[c] = __builtin_amdgcn_mfma_f32_32x32x16_bf16(vf, pf[ks], o[c], 0, 0, 0);
        }
}

struct Tensors { const bf16* q; const bf16* k; const bf16* v; bf16* o; const float* lf; const float* rel_bias; };

template <int MODE>
__device__ __forceinline__ void attn_item(ALAS unsigned char* lds, const Tensors& T, int b, int hd, int blk) {
    int tid_l = threadIdx.x; asm volatile("" : "+v"(tid_l));
    const int tid = tid_l, lane = tid & 63, w = __builtin_amdgcn_readfirstlane(tid >> 6), r = lane & 31, h = lane >> 5;
    if (MODE == 0) {
        ALAS float* bt = (ALAS float*)(lds + OFF_BIAS);
        for (int i = tid; i < 513; i += 512) bt[i] = T.rel_bias[hd * 513 + i] * LOG2E;
    } else {
        ALAS float* negF = (ALAS float*)(lds + OFF_NEGF); ALAS float* wsum = (ALAS float*)(lds + OFF_MISC + 64);
        float v[4];
#pragma unroll
        for (int e = 0; e < 4; ++e) v[e] = T.lf[((size_t)(b * SEQ + 4 * tid + e)) * 8 + hd];
        v[1] += v[0]; v[2] += v[1]; v[3] += v[2];
        const float tot = v[3]; float x = tot;
#pragma unroll
        for (int o_ = 1; o_ < 64; o_ <<= 1) { const float y = __shfl_up(x, o_); if (lane >= o_) x += y; }
        if (lane == 63) wsum[w] = x;
        __syncthreads();
        float offs = x - tot;
        for (int j = 0; j < w; ++j) offs += wsum[j];
#pragma unroll
        for (int e = 0; e < 4; ++e) negF[4 * tid + e] = -(v[e] + offs) * LOG2E;
    }
    const int qt = 4 * blk + (w >> 1);
    const int t_lo = (MODE == 0) ? (4 * blk - 8 > 0 ? 4 * blk - 8 : 0) : 0, t_hi = 4 * blk + 3;
    const int w_lo = (MODE == 0) ? qt - 8 : 0, w_hi = qt;
    const int tokq = b * SEQ + 64 * qt + 32 * (w & 1) + r;
    bf16x8 qf[8];
#pragma unroll
    for (int ks = 0; ks < 8; ++ks) qf[ks] = *(const bf16x8*)(T.q + (size_t)tokq * ROWP + hd * HD + 16 * ks + 8 * h);
    f32x16 o[4];
#pragma unroll
    for (int c = 0; c < 4; ++c)
#pragma unroll
        for (int i = 0; i < 16; ++i) o[c][i] = 0.f;
    float m_run = -1e30f, l_run = 0.f;
    const bf16* Kg = T.k + hd * HD; const bf16* Vg = T.v + hd * HD;
    TileRegs R;
    tile_gload(R, Kg, Vg, b * SEQ + 64 * t_lo, tid);
    tile_lstore(R, lds + OFF_K, lds + OFF_V, tid);
    __syncthreads();
    int cur = 0;
    for (int t = t_lo; t <= t_hi; ++t) {
        const bool more = t < t_hi;
        if (more) tile_gload(R, Kg, Vg, b * SEQ + 64 * (t + 1), tid);
        if (t >= w_lo && t <= w_hi) {
            const int tq = 64 * qt + 32 * (w & 1) + r;
            tile_compute<MODE>(o, m_run, l_run, qf, lds, lds + OFF_K + cur * 16384, lds + OFF_V + cur * 16384, lane,
                               tq - 64 * t - 8 * h, (qt - t) >= 5, 64 * t + 8 * h, t == qt, tq - 64 * t - 8 * h);
        }
        if (more) tile_lstore(R, lds + OFF_K + (cur ^ 1) * 16384, lds + OFF_V + (cur ^ 1) * 16384, tid);
        __syncthreads();
        cur ^= 1;
    }
    float l_tot = l_run; { auto rr = __builtin_amdgcn_permlane32_swap(__float_as_uint(l_run), __float_as_uint(l_run), false, false); l_tot = __uint_as_float(rr[0]) + __uint_as_float(rr[1]); }
    const float inv = 1.0f / l_tot;
    ALAS unsigned char* stg = lds + w * 8704;
#pragma unroll
    for (int c = 0; c < 4; ++c)
#pragma unroll
        for (int g = 0; g < 4; ++g) { u32x2 wv; wv.x = cvtpk_s(o[c][4 * g] * inv, o[c][4 * g + 1] * inv); wv.y = cvtpk_s(o[c][4 * g + 2] * inv, o[c][4 * g + 3] * inv);
            *(ALAS u32x2*)(stg + r * 272 + (32 * c + 8 * g + 4 * h) * 2) = wv; }
    asm volatile("s_waitcnt lgkmcnt(0)" ::: "memory");
    const int tok0 = b * SEQ + 64 * qt + 32 * (w & 1);
#pragma unroll
    for (int j = 0; j < 8; ++j) { const int row = (lane >> 4) + 4 * j, ch = lane & 15;
        const u32x4 v = *(ALAS const u32x4*)(stg + row * 272 + ch * 16);
        *(u32x4*)(T.o + (size_t)(tok0 + row) * 2048 + hd * HD + ch * 8) = v; }
}
}
typedef unsigned short bf16;
typedef float f32x4 __attribute__((ext_vector_type(4)));
typedef unsigned v4u __attribute__((ext_vector_type(4)));
typedef unsigned v2u __attribute__((ext_vector_type(2)));
constexpr int NWAVES = 8, NTHR = 512;
constexpr int M = 8192, D = 2048, FF = 5632, NGU = 2 * FF, DIN = 6152, NQKV = 6144, DPLE = 256, SEQ = 2048, NHB = 8;
constexpr size_t MiB = 1u << 20;
constexpr size_t WS_CTL = 0;
constexpr size_t CTL_CNT = 0;
constexpr size_t CTL_SS = 4096;
constexpr size_t CTL_LF = CTL_SS + 5 * (size_t)M * 4;
constexpr size_t CTL_WF = CTL_LF + (size_t)M * 8 * 4;
static_assert(CTL_WF + 8 * (size_t)D * 4 <= MiB, "control region");
constexpr size_t WS_WGU1 = 1 * MiB, WS_WD1 = WS_WGU1 + 44 * MiB, WS_WIN = WS_WD1 + 22 * MiB, WS_WOUT = WS_WIN + 24 * MiB, WS_WGU2 = WS_WOUT + 8 * MiB,
                 WS_WD2 = WS_WGU2 + 44 * MiB, WS_WG = WS_WD2 + 22 * MiB, WS_WP = WS_WG + 8 * MiB, WS_PB = WS_WP + 1 * MiB  , WS_AB = WS_PB + 4 * MiB  ,
                 WS_R1 = WS_AB + 32 * MiB  , WS_H = WS_R1 + 128 * MiB  , WS_END = WS_H + 64 * MiB;
constexpr size_t QKV_T = (size_t)M * 1024;
constexpr int LDS_BYTES = 147456;

__device__ __forceinline__ unsigned f2bf(float f) { unsigned u = __builtin_bit_cast(unsigned, f); return (u + 0x7fffu + ((u >> 16) & 1u)) >> 16; }
__device__ __forceinline__ unsigned pk2(float lo, float hi) { typedef float f2_t __attribute__((ext_vector_type(2))); typedef __bf16 b2_t __attribute__((ext_vector_type(2))); f2_t v = {lo, hi}; b2_t b = __builtin_convertvector(v, b2_t); return __builtin_bit_cast(unsigned, b); }
__device__ __forceinline__ float wave_sum(float v) {
#pragma unroll
    for (int o = 1; o < 64; o <<= 1) v += __shfl_xor(v, o);
    return v;
}
struct ConvRegs { f32x4 v[16]; };
constexpr int LDS_G = 8 * 16896;
__device__ __forceinline__ void conv_load(ConvRegs& R, const float* __restrict__ W, int ldw, int k0, int n0, int lane) {
#pragma unroll
    for (int it = 0; it < 8; ++it) { const int kk = 8 * it + (lane >> 3); const float* src = W + (size_t)(k0 + kk) * ldw + n0 + 4 * (lane & 7);
        R.v[it] = __builtin_nontemporal_load((const f32x4*)src); R.v[8 + it] = __builtin_nontemporal_load((const f32x4*)(src + 32)); }
}
template <bool HAS_G, bool TILED> __device__ __forceinline__ void conv_store(const ConvRegs& R, const LAS float* gl, bf16* WT, int K, int k0, int drowA, int drowB, LAS float* scr, int lane) {
#pragma unroll
    for (int it = 0; it < 8; ++it) { const int kk = 8 * it + (lane >> 3); const float gg = HAS_G ? gl[k0 + kk] : 1.0f; LAS float* s = scr + kk * 33 + 4 * (lane & 7);
        s[0] = R.v[it][0] * gg; s[1] = R.v[it][1] * gg; s[2] = R.v[it][2] * gg; s[3] = R.v[it][3] * gg;
        s[2112 + 0] = R.v[8 + it][0] * gg; s[2112 + 1] = R.v[8 + it][1] * gg; s[2112 + 2] = R.v[8 + it][2] * gg; s[2112 + 3] = R.v[8 + it][3] * gg; }
    asm volatile("s_waitcnt lgkmcnt(0)" ::: "memory");
    const int c = lane & 7;
#pragma unroll
    for (int hf = 0; hf < 2; ++hf)
#pragma unroll
        for (int j = 0; j < 4; ++j) { const int n = (lane >> 3) + 8 * j; const LAS float* s = scr + hf * 2112 + (8 * c) * 33 + n;
            v4u o; o.x = pk2(s[0 * 33], s[1 * 33]); o.y = pk2(s[2 * 33], s[3 * 33]); o.z = pk2(s[4 * 33], s[5 * 33]); o.w = pk2(s[6 * 33], s[7 * 33]);
            const int row = (hf ? drowB : drowA) + n;
            if (TILED) *(v4u*)(WT + ((size_t)(row >> 8) * (K >> 6) + (k0 >> 6)) * 16384 + (size_t)(row & 255) * 64 + 8 * c) = o;
            else *(v4u*)(WT + (size_t)row * K + k0 + 8 * c) = o; }
    asm volatile("s_waitcnt lgkmcnt(0)" ::: "memory");
}
__device__ __forceinline__ int gu_row(int n0) { const int hi = n0 >= FF, n = n0 - (hi ? FF : 0); return 256 * (n >> 7) + (n & 127) + 128 * hi; }
template <bool HAS_G, bool gu, bool PIPE, bool TILED = false> __device__ __forceinline__ void conv_matrix(const float* W, int ldw, const float* g, bf16* WT, int K, int ncols, int wv, int nwv, LAS float* scr, int lane, LAS unsigned char* lds) {
    const LAS float* gl = (const LAS float*)(lds + LDS_G);
    if (HAS_G) { __syncthreads(); for (int i = threadIdx.x; i < K; i += NTHR) ((LAS float*)(lds + LDS_G))[i] = g[i]; __syncthreads(); }
    const int nb = ncols / 64, total = (K / 64) * nb, last = total - 1;
    ConvRegs RA, RB;
    int it = wv;
    if (!PIPE) {
        if (it < total) conv_load(RA, W, ldw, 64 * (it / nb), 64 * (it % nb), lane);
        while (it < total) {
            const int itB = it + nwv, itA2 = itB + nwv;
            if (itB < total) conv_load(RB, W, ldw, 64 * (itB / nb), 64 * (itB % nb), lane);
            { const int n0 = 64 * (it % nb); conv_store<HAS_G, TILED>(RA, gl, WT, K, 64 * (it / nb), gu ? gu_row(n0) : n0, gu ? gu_row(n0 + 32) : n0 + 32, scr, lane); }
            if (itA2 < total) conv_load(RA, W, ldw, 64 * (itA2 / nb), 64 * (itA2 % nb), lane);
            if (itB < total) { const int n0 = 64 * (itB % nb); conv_store<HAS_G, TILED>(RB, gl, WT, K, 64 * (itB / nb), gu ? gu_row(n0) : n0, gu ? gu_row(n0 + 32) : n0 + 32, scr, lane); }
            it = itA2;
        }
        return;
    }
    if (it >= total) return;
    conv_load(RA, W, ldw, 64 * (it / nb), 64 * (it % nb), lane);
    while (it < total) {
        const int itB = (it + nwv < last) ? it + nwv : last, itA2 = (it + 2 * nwv < last) ? it + 2 * nwv : last;
        conv_load(RB, W, ldw, 64 * (itB / nb), 64 * (itB % nb), lane);
        { const int n0 = 64 * (it % nb); conv_store<HAS_G, TILED>(RA, gl, WT, K, 64 * (it / nb), gu ? gu_row(n0) : n0, gu ? gu_row(n0 + 32) : n0 + 32, scr, lane); }
        conv_load(RA, W, ldw, 64 * (itA2 / nb), 64 * (itA2 % nb), lane);
        { const int n0 = 64 * (itB % nb); conv_store<HAS_G, TILED>(RB, gl, WT, K, 64 * (itB / nb), gu ? gu_row(n0) : n0, gu ? gu_row(n0 + 32) : n0 + 32, scr, lane); }
        it += 2 * nwv;
    }
}


constexpr size_t CTL_BAR = 512 * 1024;
static_assert(CTL_WF + 8 * (size_t)D * 4 <= CTL_BAR && CTL_BAR + XCD_BAR_WORDS * 4 <= MiB, "control region");
constexpr size_t CTL_PCNT = CTL_BAR + 16384;
static_assert(CTL_PCNT + 32 * 256 <= MiB, "control region");
constexpr int LDS_XB = LDS_BYTES - 64;
#ifndef USE_TILED
#define USE_TILED false
#endif
#ifndef PHMASK
#define PHMASK 0x3ff
#endif
#define PH_ON(k) (((PHMASK) >> (k)) & 1)
struct Args { const float* in[17]; float* out; unsigned char* ws; };
typedef const __attribute__((address_space(4))) unsigned char* kargp_t;
__device__ __forceinline__ unsigned long long karg64(int i) { kargp_t p = (kargp_t)__builtin_amdgcn_kernarg_segment_ptr(); asm volatile("" : "+s"(p)); return *(const __attribute__((address_space(4))) unsigned long long*)(p + 8 * i); }
#define GAS1 __attribute__((address_space(1)))
#define ARG_IN(i) ((const float*)(const GAS1 float*)karg64(i))
#define ARG_OUT ((float*)(GAS1 float*)karg64(17))
#define ARG_WS ((unsigned char*)(GAS1 unsigned char*)karg64(18))

__global__ void __launch_bounds__(NTHR, 2) fwd_kernel(Args a) {
    extern __shared__ __attribute__((aligned(16))) unsigned char lds_raw[];
    LAS unsigned char* lds = (LAS unsigned char*)lds_raw;
    cg::grid_group grid = cg::this_grid();
    const int G = gridDim.x, bx = blockIdx.x, NGW = G * NWAVES;
    const int G1 = (G == 256) ? 235 : G - (G / 12 > 0 ? G / 12 : 1);
    if (threadIdx.x == 0) { ((volatile LAS unsigned*)(lds + LDS_XB))[0] = 0u; ((volatile LAS unsigned*)(lds + LDS_XB))[1] = 0u; }
    const XcdBarrier xbar = xcd_barrier_post((unsigned*)(ARG_WS + CTL_BAR), (volatile LAS unsigned*)(lds + LDS_XB));
#define TID_DECL int tid_l = threadIdx.x; asm volatile("" : "+v"(tid_l)); const int tid = tid_l, lane = tid & 63, wave = __builtin_amdgcn_readfirstlane(tid >> 6), gw = bx * NWAVES + wave; (void)lane; (void)gw;
#define P_SS(i) ((float*)(ws + CTL_SS) + (size_t)(i) * M)
#define P_LF ((float*)(ws + CTL_LF))
#define P_WF ((float*)(ws + CTL_WF))
#define P_CNT ((unsigned*)(ws + CTL_CNT))
#define P_BF(off) ((bf16*)(ws + (off)))
#define P_ACT P_BF(WS_R1)
#define P_QKV P_BF(WS_R1)
#define P_OB P_BF(WS_R1 + 96 * MiB)
#define P_AB P_BF(WS_AB)
#define P_H ((float*)(ws + WS_H))

    {
    if constexpr (PH_ON(0)) {
        unsigned char* const ws = ARG_WS;
        TID_DECL
        LAS float* scr = (LAS float*)(lds + wave * 16896);
        conv_matrix<true, true, false>(ARG_IN(3), NGU, ARG_IN(2), P_BF(WS_WGU1), D, NGU, gw, NGW, scr, lane, lds);
        for (int m = gw; m < M; m += 2 * NGW) {
            const int m2 = (m + NGW < M) ? m + NGW : m;
            const f32x4* xa = (const f32x4*)(ARG_IN(0) + (size_t)m * D) + lane; const f32x4* xb_ = (const f32x4*)(ARG_IN(0) + (size_t)m2 * D) + lane; f32x4 va[8], vb[8];
#pragma unroll
            for (int j = 0; j < 8; ++j) va[j] = __builtin_nontemporal_load(xa + 64 * j);
#pragma unroll
            for (int j = 0; j < 8; ++j) vb[j] = __builtin_nontemporal_load(xb_ + 64 * j);
            float sa = 0.f, sb = 0.f;
#pragma unroll
            for (int j = 0; j < 8; ++j) { sa += (va[j][0] * va[j][0] + va[j][1] * va[j][1]) + (va[j][2] * va[j][2] + va[j][3] * va[j][3]); sb += (vb[j][0] * vb[j][0] + vb[j][1] * vb[j][1]) + (vb[j][2] * vb[j][2] + vb[j][3] * vb[j][3]); }
            sa = wave_sum(sa); sb = wave_sum(sb); if (lane == 0) { P_SS(0)[m] = sa; P_SS(0)[m2] = sb; }
            v2u* oa = (v2u*)(P_AB + (size_t)m * D) + lane; v2u* ob_ = (v2u*)(P_AB + (size_t)m2 * D) + lane;
#pragma unroll
            for (int j = 0; j < 8; ++j) { v2u o; o.x = pk2(va[j][0], va[j][1]); o.y = pk2(va[j][2], va[j][3]); oa[64 * j] = o; }
#pragma unroll
            for (int j = 0; j < 8; ++j) { v2u o; o.x = pk2(vb[j][0], vb[j][1]); o.y = pk2(vb[j][2], vb[j][3]); ob_[64 * j] = o; }
        }
        for (int i = bx * NTHR + tid; i < 4 * M; i += G * NTHR) P_SS(1)[i] = 0.f;
        if (bx == 0 && tid == 0) { P_CNT[0] = 0u; P_CNT[64] = 0u; }
        if (bx == 1) for (int i = tid; i < 32 * 64; i += NTHR) ((unsigned*)(ws + CTL_PCNT))[i] = 0u;
        for (int i = bx * NTHR + tid; i < 8 * D; i += G * NTHR) { const int j = i / D, k = i % D; P_WF[i] = ARG_IN(5)[k] * ARG_IN(6)[(size_t)k * DIN + NQKV + j]; }
    }
    }
    if (ARG_WS == nullptr) grid.sync();
    xcd_barrier(xbar);

    {
    if constexpr (PH_ON(1)) {
        unsigned char* const ws = ARG_WS;
        if (bx < G1) { pg8::Gemm g{P_AB, P_BF(WS_WGU1), M, NGU, D}; pg8::StaticOrder S; S.init(M, NGU, G1, bx);
          pg8::EpiSwiglu E{P_ACT, P_SS(0)};
          pg8::gemm_phase<pg8::EpiSwiglu, pg8::StaticOrder, true, true>(lds, g, S, E); }
        else {
            TID_DECL
            LAS float* scr = (LAS float*)(lds + wave * 16896); const int wv = (bx - G1) * NWAVES + wave, nwv = (G - G1) * NWAVES;
            conv_matrix<false, false, true, USE_TILED>(ARG_IN(4), D, nullptr, P_BF(WS_WD1), FF, D, wv, nwv, scr, lane, lds);
            conv_matrix<false, false, true>(ARG_IN(15), D, nullptr, P_BF(WS_WP), DPLE, D, wv, nwv, scr, lane, lds);
            conv_matrix<true, false, true>(ARG_IN(6), DIN, ARG_IN(5), P_BF(WS_WIN), D, NQKV, wv, nwv, scr, lane, lds);
            conv_matrix<false, false, true>(ARG_IN(9), D, nullptr, P_BF(WS_WOUT), D, D, wv, nwv, scr, lane, lds);
        }
    }
    }
    xcd_barrier(xbar);
    if constexpr (PH_ON(2)) {
        unsigned char* const ws = ARG_WS;
        pg8::Gemm g{P_ACT, P_BF(WS_WD1), M, D, FF}; pg8::StaticOrder S; S.init(M, D, G, bx);
        pg8::EpiResid<true> E{nullptr, P_AB, P_SS(1), 0.5f, xbar};
        pg8::gemm_phase<pg8::EpiResid<true>, pg8::StaticOrder, false, true, USE_TILED>(lds, g, S, E);
    }
    {
    if constexpr (PH_ON(3)) {
        unsigned char* const ws = ARG_WS;
        TID_DECL
        pg8::Gemm g{P_AB, P_BF(WS_WIN), M, NQKV, D}; pg8::StaticOrder S; S.init(M, NQKV, G, bx);
        pg8::EpiQKV E{P_QKV, P_SS(1), 0.08838834764831845f * 1.4426950408889634f, QKV_T};
        pg8::gemm_phase<pg8::EpiQKV, pg8::StaticOrder, true, true>(lds, g, S, E);
        for (int m = gw; m < M; m += 2 * NGW) {
            const int m2 = (m + NGW < M) ? m + NGW : m;
            const v2u* hra = (const v2u*)(P_AB + (size_t)m * D) + lane; const v2u* hrb = (const v2u*)(P_AB + (size_t)m2 * D) + lane; f32x4 va[8], vb[8];
#pragma unroll
            for (int j = 0; j < 8; ++j) { const v2u w = hra[64 * j]; va[j] = (f32x4){__uint_as_float(w.x << 16), __uint_as_float(w.x & 0xffff0000u), __uint_as_float(w.y << 16), __uint_as_float(w.y & 0xffff0000u)}; }
#pragma unroll
            for (int j = 0; j < 8; ++j) { const v2u w = hrb[64 * j]; vb[j] = (f32x4){__uint_as_float(w.x << 16), __uint_as_float(w.x & 0xffff0000u), __uint_as_float(w.y << 16), __uint_as_float(w.y & 0xffff0000u)}; }
            float sa[8], sb[8];
#pragma unroll
            for (int jj = 0; jj < 8; ++jj) { const f32x4* wr_ = (const f32x4*)(P_WF + (size_t)jj * D) + lane; float a = 0.f, b = 0.f;
#pragma unroll
                for (int j = 0; j < 8; ++j) { const f32x4 wv = wr_[64 * j];
                    a += (va[j][0] * wv[0] + va[j][1] * wv[1]) + (va[j][2] * wv[2] + va[j][3] * wv[3]); b += (vb[j][0] * wv[0] + vb[j][1] * wv[1]) + (vb[j][2] * wv[2] + vb[j][3] * wv[3]); }
                sa[jj] = a; sb[jj] = b; }
            const bool u5 = lane >= 32, u4 = (lane >> 4) & 1, u3 = (lane >> 3) & 1;
#define FRED(s, out) { float b4[4], c2[2]; _Pragma("unroll") for (int k = 0; k < 4; ++k) { const float snd = u5 ? s[k] : s[k + 4]; b4[k] = (u5 ? s[k + 4] : s[k]) + __shfl_xor(snd, 32); } \
                _Pragma("unroll") for (int k = 0; k < 2; ++k) { const float snd = u4 ? b4[k] : b4[k + 2]; c2[k] = (u4 ? b4[k + 2] : b4[k]) + __shfl_xor(snd, 16); } \
                { const float snd = u3 ? c2[0] : c2[1]; out = (u3 ? c2[1] : c2[0]) + __shfl_xor(snd, 8); } out += __shfl_xor(out, 4); out += __shfl_xor(out, 2); out += __shfl_xor(out, 1); }
            float da, db; FRED(sa, da) FRED(sb, db)
#undef FRED
            if ((lane & 7) == 0) { const int jj = lane >> 3; const float bf = ARG_IN(7)[jj];
                const float za = da * pg8::rs_of(P_SS(1), m) + bf, zb = db * pg8::rs_of(P_SS(1), m2) + bf;
                P_LF[(size_t)m * 8 + jj] = fminf(za, 0.f) - log1pf(__expf(-fabsf(za))); P_LF[(size_t)m2 * 8 + jj] = fminf(zb, 0.f) - log1pf(__expf(-fabsf(zb))); }
        }
    }
    xcd_barrier(xbar);
    }
    if constexpr (PH_ON(4)) {
        unsigned char* const ws = ARG_WS;
        TID_DECL
        const int GA = G - 56;
        if (bx >= GA) {
            LAS float* scr = (LAS float*)(lds + wave * 16896); const int wv = (bx - GA) * NWAVES + wave, nwv = (G - GA) * NWAVES;
            conv_matrix<true, true, true>(ARG_IN(11), NGU, ARG_IN(10), P_BF(WS_WGU2), D, NGU, wv, nwv, scr, lane, lds);
            { constexpr int NP4 = M * DPLE / 4; const int t0 = (bx - GA) * NTHR + tid, st = (G - GA) * NTHR;
              for (int i = t0; i < NP4; i += 8 * st) { f32x4 v[8];
#pragma unroll
                for (int q = 0; q < 8; ++q) { const int ii = i + q * st; v[q] = ((const f32x4*)ARG_IN(1))[ii < NP4 ? ii : i]; }
#pragma unroll
                for (int q = 0; q < 8; ++q) { const int ii = i + q * st; if (ii < NP4) { v2u o; o.x = pk2(v[q][0], v[q][1]); o.y = pk2(v[q][2], v[q][3]); ((v2u*)P_BF(WS_PB))[ii] = o; } } } }
            __syncthreads();
        }
        {
        LAS unsigned* slot = (LAS unsigned*)(lds + att::OFF_MISC);
        att::Tensors TA{P_QKV, P_QKV + QKV_T, P_QKV + 2 * QKV_T, P_OB, P_LF, ARG_IN(8)};
        att::Tensors TB{P_QKV + 3 * QKV_T, P_QKV + 4 * QKV_T, P_QKV + 5 * QKV_T, P_OB + 1024, P_LF, ARG_IN(8)};
        { const int rep = 0;
        for (;;) {
            if (tid == 0) slot[0] = atomicAdd(P_CNT + 64 * rep, 1u);
            __syncthreads();
            const int item = (int)slot[0];
            __syncthreads();
            if (item >= 512) break;
            int mode, blk_, bh;
            bh = item % 32; { const int grp = item / 32;
              if (grp < 5) { mode = 1; blk_ = 7 - grp; }
              else if (grp < 11) { mode = 0; blk_ = 12 - grp; }
              else if (grp == 11) { mode = 1; blk_ = 2; }
              else if (grp == 12) { mode = 0; blk_ = 1; }
              else if (grp == 13) { mode = 1; blk_ = 1; }
              else if (grp == 14) { mode = 0; blk_ = 0; }
              else { mode = 1; blk_ = 0; } }
            if (mode) att::attn_item<1>(lds, TB, bh >> 3, bh & 7, blk_); else att::attn_item<0>(lds, TA, bh >> 3, bh & 7, blk_);
        }
        }
        }
    }
    xcd_barrier(xbar);
    if constexpr (PH_ON(5)) {
        unsigned char* const ws = ARG_WS;
        pg8::Gemm g{P_OB, P_BF(WS_WOUT), M, D, D}; pg8::StaticOrder S; S.init(M, D, G, bx);
        pg8::EpiResid<true> E{nullptr, P_AB, P_SS(2), 1.0f, xbar};
        pg8::gemm_phase<pg8::EpiResid<true>, pg8::StaticOrder, false, true>(lds, g, S, E);
    }
    {
    if constexpr (PH_ON(6)) {
        unsigned char* const ws = ARG_WS;
        if (bx < G1) { pg8::Gemm g{P_AB, P_BF(WS_WGU2), M, NGU, D}; pg8::StaticOrder S; S.init(M, NGU, G1, bx);
          pg8::EpiSwiglu E{P_ACT, P_SS(2)};
          pg8::gemm_phase<pg8::EpiSwiglu, pg8::StaticOrder, true, true>(lds, g, S, E); }
        else {
            { int Kpp = DPLE; asm volatile("" : "+s"(Kpp));
              pg8::Gemm g2{P_BF(WS_PB), P_BF(WS_WP), M, D, Kpp}; pg8::StaticOrder S2; S2.init(M, D, G - G1, bx - G1); pg8::EpiBf16Plain E2{P_OB};
              pg8::gemm_phase<pg8::EpiBf16Plain, pg8::StaticOrder, true, true>(lds, g2, S2, E2); }
            TID_DECL
            LAS float* scr = (LAS float*)(lds + wave * 16896); const int wv = (bx - G1) * NWAVES + wave, nwv = (G - G1) * NWAVES;
            conv_matrix<false, false, true, USE_TILED>(ARG_IN(12), D, nullptr, P_BF(WS_WD2), FF, D, wv, nwv, scr, lane, lds);
            conv_matrix<true, false, true>(ARG_IN(14), D, ARG_IN(13), P_BF(WS_WG), D, D, wv, nwv, scr, lane, lds);
        }
    }
    xcd_barrier(xbar);
    }
    if constexpr (PH_ON(7)) {
        unsigned char* const ws = ARG_WS;
        pg8::Gemm g{P_ACT, P_BF(WS_WD2), M, D, FF}; pg8::StaticOrder S; S.init(M, D, G, bx);
        pg8::EpiResid<true> E{nullptr, P_AB, P_SS(3), 0.5f, xbar};
        pg8::gemm_phase<pg8::EpiResid<true>, pg8::StaticOrder, false, true, USE_TILED>(lds, g, S, E);
    }
    if constexpr (PH_ON(8)) {
        unsigned char* const ws = ARG_WS;
        pg8::Gemm g{P_AB, P_BF(WS_WG), M, D, D}; pg8::StaticOrder S; S.init(M, D, G, bx);
        pg8::EpiPleNorm E{P_AB, ARG_OUT, P_SS(3), P_SS(4), ARG_IN(16), (unsigned*)(ws + CTL_PCNT), P_OB};
        pg8::gemm_phase<pg8::EpiPleNorm, pg8::StaticOrder, false, true>(lds, g, S, E);
    }
}

extern "C" void kernel_launch(void* const* d_in, const int* in_sizes, int n_in, void* d_out, int out_size, void* d_ws, size_t ws_size, hipStream_t stream) {
    static int grid = 0;
    if (grid == 0) {
        if (n_in != 17 || out_size != M * D || ws_size < WS_END) { fprintf(stderr, "kernel_launch: unexpected problem (n_in %d, out %d, ws %zu, need %zu)\n", n_in, out_size, ws_size, (size_t)WS_END); grid = -1; return; }
        int dev = 0, cus = 0, per_cu = 0;
        hipGetDevice(&dev); hipDeviceGetAttribute(&cus, hipDeviceAttributeMultiprocessorCount, dev);
        if (hipFuncSetAttribute((const void*)fwd_kernel, hipFuncAttributeMaxDynamicSharedMemorySize, LDS_BYTES) != hipSuccess) { fprintf(stderr, "kernel_launch: hipFuncSetAttribute failed\n"); grid = -1; return; }
        if (hipOccupancyMaxActiveBlocksPerMultiprocessor(&per_cu, (const void*)fwd_kernel, NTHR, LDS_BYTES) != hipSuccess || per_cu < 1) { fprintf(stderr, "kernel_launch: occupancy query says %d\n", per_cu); per_cu = 1; }
        (void)hipGetLastError();
        if (cus != 256) { fprintf(stderr, "kernel_launch: built for a 256-CU device (got %d CUs); nothing launched\n", cus); grid = -1; return; }
        grid = cus;
    }
    if (grid < 0) return;
    Args a{};
    for (int i = 0; i < 17; ++i) a.in[i] = (const float*)d_in[i];
    a.out = (float*)d_out; a.ws = (unsigned char*)d_ws;
    void* args[] = {&a};
    if (hipMemsetAsync((char*)d_ws + CTL_BAR, 0, XCD_BAR_WORDS * 4, stream) != hipSuccess) { fprintf(stderr, "kernel_launch: hipMemsetAsync failed\n"); return; }
    hipError_t e = hipLaunchCooperativeKernel((const void*)fwd_kernel, dim3(grid), dim3(NTHR), args, LDS_BYTES, stream);
    if (e != hipSuccess) fprintf(stderr, "cooperative launch failed: %s (grid %d)\n", hipGetErrorString(e), grid);
}
```

```cpp
#include <hip/hip_runtime.h>
#include <hip/hip_cooperative_groups.h>
#include <cstdio>
#include <cstdint>
namespace cg = cooperative_groups;
#define LAS __attribute__((address_space(3)))
#define XB_TMO      128
#define XB_XCNT(j)  (256  + 64 * (j))
#define XB_XSUB(j)  (1280 + 64 * (j))
#define XB_XGEN(j)  (2304 + 64 * (j))
#define XB_TOP      3328
#define XB_TOPGEN   3392
#define XCD_BAR_WORDS 3456
#define XB_SPIN_CAP (1u << 18)

__device__ __forceinline__ unsigned xb_ld(unsigned* p)              { return __hip_atomic_load(p, __ATOMIC_RELAXED, __HIP_MEMORY_SCOPE_AGENT); }
__device__ __forceinline__ unsigned xb_add(unsigned* p, unsigned v) { return __hip_atomic_fetch_add(p, v, __ATOMIC_RELAXED, __HIP_MEMORY_SCOPE_AGENT); }
__device__ __forceinline__ unsigned xb_xcc_id() { return (unsigned)__builtin_amdgcn_s_getreg((3 << 11) | 20) & 0xFu; }
#define XB_SPIN(cond, bar) do { unsigned _sp = 0; while (cond) { __builtin_amdgcn_s_sleep(1); \
    if ((++_sp & 255u) == 0u) { if (xb_ld(&(bar)[XB_TMO])) break; if (_sp > XB_SPIN_CAP) { atomicAdd(&(bar)[XB_TMO], 1u); break; } } } } while (0)

struct XcdBarrier {
    unsigned* bar; unsigned x;
    volatile LAS unsigned* st;
};

__device__ __forceinline__ XcdBarrier xcd_barrier_post(unsigned* bar, volatile LAS unsigned* st) {
    XcdBarrier b; b.bar = bar; b.x = xb_xcc_id(); b.st = st;
    if (threadIdx.x == 0) (void)xb_add(&bar[XB_XCNT(b.x)], 1u);
    return b;
}
__device__ __forceinline__ void xcd_barrier_complete(unsigned* bar, unsigned x, unsigned& nloc, unsigned& nx) {
    const unsigned G = gridDim.x * gridDim.y * gridDim.z;
    unsigned sum, cnt, mine, sp = 0u;
    for (;;) {
        sum = 0u; cnt = 0u; mine = 0u;
#pragma unroll
        for (unsigned j = 0; j < 16; ++j) { const unsigned c = xb_ld(&bar[XB_XCNT(j)]); sum += c; cnt += (c > 0u) ? 1u : 0u; mine = (j == x) ? c : mine; }
        if (sum == G) break;
        __builtin_amdgcn_s_sleep(1);
        if ((++sp & 255u) == 0u) { if (xb_ld(&bar[XB_TMO])) break; if (sp > XB_SPIN_CAP) { atomicAdd(&bar[XB_TMO], 1u); break; } }
    }
    nloc = mine > 0u ? mine : 1u; nx = cnt > 0u ? cnt : 1u;
}

__device__ __forceinline__ void xcd_barrier(const XcdBarrier& b) {
    asm volatile("s_waitcnt vmcnt(0)" ::: "memory");
    __syncthreads();
    if (threadIdx.x == 0) {
        unsigned* bar = b.bar;
        __builtin_amdgcn_s_waitcnt(0);
        unsigned nloc = b.st[0], nx = b.st[1];
        if (nloc == 0u) { xcd_barrier_complete(bar, b.x, nloc, nx); b.st[0] = nloc; b.st[1] = nx; }
        const unsigned old = xb_add(&bar[XB_XSUB(b.x)], 1u);
        const unsigned gen = old / nloc;
        if (old + 1u == (gen + 1u) * nloc) {
            __builtin_amdgcn_fence(__ATOMIC_RELEASE, "agent");
            asm volatile("s_waitcnt vmcnt(0)" ::: "memory");
            const unsigned og = xb_add(&bar[XB_TOP], 1u);
            const unsigned tg = og / nx;
            if (og + 1u == (tg + 1u) * nx) xb_add(&bar[XB_TOPGEN], 1u);
            else XB_SPIN(xb_ld(&bar[XB_TOPGEN]) == tg, bar);
            __builtin_amdgcn_fence(__ATOMIC_ACQUIRE, "agent");
            xb_add(&bar[XB_XGEN(b.x)], 1u);
            asm volatile("s_waitcnt vmcnt(0)" ::: "memory");
        } else {
            XB_SPIN(xb_ld(&bar[XB_XGEN(b.x)]) == gen, bar);
            __builtin_amdgcn_fence(__ATOMIC_ACQUIRE, "agent");
            asm volatile("s_waitcnt vmcnt(0)" ::: "memory");
        }
    }
    __syncthreads();
}

namespace pg8 {
#define PG8_LAS __attribute__((address_space(3)))
typedef unsigned short bf16_t;
typedef short bf16x8 __attribute__((ext_vector_type(8)));
typedef float f32x4 __attribute__((ext_vector_type(4)));
typedef unsigned u32x4 __attribute__((ext_vector_type(4)));
constexpr int BM = 256, BK = 64, HALF = 128, HTB = HALF * BK * 2  , STAGE_BYTES = 8 * HTB, NXCD = 8, WGM = 8;

__host__ __device__ __forceinline__ int lds_byte(int r, int c) { const int st = (r >> 4) * 2 + (c >> 5), rr = r & 15, cc = c & 31, ob = rr * 64 + cc * 2; return st * 1024 + (ob ^ (((ob >> 9) & 1) << 5)); }
__host__ __device__ __forceinline__ void stage_rc(int b, int& R, int& C) { const int st = b / 1024, sb = b % 1024, swz = sb ^ (((sb >> 9) & 1) << 5); R = (st >> 1) * 16 + swz / 64; C = (st & 1) * 32 + (swz % 64) / 2; }
__host__ __device__ __forceinline__ int perm32(int rho) { const int n = rho >> 4, i = rho & 15; return 8 * (i >> 2) + 4 * n + (i & 3); }

struct Unit { int pm, pn; };
struct Gemm { const bf16_t* A; const bf16_t* Bt; int M, N, K; };

struct StaticOrder {
    int nM, nN, nwg, G, c;
    __host__ __device__ void init(int M, int N, int G_, int c_) { nM = M / BM; nN = N / BM; nwg = nM * nN; G = G_; c = c_; }
    __host__ __device__ bool next(int i, Unit& u) const {
        const long L = (long)i * G + c; if (L >= nwg) return false;
        int wgid = (int)L; { const int q = nwg / NXCD, r = nwg % NXCD, xcd = wgid % NXCD, off = wgid / NXCD; wgid = (xcd < r ? xcd * (q + 1) : r * (q + 1) + (xcd - r) * q) + off; }
        const int nig = WGM * nN, gid = wgid / nig, fm = gid * WGM, gsz = (nM - fm) < WGM ? (nM - fm) : WGM;
        u.pm = fm + ((wgid % nig) % gsz); u.pn = (wgid % nig) / gsz; return true;
    }
    __device__ __forceinline__ void a_ready(const Unit&) const {}
    __device__ __forceinline__ void done(const Unit&) const {}
};

__device__ __forceinline__ unsigned cvt_pk_bf16(float lo, float hi) { unsigned r; asm volatile("v_cvt_pk_bf16_f32 %0, %1, %2" : "=v"(r) : "v"(lo), "v"(hi)); return r; }
typedef float f32x2 __attribute__((ext_vector_type(2)));
#ifndef USE_TILED
#define USE_TILED false
#endif
constexpr float RMS_EPS = 1e-6f;
constexpr int DM = 2048, DFF = 5632;
__device__ __forceinline__ float rs_of(const float* ss, int row) { return __builtin_amdgcn_rsqf(ss[row] * (1.0f / 2048.0f) + RMS_EPS); }
__device__ __forceinline__ float silu_f(float a) { return a * __builtin_amdgcn_rcpf(1.0f + __builtin_amdgcn_exp2f(-1.4426950408889634f * a)); }
__device__ __forceinline__ float sigm_f(float a) { return __builtin_amdgcn_rcpf(1.0f + __builtin_amdgcn_exp2f(-1.4426950408889634f * a)); }
__device__ __forceinline__ u32x4 pack8(const f32x4 v0, const f32x4 v1) { u32x4 w; w.x = cvt_pk_bf16(v0[0], v0[1]); w.y = cvt_pk_bf16(v0[2], v0[3]); w.z = cvt_pk_bf16(v1[0], v1[1]); w.w = cvt_pk_bf16(v1[2], v1[3]); return w; }

struct EpiSwiglu {
    static constexpr bool PERM = true, AFTER_DRAIN = false;
    static constexpr bool PRELOAD = true;
    bf16_t* O; const float* ss;
    __device__ __forceinline__ void preload(const Unit& u, int wr, int fr, float (&pre)[8]) const {
#pragma unroll
        for (int i = 0; i < 8; ++i) pre[i] = ss[u.pm * BM + wr * 64 + fr + (i >> 2) * HALF + (i & 3) * 16];
    }
    __device__ __forceinline__ void operator()(const f32x4 (&acc)[2][2][4][2], const Unit& u, int wr, int wc, int fr, int fq, const float (&pre)[8]) const {
        const int row0 = u.pm * BM + wr * 64 + fr, col0 = u.pn * 128 + wc * 32 + 8 * fq;
        float rsv[2][4];
#pragma unroll
        for (int ai = 0; ai < 2; ++ai)
#pragma unroll
            for (int m = 0; m < 4; ++m) rsv[ai][m] = pre[4 * ai + m];
#pragma unroll
        for (int ai = 0; ai < 2; ++ai)
#pragma unroll
            for (int m = 0; m < 4; ++m) {
                const int r = row0 + ai * HALF + m * 16; const float rs = __builtin_amdgcn_rsqf(rsv[ai][m] * (1.0f / 2048.0f) + RMS_EPS);
                f32x4 v[2];
                const float k1 = -1.4426950408889634f * rs, rs2 = rs * rs;
#pragma unroll
                for (int n = 0; n < 2; ++n) { const f32x4 a = acc[ai][0][m][n], b = acc[ai][1][m][n];
#pragma unroll
                    for (int q = 0; q < 4; ++q) v[n][q] = (a[q] * b[q]) * rs2 * __builtin_amdgcn_rcpf(1.0f + __builtin_amdgcn_exp2f(k1 * a[q])); }
                if (USE_TILED) *(u32x4*)(O + ((size_t)(r >> 8) * (DFF / 64) + (col0 >> 6)) * 16384 + (size_t)(r & 255) * 64 + (col0 & 63)) = pack8(v[0], v[1]);
                else *(u32x4*)(O + (size_t)r * DFF + col0) = pack8(v[0], v[1]);
            }
    }
};
template <bool IN_BF16> struct EpiResid {
    static constexpr bool PERM = true, AFTER_DRAIN = true;
    const float* hin; bf16_t* hb; float* ss; float scale; ::XcdBarrier xbar;
    __device__ __forceinline__ void fused(f32x4 (&acc)[2][2][4][2], const Unit& u, int wr, int wc, int fr, int fq, PG8_LAS unsigned char*, int, int) const {
        const int row0 = u.pm * BM + wr * 64 + fr, col0 = u.pn * BM + wc * 32 + 8 * fq;
        f32x4 xv[4][2][2][2];
#define EPIRESID_LOAD(k) _Pragma("unroll") for (int mm = 0; mm < 2; ++mm) _Pragma("unroll") for (int bj = 0; bj < 2; ++bj) { \
            const size_t off_ = (size_t)(row0 + ((k) >> 1) * HALF + (2 * ((k) & 1) + mm) * 16) * DM + col0 + bj * HALF; \
            if (IN_BF16) { const u32x4 w_ = *(const u32x4*)(hb + off_); \
                xv[k][mm][bj][0] = (f32x4){__uint_as_float(w_.x << 16), __uint_as_float(w_.x & 0xffff0000u), __uint_as_float(w_.y << 16), __uint_as_float(w_.y & 0xffff0000u)}; \
                xv[k][mm][bj][1] = (f32x4){__uint_as_float(w_.z << 16), __uint_as_float(w_.z & 0xffff0000u), __uint_as_float(w_.w << 16), __uint_as_float(w_.w & 0xffff0000u)}; } \
            else { xv[k][mm][bj][0] = *(const f32x4*)(hin + off_); xv[k][mm][bj][1] = *(const f32x4*)(hin + off_ + 4); } }
        EPIRESID_LOAD(0)
#pragma unroll
        for (int k = 0; k < 4; ++k) {
            if (k == 0) { EPIRESID_LOAD(1) } else if (k == 1) { EPIRESID_LOAD(2) } else if (k == 2) { EPIRESID_LOAD(3) }
            asm volatile("" ::: "memory");
            const int ai = k >> 1;
#pragma unroll
            for (int mm = 0; mm < 2; ++mm) { const int m = 2 * (k & 1) + mm, r = row0 + ai * HALF + m * 16; float sq = 0.f;
#pragma unroll
                for (int bj = 0; bj < 2; ++bj) { const size_t off = (size_t)r * DM + col0 + bj * HALF;
                    const f32x4 a = xv[k][mm][bj][0] + acc[ai][bj][m][0] * scale, b = xv[k][mm][bj][1] + acc[ai][bj][m][1] * scale;
                    *(u32x4*)(hb + off) = pack8(a, b);
                    sq += (a[0] * a[0] + a[1] * a[1]) + (a[2] * a[2] + a[3] * a[3]) + (b[0] * b[0] + b[1] * b[1]) + (b[2] * b[2] + b[3] * b[3]); }
                sq += __shfl_xor(sq, 16); sq += __shfl_xor(sq, 32);
                if (fq == 0) unsafeAtomicAdd(ss + r, sq); }
            asm volatile("" ::: "memory");
        }
#undef EPIRESID_LOAD
        ::xcd_barrier(xbar);
    }
};
struct EpiQKV {
    static constexpr bool PERM = true, AFTER_DRAIN = false;
    static constexpr bool PRELOAD = true;
    bf16_t* base; const float* ss; float qscale; size_t tstride;
    __device__ __forceinline__ void preload(const Unit& u, int wr, int fr, float (&pre)[8]) const {
#pragma unroll
        for (int i = 0; i < 8; ++i) pre[i] = ss[u.pm * BM + wr * 64 + fr + (i >> 2) * HALF + (i & 3) * 16];
    }
    __device__ __forceinline__ void operator()(const f32x4 (&acc)[2][2][4][2], const Unit& u, int wr, int wc, int fr, int fq, const float (&pre)[8]) const {
        const int t = u.pn >> 2; const float sc = (t == 0 || t == 3) ? qscale : 1.0f;
        const int row0 = u.pm * BM + wr * 64 + fr, col0 = (u.pn & 3) * BM + wc * 32 + 8 * fq; bf16_t* O = base + (size_t)t * tstride;
        float rsv[2][4];
#pragma unroll
        for (int ai = 0; ai < 2; ++ai)
#pragma unroll
            for (int m = 0; m < 4; ++m) rsv[ai][m] = pre[4 * ai + m];
#pragma unroll
        for (int ai = 0; ai < 2; ++ai)
#pragma unroll
            for (int m = 0; m < 4; ++m) {
                const int r = row0 + ai * HALF + m * 16; const float rs = __builtin_amdgcn_rsqf(rsv[ai][m] * (1.0f / 2048.0f) + RMS_EPS) * sc;
#pragma unroll
                for (int bj = 0; bj < 2; ++bj) *(u32x4*)(O + (size_t)r * 1024 + col0 + bj * HALF) = pack8(acc[ai][bj][m][0] * rs, acc[ai][bj][m][1] * rs);
            }
    }
};
struct EpiF32 {
    static constexpr bool PERM = true, AFTER_DRAIN = false;
    float* O;
    __device__ __forceinline__ void operator()(const f32x4 (&acc)[2][2][4][2], const Unit& u, int wr, int wc, int fr, int fq) const {
        const int row0 = u.pm * BM + wr * 64 + fr, col0 = u.pn * BM + wc * 32 + 8 * fq;
#pragma unroll
        for (int ai = 0; ai < 2; ++ai)
#pragma unroll
            for (int m = 0; m < 4; ++m)
            {
#pragma unroll
              for (int bj = 0; bj < 2; ++bj) { float* o = O + (size_t)(row0 + ai * HALF + m * 16) * DM + col0 + bj * HALF; *(f32x4*)o = acc[ai][bj][m][0]; *(f32x4*)(o + 4) = acc[ai][bj][m][1]; } }
    }
};
struct EpiBf16Plain {
    static constexpr bool PERM = true, AFTER_DRAIN = false;
    bf16_t* O;
    __device__ __forceinline__ void operator()(const f32x4 (&acc)[2][2][4][2], const Unit& u, int wr, int wc, int fr, int fq) const {
        const int row0 = u.pm * BM + wr * 64 + fr, col0 = u.pn * BM + wc * 32 + 8 * fq;
#pragma unroll
        for (int ai = 0; ai < 2; ++ai)
#pragma unroll
            for (int m = 0; m < 4; ++m)
#pragma unroll
                for (int bj = 0; bj < 2; ++bj) *(u32x4*)(O + (size_t)(row0 + ai * HALF + m * 16) * DM + col0 + bj * HALF) = pack8(acc[ai][bj][m][0], acc[ai][bj][m][1]);
    }
};
struct EpiPle {
    static constexpr bool PERM = true, AFTER_DRAIN = false;
    const float* hin; float* out; const float* ss3; float* ss4;
    __device__ __forceinline__ void operator()(const f32x4 (&acc)[2][2][4][2], const Unit& u, int wr, int wc, int fr, int fq) const {
        const int row0 = u.pm * BM + wr * 64 + fr, col0 = u.pn * BM + wc * 32 + 8 * fq;
#pragma unroll
        for (int ai = 0; ai < 2; ++ai)
#pragma unroll
            for (int m = 0; m < 4; ++m) {
                const int r = row0 + ai * HALF + m * 16; const float rs = rs_of(ss3, r); float sq = 0.f;
#pragma unroll
                for (int bj = 0; bj < 2; ++bj) { const size_t off = (size_t)r * DM + col0 + bj * HALF;
                    const f32x4 x0 = *(const f32x4*)(hin + off), x1 = *(const f32x4*)(hin + off + 4), p0 = *(const f32x4*)(out + off), p1 = *(const f32x4*)(out + off + 4);
                    const f32x4 a0 = acc[ai][bj][m][0] * rs, a1 = acc[ai][bj][m][1] * rs;
                    const f32x4 g0 = (f32x4){sigm_f(a0[0]), sigm_f(a0[1]), sigm_f(a0[2]), sigm_f(a0[3])}, g1 = (f32x4){sigm_f(a1[0]), sigm_f(a1[1]), sigm_f(a1[2]), sigm_f(a1[3])};
                    const f32x4 y0 = x0 + g0 * p0, y1 = x1 + g1 * p1;
                    *(f32x4*)(out + off) = y0; *(f32x4*)(out + off + 4) = y1;
                    sq += (y0[0] * y0[0] + y0[1] * y0[1]) + (y0[2] * y0[2] + y0[3] * y0[3]) + (y1[0] * y1[0] + y1[1] * y1[1]) + (y1[2] * y1[2] + y1[3] * y1[3]); }
                sq += __shfl_xor(sq, 16); sq += __shfl_xor(sq, 32);
                if (fq == 0) unsafeAtomicAdd(ss4 + r, sq);
            }
    }
};

struct EpiPleNorm {
    static constexpr bool PERM = true, AFTER_DRAIN = true;
    const bf16_t* hbin; float* out; const float* ss3; float* ss4; const float* gfin; unsigned* pcnt; const bf16_t* ppb;
    __device__ __forceinline__ void fused(f32x4 (&acc)[2][2][4][2], const Unit& u, int wr, int wc, int fr, int fq, PG8_LAS unsigned char*, int, int lane) const {
        const int row0 = u.pm * BM + wr * 64 + fr, col0 = u.pn * BM + wc * 32 + 8 * fq;
        float rsv[2][4];
#pragma unroll
        for (int ai = 0; ai < 2; ++ai)
#pragma unroll
            for (int m = 0; m < 4; ++m) rsv[ai][m] = ss3[row0 + ai * HALF + m * 16];
#pragma unroll
        for (int ai = 0; ai < 2; ++ai)
#pragma unroll
            for (int mh = 0; mh < 2; ++mh) {
                f32x4 xv[2][2][2]; u32x4 pw[2][2];
#pragma unroll
                for (int mm = 0; mm < 2; ++mm)
#pragma unroll
                    for (int bj = 0; bj < 2; ++bj) { const size_t off = (size_t)(row0 + ai * HALF + (2 * mh + mm) * 16) * DM + col0 + bj * HALF;
                        const u32x4 w_ = *(const u32x4*)(hbin + off);
                        xv[mm][bj][0] = (f32x4){__uint_as_float(w_.x << 16), __uint_as_float(w_.x & 0xffff0000u), __uint_as_float(w_.y << 16), __uint_as_float(w_.y & 0xffff0000u)};
                        xv[mm][bj][1] = (f32x4){__uint_as_float(w_.z << 16), __uint_as_float(w_.z & 0xffff0000u), __uint_as_float(w_.w << 16), __uint_as_float(w_.w & 0xffff0000u)};
                        pw[mm][bj] = *(const u32x4*)(ppb + off); }
#pragma unroll
                for (int mm = 0; mm < 2; ++mm) { const int m = 2 * mh + mm, r = row0 + ai * HALF + m * 16; const float rs = __builtin_amdgcn_rsqf(rsv[ai][m] * (1.0f / 2048.0f) + RMS_EPS); float sq = 0.f;
#pragma unroll
                    for (int bj = 0; bj < 2; ++bj) {
                        const f32x4 a0 = acc[ai][bj][m][0] * rs, a1 = acc[ai][bj][m][1] * rs;
                        const f32x4 g0 = (f32x4){sigm_f(a0[0]), sigm_f(a0[1]), sigm_f(a0[2]), sigm_f(a0[3])}, g1 = (f32x4){sigm_f(a1[0]), sigm_f(a1[1]), sigm_f(a1[2]), sigm_f(a1[3])};
                        const u32x4 w = pw[mm][bj];
                        const f32x4 p0 = (f32x4){__uint_as_float(w.x << 16), __uint_as_float(w.x & 0xffff0000u), __uint_as_float(w.y << 16), __uint_as_float(w.y & 0xffff0000u)}, p1 = (f32x4){__uint_as_float(w.z << 16), __uint_as_float(w.z & 0xffff0000u), __uint_as_float(w.w << 16), __uint_as_float(w.w & 0xffff0000u)};
                        const f32x4 y0 = xv[mm][bj][0] + g0 * p0, y1 = xv[mm][bj][1] + g1 * p1;
                        acc[ai][bj][m][0] = y0; acc[ai][bj][m][1] = y1;
                        sq += (y0[0] * y0[0] + y0[1] * y0[1]) + (y0[2] * y0[2] + y0[3] * y0[3]) + (y1[0] * y1[0] + y1[1] * y1[1]) + (y1[2] * y1[2] + y1[3] * y1[3]); }
                    sq += __shfl_xor(sq, 16); sq += __shfl_xor(sq, 32);
                    if (fq == 0) unsafeAtomicAdd(ss4 + r, sq); }
            }
        asm volatile("s_waitcnt vmcnt(0)" ::: "memory");
        unsigned* c = pcnt + 64 * u.pm;
        if (lane == 0) __hip_atomic_fetch_add(c, 1u, __ATOMIC_RELAXED, __HIP_MEMORY_SCOPE_AGENT);
        if (wr == 0 && wc == 0) { unsigned sp = 0; while ((unsigned)__builtin_amdgcn_readfirstlane(__hip_atomic_load(c, __ATOMIC_RELAXED, __HIP_MEMORY_SCOPE_AGENT)) < 64u) { __builtin_amdgcn_s_sleep(4); if (++sp > (1u << 21)) break; } }
        asm volatile("s_waitcnt vmcnt(0) lgkmcnt(0)" ::: "memory"); __builtin_amdgcn_s_barrier(); asm volatile("" ::: "memory");
        f32x4 gv[2][2];
#pragma unroll
        for (int bj = 0; bj < 2; ++bj) { gv[bj][0] = *(const f32x4*)(gfin + col0 + bj * HALF); gv[bj][1] = *(const f32x4*)(gfin + col0 + bj * HALF + 4); }
        float s4[2][4];
#pragma unroll
        for (int ai = 0; ai < 2; ++ai)
#pragma unroll
            for (int m = 0; m < 4; ++m) s4[ai][m] = __hip_atomic_load(ss4 + row0 + ai * HALF + m * 16, __ATOMIC_RELAXED, __HIP_MEMORY_SCOPE_AGENT);
#pragma unroll
        for (int ai = 0; ai < 2; ++ai)
#pragma unroll
            for (int m = 0; m < 4; ++m) {
                const int r = row0 + ai * HALF + m * 16;
                const float rs = __builtin_amdgcn_rsqf(s4[ai][m] * (1.0f / 2048.0f) + RMS_EPS);
#pragma unroll
                for (int bj = 0; bj < 2; ++bj) { float* o = out + (size_t)r * DM + col0 + bj * HALF;
                    *(f32x4*)o = acc[ai][bj][m][0] * rs * gv[bj][0]; *(f32x4*)(o + 4) = acc[ai][bj][m][1] * rs * gv[bj][1]; }
            }
    }
};
template <class E_> struct has_preload { template <class T> static constexpr auto test(int) -> decltype(T::PRELOAD, true) { return T::PRELOAD; } template <class> static constexpr bool test(...) { return false; } static constexpr bool value = test<E_>(0); };
template <class Epi, class Sched, bool ALIGN_EPI = false, bool SP2 = false, bool TILED = false  >
__device__ __forceinline__ void gemm_phase(PG8_LAS unsigned char* lds, const Gemm g, const Sched& S, const Epi& E) {
    int tid_l = threadIdx.x; asm volatile("" : "+v"(tid_l));
    const int tid = tid_l, wid = __builtin_amdgcn_readfirstlane(tid >> 6), lane = tid & 63, wr = wid >> 2, wc = wid & 3, fr = lane & 15, fq = lane >> 4;
    const int K = g.K, nt = K / BK;
    unsigned voffA[2], voffB[2];
#pragma unroll
    for (int i = 0; i < 2; ++i) { int R, C; stage_rc(tid * 16 + i * 8192, R, C); const int Rb = Epi::PERM ? ((R & ~31) + perm32(R & 31)) : R;
        voffA[i] = (unsigned)(R * (TILED ? BK : K) + C) * 2u; voffB[i] = (unsigned)(Rb * (TILED ? BK : K) + C) * 2u; }
    const size_t kstep = TILED ? (size_t)(BM * BK * 2) : (size_t)(BK * 2);
    const size_t hstep = TILED ? (size_t)(HALF * BK * 2) : (size_t)HALF * K * 2;
    const size_t tstep = (size_t)BM * K * 2;
    const unsigned ldsw = (unsigned)wid * 1024u;
    const int aoff = lds_byte(wr * 64 + fr, fq * 8), boff = lds_byte(wc * 32 + fr, fq * 8);
#define PG8_SA(b, h) (((b) * 2 + (h)) * HTB)
#define PG8_SB(b, h) ((4 + (b) * 2 + (h)) * HTB)
#define PG8_STAGE(bufoff, gbase, voff) do { _Pragma("unroll") for (int _i = 0; _i < 2; ++_i) \
        __builtin_amdgcn_global_load_lds((const unsigned*)((const char*)(gbase) + (voff)[_i]), (PG8_LAS unsigned*)(lds + (bufoff) + ldsw + _i * 8192), 16, 0, 0); } while (0)
#define PG8_LDA(dst, b, h) do { _Pragma("unroll") for (int m = 0; m < 4; ++m) _Pragma("unroll") for (int k = 0; k < 2; ++k) dst[m][k] = *(const PG8_LAS bf16x8*)(lds + PG8_SA(b, h) + aoff + m * 2048 + k * 1024); } while (0)
#define PG8_LDB(dst, b, h) do { _Pragma("unroll") for (int n = 0; n < 2; ++n) _Pragma("unroll") for (int k = 0; k < 2; ++k) dst[n][k] = *(const PG8_LAS bf16x8*)(lds + PG8_SB(b, h) + boff + n * 2048 + k * 1024); } while (0)
#define PG8_MMA(ai, bj, At, Bt) do { __builtin_amdgcn_s_setprio(1); _Pragma("unroll") for (int m = 0; m < 4; ++m) _Pragma("unroll") for (int n = 0; n < 2; ++n) _Pragma("unroll") for (int k = 0; k < 2; ++k) \
        acc[ai][bj][m][n] = __builtin_amdgcn_mfma_f32_16x16x32_bf16(Bt[n][k], At[m][k], acc[ai][bj][m][n], 0, 0, 0); __builtin_amdgcn_s_setprio(0); } while (0)
#define PG8_WAIT_V(n) asm volatile("s_waitcnt vmcnt(" #n ")" ::: "memory")
#define PG8_WAIT_L(n) asm volatile("s_waitcnt lgkmcnt(" #n ")" ::: "memory")
#define PG8_BAR __builtin_amdgcn_s_barrier()
#define PG8_SCHED __builtin_amdgcn_sched_barrier(0)
    Unit cur, nxt; int ui = 0;
    if (!S.next(0, cur)) return;
    f32x4 acc[2][2][4][2];
#pragma unroll
    for (int a = 0; a < 2; ++a)
#pragma unroll
        for (int b = 0; b < 2; ++b)
#pragma unroll
            for (int m = 0; m < 4; ++m)
#pragma unroll
                for (int n = 0; n < 2; ++n) acc[a][b][m][n] = (f32x4){0.f, 0.f, 0.f, 0.f};
    bf16x8 At[4][2], B0[2][2], B1[2][2];
    const char* cA = (const char*)g.A + (size_t)cur.pm * tstep; const char* cB = (const char*)g.Bt + (size_t)cur.pn * tstep;
    S.a_ready(cur);
    float pre[8];
    if constexpr (has_preload<Epi>::value) E.preload(cur, wr, fr, pre);
    if constexpr (SP2) {
        PG8_STAGE(PG8_SB(0, 0), cB, voffB); PG8_STAGE(PG8_SB(0, 1), cB + hstep, voffB); PG8_STAGE(PG8_SA(0, 0), cA, voffA); PG8_STAGE(PG8_SA(0, 1), cA + hstep, voffA);
        if (wr == 1) PG8_BAR;
        PG8_WAIT_V(2); PG8_BAR;
        PG8_STAGE(PG8_SB(1, 0), cB + kstep, voffB); PG8_STAGE(PG8_SA(1, 0), cA + kstep, voffA); PG8_STAGE(PG8_SB(1, 1), cB + hstep + kstep, voffB);
        PG8_WAIT_V(6); PG8_BAR;
    } else {
        PG8_STAGE(PG8_SB(0, 0), cB, voffB); PG8_STAGE(PG8_SA(0, 0), cA, voffA); PG8_STAGE(PG8_SB(0, 1), cB + hstep, voffB); PG8_STAGE(PG8_SA(0, 1), cA + hstep, voffA);
        if (wr == 1) PG8_BAR;
        PG8_WAIT_V(4); PG8_BAR;
        PG8_STAGE(PG8_SB(1, 0), cB + kstep, voffB); PG8_STAGE(PG8_SA(1, 0), cA + kstep, voffA); PG8_STAGE(PG8_SB(1, 1), cB + hstep + kstep, voffB);
        PG8_WAIT_V(6); PG8_BAR;
    }
    for (;;) {
        const bool has_next = S.next(ui + 1, nxt);
        const char* nA = has_next ? (const char*)g.A + (size_t)nxt.pm * tstep : cA; const char* nB = has_next ? (const char*)g.Bt + (size_t)nxt.pn * tstep : cB;
        for (int t = 0; t < nt; t += 2) {
            const bool last = (t == nt - 2);
            const char* a1 = cA + (size_t)(t + 1) * kstep;
            const char* a2 = last ? nA : cA + (size_t)(t + 2) * kstep; const char* b2 = last ? nB : cB + (size_t)(t + 2) * kstep;
            const char* a3 = a2 + kstep; const char* b3 = b2 + kstep;
            if (last && has_next) S.a_ready(nxt);
            if constexpr (SP2) {
            PG8_LDB(B0, 0, 0); PG8_LDB(B1, 0, 1); PG8_SCHED; PG8_LDA(At, 0, 0); PG8_STAGE(PG8_SA(1, 1), a1 + hstep, voffA);
            PG8_WAIT_V(8); PG8_WAIT_L(0); PG8_BAR; PG8_MMA(0, 0, At, B0); PG8_MMA(0, 1, At, B1); PG8_BAR; PG8_SCHED;
            PG8_LDA(At, 0, 1); PG8_STAGE(PG8_SB(0, 0), b2, voffB); PG8_STAGE(PG8_SB(0, 1), b2 + hstep, voffB); PG8_STAGE(PG8_SA(0, 0), a2, voffA);
            PG8_WAIT_V(8); PG8_WAIT_L(0); PG8_BAR; PG8_MMA(1, 0, At, B0); PG8_MMA(1, 1, At, B1); PG8_BAR; PG8_SCHED;
            PG8_LDB(B0, 1, 0); PG8_LDB(B1, 1, 1); PG8_SCHED; PG8_LDA(At, 1, 0); PG8_STAGE(PG8_SA(0, 1), a2 + hstep, voffA);
            PG8_WAIT_V(8); PG8_WAIT_L(0); PG8_BAR; PG8_MMA(0, 0, At, B0); PG8_MMA(0, 1, At, B1); PG8_BAR; PG8_SCHED;
            PG8_LDA(At, 1, 1); PG8_STAGE(PG8_SB(1, 0), b3, voffB); PG8_STAGE(PG8_SB(1, 1), b3 + hstep, voffB); PG8_STAGE(PG8_SA(1, 0), a3, voffA);
            PG8_WAIT_V(8); PG8_WAIT_L(0); PG8_BAR; PG8_MMA(1, 0, At, B0); PG8_MMA(1, 1, At, B1); PG8_BAR; PG8_SCHED;
            } else {
            PG8_LDB(B0, 0, 0); PG8_SCHED; PG8_LDA(At, 0, 0); PG8_STAGE(PG8_SA(1, 1), a1 + hstep, voffA);
            PG8_WAIT_L(8); PG8_BAR; PG8_WAIT_L(0); PG8_MMA(0, 0, At, B0); PG8_BAR; PG8_SCHED;
            PG8_LDB(B1, 0, 1); PG8_STAGE(PG8_SB(0, 0), b2, voffB);
            PG8_BAR; PG8_WAIT_L(0); PG8_MMA(0, 1, At, B1); PG8_BAR;
            PG8_LDA(At, 0, 1); PG8_STAGE(PG8_SA(0, 0), a2, voffA);
            PG8_BAR; PG8_WAIT_L(0); PG8_MMA(1, 0, At, B0); PG8_BAR; PG8_SCHED;
            PG8_STAGE(PG8_SB(0, 1), b2 + hstep, voffB);
            PG8_WAIT_V(6); PG8_BAR; PG8_MMA(1, 1, At, B1); PG8_BAR;
            PG8_LDB(B0, 1, 0); PG8_SCHED; PG8_LDA(At, 1, 0); PG8_STAGE(PG8_SA(0, 1), a2 + hstep, voffA);
            PG8_WAIT_L(8); PG8_BAR; PG8_WAIT_L(0); PG8_MMA(0, 0, At, B0); PG8_BAR; PG8_SCHED;
            PG8_LDB(B1, 1, 1); PG8_STAGE(PG8_SB(1, 0), b3, voffB);
            PG8_BAR; PG8_WAIT_L(0); PG8_MMA(0, 1, At, B1); PG8_BAR;
            PG8_LDA(At, 1, 1); PG8_STAGE(PG8_SA(1, 0), a3, voffA);
            PG8_BAR; PG8_WAIT_L(0); PG8_MMA(1, 0, At, B0); PG8_BAR; PG8_SCHED;
            PG8_STAGE(PG8_SB(1, 1), b3 + hstep, voffB);
            PG8_WAIT_V(6); PG8_BAR; PG8_MMA(1, 1, At, B1); PG8_BAR;
            }
        }
        if constexpr (ALIGN_EPI) { if (wr == 0) PG8_BAR; }
        if constexpr (!Epi::AFTER_DRAIN) { if constexpr (has_preload<Epi>::value) E(acc, cur, wr, wc, fr, fq, pre); else E(acc, cur, wr, wc, fr, fq); S.done(cur); }
        if (!has_next) break;
#pragma unroll
        for (int a = 0; a < 2; ++a)
#pragma unroll
            for (int b = 0; b < 2; ++b)
#pragma unroll
                for (int m = 0; m < 4; ++m)
#pragma unroll
                    for (int n = 0; n < 2; ++n) acc[a][b][m][n] = (f32x4){0.f, 0.f, 0.f, 0.f};
        cur = nxt; cA = nA; cB = nB; ++ui;
        if constexpr (has_preload<Epi>::value) E.preload(cur, wr, fr, pre);
        if constexpr (ALIGN_EPI) { if (wr == 1) PG8_BAR; }
    }
    PG8_WAIT_V(0);
    if constexpr (!ALIGN_EPI) { if (wr == 0) PG8_BAR; }
    PG8_BAR;
    if constexpr (Epi::AFTER_DRAIN) { E.fused(acc, cur, wr, wc, fr, fq, lds, wid, lane); S.done(cur); }
#undef PG8_SA
#undef PG8_SB
#undef PG8_STAGE
#undef PG8_LDA
#undef PG8_LDB
#undef PG8_MMA
#undef PG8_WAIT_V
#undef PG8_WAIT_L
#undef PG8_BAR
#undef PG8_SCHED
}
}
namespace att {
#define ALAS __attribute__((address_space(3)))
typedef unsigned short bf16;
typedef short bf16x8 __attribute__((ext_vector_type(8)));
typedef short s16x4 __attribute__((ext_vector_type(4)));
typedef float f32x16 __attribute__((ext_vector_type(16)));
typedef float f32x4 __attribute__((ext_vector_type(4)));
typedef unsigned u32x4 __attribute__((ext_vector_type(4)));
typedef unsigned u32x2 __attribute__((ext_vector_type(2)));
typedef float f32x2_t __attribute__((ext_vector_type(2))); typedef __bf16 bf16x2_t __attribute__((ext_vector_type(2)));
constexpr int SEQ = 2048, NB = 4, NH = 8, HD = 128, ROWP = 1024;
constexpr int OFF_K = 0, OFF_V = 32768, OFF_NEGF = 65536, OFF_BIAS = 65536 + 8192, OFF_MISC = OFF_BIAS + 2304;
constexpr float LOG2E = 1.4426950408889634f;
__device__ __forceinline__ unsigned off_b(unsigned row, unsigned ch) { return 256u * row + 16u * (ch ^ (((row & 3u) << 2) | ((row >> 2) & 3u))); }
__device__ __forceinline__ unsigned cvtpk_s(float lo, float hi) { f32x2_t v = {lo, hi}; bf16x2_t b = __builtin_convertvector(v, bf16x2_t); return __builtin_bit_cast(unsigned, b); }
__device__ __forceinline__ float fadd_s(float x, float y) { float r = x + y; asm("" : "+v"(r)); return r; }
__device__ __forceinline__ float fsub_s(float x, float y) { float r = x - y; asm("" : "+v"(r)); return r; }
__device__ __forceinline__ float fmul_s(float x, float y) { float r = x * y; asm("" : "+v"(r)); return r; }
__device__ __forceinline__ s16x4 vtr(ALAS const unsigned char* p) { return __builtin_bit_cast(s16x4, __builtin_amdgcn_ds_read_tr16_b64_v4i16((ALAS s16x4*)p)); }

struct TileRegs { u32x4 k[2], v[2]; };
__device__ __forceinline__ void tile_gload(TileRegs& R, const bf16* Kg, const bf16* Vg, int tok0, int tid) {
#pragma unroll
    for (int i = 0; i < 2; ++i) { const int id = tid + 512 * i, row = id >> 4, ch = id & 15; const size_t o = (size_t)(tok0 + row) * ROWP + ch * 8;
        R.k[i] = *(const u32x4*)(Kg + o); R.v[i] = *(const u32x4*)(Vg + o); }
}
__device__ __forceinline__ void tile_lstore(const TileRegs& R, ALAS unsigned char* kbuf, ALAS unsigned char* vbuf, int tid) {
#pragma unroll
    for (int i = 0; i < 2; ++i) { const int id = tid + 512 * i, row = id >> 4, ch = id & 15; const unsigned o = off_b(row, ch);
        *(ALAS u32x4*)(kbuf + o) = R.k[i]; *(ALAS u32x4*)(vbuf + o) = R.v[i]; }
}

template <int MODE>
__device__ __forceinline__ void tile_compute(f32x16 (&o)[4], float& m_run, float& l_run, const bf16x8 (&qf)[8], ALAS const unsigned char* lds, ALAS const unsigned char* kbuf, ALAS const unsigned char* vbuf,
                                             int lane, int rel0  , bool cst  , int key0  , bool diag, int tloc  ) {
    const int r = lane & 31, h = lane >> 5;
    const int kap = (r & 0x13) | ((r & 4) << 1) | ((r & 8) >> 1);
    f32x16 s[2];
    if (MODE == 1) {
        ALAS const float* nf = (ALAS const float*)(lds + OFF_NEGF) + key0;
#pragma unroll
        for (int kb = 0; kb < 2; ++kb)
#pragma unroll
            for (int g = 0; g < 4; ++g) { const f32x4 f = *(ALAS const f32x4*)(nf + 32 * kb + 4 * (g & 1) + 16 * (g >> 1));
#pragma unroll
                for (int e = 0; e < 4; ++e) s[kb][4 * g + e] = f[e]; }
    } else {
        const float c = cst ? ((ALAS const float*)(lds + OFF_BIAS))[512] : 0.f;
#pragma unroll
        for (int i = 0; i < 16; ++i) { s[0][i] = c; s[1][i] = c; }
    }
#pragma unroll
    for (int ks = 0; ks < 8; ++ks) {
        const bf16x8 k0 = *(ALAS const bf16x8*)(kbuf + off_b(kap, 2 * ks + h));
        const bf16x8 k1 = *(ALAS const bf16x8*)(kbuf + 8192 + off_b(kap, 2 * ks + h));
        s[0] = __builtin_amdgcn_mfma_f32_32x32x16_bf16(k0, qf[ks], s[0], 0, 0, 0);
        s[1] = __builtin_amdgcn_mfma_f32_32x32x16_bf16(k1, qf[ks], s[1], 0, 0, 0);
    }
    if (MODE == 0) {
        if (!cst) { ALAS const float* bt = (ALAS const float*)(lds + OFF_BIAS);
#pragma unroll
            for (int kb = 0; kb < 2; ++kb)
#pragma unroll
                for (int i = 0; i < 16; ++i) { int rel = rel0 - 32 * kb - (i & 7) - 16 * (i >> 3); rel = rel < 256 ? rel : 256; rel = rel > -256 ? rel : -256; s[kb][i] = fadd_s(s[kb][i], bt[rel + 256]); }
        }
    } else if (diag) {
#pragma unroll
        for (int kb = 0; kb < 2; ++kb)
#pragma unroll
            for (int i = 0; i < 16; ++i) if (32 * kb + (i & 7) + 16 * (i >> 3) > tloc) s[kb][i] = -INFINITY;
    }
    float mx = s[0][0];
#pragma unroll
    for (int i = 1; i < 16; ++i) mx = fmaxf(mx, s[0][i]);
#pragma unroll
    for (int i = 0; i < 16; ++i) mx = fmaxf(mx, s[1][i]);
    { auto rr = __builtin_amdgcn_permlane32_swap(__float_as_uint(mx), __float_as_uint(mx), false, false); mx = fmaxf(__uint_as_float(rr[0]), __uint_as_float(rr[1])); }
    constexpr float RESC_THR = 10.0f;
    if (__builtin_amdgcn_ballot_w64(mx > m_run + RESC_THR) != 0ull) {
        const float m_new = fmaxf(m_run, mx), alpha = __builtin_amdgcn_exp2f(m_run - m_new);
        m_run = m_new; l_run *= alpha;
#pragma unroll
        for (int c = 0; c < 4; ++c)
#pragma unroll
            for (int i = 0; i < 16; ++i) o[c][i] = fmul_s(o[c][i], alpha);
    }
    float ps = 0.f;
#pragma unroll
    for (int kb = 0; kb < 2; ++kb)
#pragma unroll
        for (int i = 0; i < 16; ++i) { const float p = __builtin_amdgcn_exp2f(fsub_s(s[kb][i], m_run)); s[kb][i] = p; ps = fadd_s(ps, p); }
    l_run += ps;
    bf16x8 pf[4];
#pragma unroll
    for (int ks = 0; ks < 4; ++ks) { const int kb = ks >> 1, b8 = 8 * (ks & 1); u32x4 w;
        w.x = cvtpk_s(s[kb][b8 + 0], s[kb][b8 + 1]); w.y = cvtpk_s(s[kb][b8 + 2], s[kb][b8 + 3]); w.z = cvtpk_s(s[kb][b8 + 4], s[kb][b8 + 5]); w.w = cvtpk_s(s[kb][b8 + 6], s[kb][b8 + 7]);
        pf[ks] = __builtin_bit_cast(bf16x8, w); }
    const unsigned blk = (lane >> 4) & 1, q4 = (lane & 15) >> 2, p4 = lane & 3;
#pragma unroll
    for (int c = 0; c < 4; ++c)
#pragma unroll
        for (int ks = 0; ks < 4; ++ks) {
            ALAS const unsigned char* a0 = vbuf + off_b(16 * ks + 8 * h + q4, 4 * c + 2 * blk + (p4 >> 1)) + 8 * (p4 & 1);
            ALAS const unsigned char* a1 = vbuf + off_b(16 * ks + 8 * h + 4 + q4, 4 * c + 2 * blk + (p4 >> 1)) + 8 * (p4 & 1);
            const s16x4 lo = vtr(a0), hi = vtr(a1);
            const bf16x8 vf = (bf16x8){lo[0], lo[1], lo[2], lo[3], hi[0], hi[1], hi[2], hi[3]};
            o[c] = __builtin_amdgcn_mfma_f32_32x32x16_bf16(vf, pf[ks], o[c], 0, 0, 0);
        }
}

struct Tensors { const bf16* q; const bf16* k; const bf16* v; bf16* o; const float* lf; const float* rel_bias; };

template <int MODE>
__device__ __forceinline__ void attn_item(ALAS unsigned char* lds, const Tensors& T, int b, int hd, int blk) {
    int tid_l = threadIdx.x; asm volatile("" : "+v"(tid_l));
    const int tid = tid_l, lane = tid & 63, w = __builtin_amdgcn_readfirstlane(tid >> 6), r = lane & 31, h = lane >> 5;
    if (MODE == 0) {
        ALAS float* bt = (ALAS float*)(lds + OFF_BIAS);
        for (int i = tid; i < 513; i += 512) bt[i] = T.rel_bias[hd * 513 + i] * LOG2E;
    } else {
        ALAS float* negF = (ALAS float*)(lds + OFF_NEGF); ALAS float* wsum = (ALAS float*)(lds + OFF_MISC + 64);
        float v[4];
#pragma unroll
        for (int e = 0; e < 4; ++e) v[e] = T.lf[((size_t)(b * SEQ + 4 * tid + e)) * 8 + hd];
        v[1] += v[0]; v[2] += v[1]; v[3] += v[2];
        const float tot = v[3]; float x = tot;
#pragma unroll
        for (int o_ = 1; o_ < 64; o_ <<= 1) { const float y = __shfl_up(x, o_); if (lane >= o_) x += y; }
        if (lane == 63) wsum[w] = x;
        __syncthreads();
        float offs = x - tot;
        for (int j = 0; j < w; ++j) offs += wsum[j];
#pragma unroll
        for (int e = 0; e < 4; ++e) negF[4 * tid + e] = -(v[e] + offs) * LOG2E;
    }
    const int qt = 4 * blk + (w >> 1);
    const int t_lo = (MODE == 0) ? (4 * blk - 8 > 0 ? 4 * blk - 8 : 0) : 0, t_hi = 4 * blk + 3;
    const int w_lo = (MODE == 0) ? qt - 8 : 0, w_hi = qt;
    const int tokq = b * SEQ + 64 * qt + 32 * (w & 1) + r;
    bf16x8 qf[8];
#pragma unroll
    for (int ks = 0; ks < 8; ++ks) qf[ks] = *(const bf16x8*)(T.q + (size_t)tokq * ROWP + hd * HD + 16 * ks + 8 * h);
    f32x16 o[4];
#pragma unroll
    for (int c = 0; c < 4; ++c)
#pragma unroll
        for (int i = 0; i < 16; ++i) o[c][i] = 0.f;
    float m_run = -1e30f, l_run = 0.f;
    const bf16* Kg = T.k + hd * HD; const bf16* Vg = T.v + hd * HD;
    TileRegs R;
    tile_gload(R, Kg, Vg, b * SEQ + 64 * t_lo, tid);
    tile_lstore(R, lds + OFF_K, lds + OFF_V, tid);
    __syncthreads();
    int cur = 0;
    for (int t = t_lo; t <= t_hi; ++t) {
        const bool more = t < t_hi;
        if (more) tile_gload(R, Kg, Vg, b * SEQ + 64 * (t + 1), tid);
        if (t >= w_lo && t <= w_hi) {
            const int tq = 64 * qt + 32 * (w & 1) + r;
            tile_compute<MODE>(o, m_run, l_run, qf, lds, lds + OFF_K + cur * 16384, lds + OFF_V + cur * 16384, lane,
                               tq - 64 * t - 8 * h, (qt - t) >= 5, 64 * t + 8 * h, t == qt, tq - 64 * t - 8 * h);
        }
        if (more) tile_lstore(R, lds + OFF_K + (cur ^ 1) * 16384, lds + OFF_V + (cur ^ 1) * 16384, tid);
        __syncthreads();
        cur ^= 1;
    }
    float l_tot = l_run; { auto rr = __builtin_amdgcn_permlane32_swap(__float_as_uint(l_run), __float_as_uint(l_run), false, false); l_tot = __uint_as_float(rr[0]) + __uint_as_float(rr[1]); }
    const float inv = 1.0f / l_tot;
    ALAS unsigned char* stg = lds + w * 8704;
#pragma unroll
    for (int c = 0; c < 4; ++c)
#pragma unroll
        for (int g = 0; g < 4; ++g) { u32x2 wv; wv.x = cvtpk_s(o[c][4 * g] * inv, o[c][4 * g + 1] * inv); wv.y = cvtpk_s(o[c][4 * g + 2] * inv, o[c][4 * g + 3] * inv);
            *(ALAS u32x2*)(stg + r * 272 + (32 * c + 8 * g + 4 * h) * 2) = wv; }
    asm volatile("s_waitcnt lgkmcnt(0)" ::: "memory");
    const int tok0 = b * SEQ + 64 * qt + 32 * (w & 1);
#pragma unroll
    for (int j = 0; j < 8; ++j) { const int row = (lane >> 4) + 4 * j, ch = lane & 15;
        const u32x4 v = *(ALAS const u32x4*)(stg + row * 272 + ch * 16);
        *(u32x4*)(T.o + (size_t)(tok0 + row) * 2048 + hd * HD + ch * 8) = v; }
}
}
typedef unsigned short bf16;
typedef float f32x4 __attribute__((ext_vector_type(4)));
typedef unsigned v4u __attribute__((ext_vector_type(4)));
typedef unsigned v2u __attribute__((ext_vector_type(2)));
constexpr int NWAVES = 8, NTHR = 512;
constexpr int M = 8192, D = 2048, FF = 5632, NGU = 2 * FF, DIN = 6152, NQKV = 6144, DPLE = 256, SEQ = 2048, NHB = 8;
constexpr size_t MiB = 1u << 20;
constexpr size_t WS_CTL = 0;
constexpr size_t CTL_CNT = 0;
constexpr size_t CTL_SS = 4096;
constexpr size_t CTL_LF = CTL_SS + 5 * (size_t)M * 4;
constexpr size_t CTL_WF = CTL_LF + (size_t)M * 8 * 4;
static_assert(CTL_WF + 8 * (size_t)D * 4 <= MiB, "control region");
constexpr size_t WS_WGU1 = 1 * MiB, WS_WD1 = WS_WGU1 + 44 * MiB, WS_WIN = WS_WD1 + 22 * MiB, WS_WOUT = WS_WIN + 24 * MiB, WS_WGU2 = WS_WOUT + 8 * MiB,
                 WS_WD2 = WS_WGU2 + 44 * MiB, WS_WG = WS_WD2 + 22 * MiB, WS_WP = WS_WG + 8 * MiB, WS_PB = WS_WP + 1 * MiB  , WS_AB = WS_PB + 4 * MiB  ,
                 WS_R1 = WS_AB + 32 * MiB  , WS_H = WS_R1 + 128 * MiB  , WS_END = WS_H + 64 * MiB;
constexpr size_t QKV_T = (size_t)M * 1024;
constexpr int LDS_BYTES = 147456;

__device__ __forceinline__ unsigned f2bf(float f) { unsigned u = __builtin_bit_cast(unsigned, f); return (u + 0x7fffu + ((u >> 16) & 1u)) >> 16; }
__device__ __forceinline__ unsigned pk2(float lo, float hi) { typedef float f2_t __attribute__((ext_vector_type(2))); typedef __bf16 b2_t __attribute__((ext_vector_type(2))); f2_t v = {lo, hi}; b2_t b = __builtin_convertvector(v, b2_t); return __builtin_bit_cast(unsigned, b); }
__device__ __forceinline__ float wave_sum(float v) {
#pragma unroll
    for (int o = 1; o < 64; o <<= 1) v += __shfl_xor(v, o);
    return v;
}
struct ConvRegs { f32x4 v[16]; };
constexpr int LDS_G = 8 * 16896;
__device__ __forceinline__ void conv_load(ConvRegs& R, const float* __restrict__ W, int ldw, int k0, int n0, int lane) {
#pragma unroll
    for (int it = 0; it < 8; ++it) { const int kk = 8 * it + (lane >> 3); const float* src = W + (size_t)(k0 + kk) * ldw + n0 + 4 * (lane & 7);
        R.v[it] = __builtin_nontemporal_load((const f32x4*)src); R.v[8 + it] = __builtin_nontemporal_load((const f32x4*)(src + 32)); }
}
template <bool HAS_G, bool TILED> __device__ __forceinline__ void conv_store(const ConvRegs& R, const LAS float* gl, bf16* WT, int K, int k0, int drowA, int drowB, LAS float* scr, int lane) {
#pragma unroll
    for (int it = 0; it < 8; ++it) { const int kk = 8 * it + (lane >> 3); const float gg = HAS_G ? gl[k0 + kk] : 1.0f; LAS float* s = scr + kk * 33 + 4 * (lane & 7);
        s[0] = R.v[it][0] * gg; s[1] = R.v[it][1] * gg; s[2] = R.v[it][2] * gg; s[3] = R.v[it][3] * gg;
        s[2112 + 0] = R.v[8 + it][0] * gg; s[2112 + 1] = R.v[8 + it][1] * gg; s[2112 + 2] = R.v[8 + it][2] * gg; s[2112 + 3] = R.v[8 + it][3] * gg; }
    asm volatile("s_waitcnt lgkmcnt(0)" ::: "memory");
    const int c = lane & 7;
#pragma unroll
    for (int hf = 0; hf < 2; ++hf)
#pragma unroll
        for (int j = 0; j < 4; ++j) { const int n = (lane >> 3) + 8 * j; const LAS float* s = scr + hf * 2112 + (8 * c) * 33 + n;
            v4u o; o.x = pk2(s[0 * 33], s[1 * 33]); o.y = pk2(s[2 * 33], s[3 * 33]); o.z = pk2(s[4 * 33], s[5 * 33]); o.w = pk2(s[6 * 33], s[7 * 33]);
            const int row = (hf ? drowB : drowA) + n;
            if (TILED) *(v4u*)(WT + ((size_t)(row >> 8) * (K >> 6) + (k0 >> 6)) * 16384 + (size_t)(row & 255) * 64 + 8 * c) = o;
            else *(v4u*)(WT + (size_t)row * K + k0 + 8 * c) = o; }
    asm volatile("s_waitcnt lgkmcnt(0)" ::: "memory");
}
__device__ __forceinline__ int gu_row(int n0) { const int hi = n0 >= FF, n = n0 - (hi ? FF : 0); return 256 * (n >> 7) + (n & 127) + 128 * hi; }
template <bool HAS_G, bool gu, bool PIPE, bool TILED = false> __device__ __forceinline__ void conv_matrix(const float* W, int ldw, const float* g, bf16* WT, int K, int ncols, int wv, int nwv, LAS float* scr, int lane, LAS unsigned char* lds) {
    const LAS float* gl = (const LAS float*)(lds + LDS_G);
    if (HAS_G) { __syncthreads(); for (int i = threadIdx.x; i < K; i += NTHR) ((LAS float*)(lds + LDS_G))[i] = g[i]; __syncthreads(); }
    const int nb = ncols / 64, total = (K / 64) * nb, last = total - 1;
    ConvRegs RA, RB;
    int it = wv;
    if (!PIPE) {
        if (it < total) conv_load(RA, W, ldw, 64 * (it / nb), 64 * (it % nb), lane);
        while (it < total) {
            const int itB = it + nwv, itA2 = itB + nwv;
            if (itB < total) conv_load(RB, W, ldw, 64 * (itB / nb), 64 * (itB % nb), lane);
            { const int n0 = 64 * (it % nb); conv_store<HAS_G, TILED>(RA, gl, WT, K, 64 * (it / nb), gu ? gu_row(n0) : n0, gu ? gu_row(n0 + 32) : n0 + 32, scr, lane); }
            if (itA2 < total) conv_load(RA, W, ldw, 64 * (itA2 / nb), 64 * (itA2 % nb), lane);
            if (itB < total) { const int n0 = 64 * (itB % nb); conv_store<HAS_G, TILED>(RB, gl, WT, K, 64 * (itB / nb), gu ? gu_row(n0) : n0, gu ? gu_row(n0 + 32) : n0 + 32, scr, lane); }
            it = itA2;
        }
        return;
    }
    if (it >= total) return;
    conv_load(RA, W, ldw, 64 * (it / nb), 64 * (it % nb), lane);
    while (it < total) {
        const int itB = (it + nwv < last) ? it + nwv : last, itA2 = (it + 2 * nwv < last) ? it + 2 * nwv : last;
        conv_load(RB, W, ldw, 64 * (itB / nb), 64 * (itB % nb), lane);
        { const int n0 = 64 * (it % nb); conv_store<HAS_G, TILED>(RA, gl, WT, K, 64 * (it / nb), gu ? gu_row(n0) : n0, gu ? gu_row(n0 + 32) : n0 + 32, scr, lane); }
        conv_load(RA, W, ldw, 64 * (itA2 / nb), 64 * (itA2 % nb), lane);
        { const int n0 = 64 * (itB % nb); conv_store<HAS_G, TILED>(RB, gl, WT, K, 64 * (itB / nb), gu ? gu_row(n0) : n0, gu ? gu_row(n0 + 32) : n0 + 32, scr, lane); }
        it += 2 * nwv;
    }
}


constexpr size_t CTL_BAR = 512 * 1024;
static_assert(CTL_WF + 8 * (size_t)D * 4 <= CTL_BAR && CTL_BAR + XCD_BAR_WORDS * 4 <= MiB, "control region");
constexpr size_t CTL_PCNT = CTL_BAR + 16384;
static_assert(CTL_PCNT + 32 * 256 <= MiB, "control region");
constexpr int LDS_XB = LDS_BYTES - 64;
#ifndef USE_TILED
#define USE_TILED false
#endif
#ifndef PHMASK
#define PHMASK 0x3ff
#endif
#define PH_ON(k) (((PHMASK) >> (k)) & 1)
struct Args { const float* in[17]; float* out; unsigned char* ws; };
typedef const __attribute__((address_space(4))) unsigned char* kargp_t;
__device__ __forceinline__ unsigned long long karg64(int i) { kargp_t p = (kargp_t)__builtin_amdgcn_kernarg_segment_ptr(); asm volatile("" : "+s"(p)); return *(const __attribute__((address_space(4))) unsigned long long*)(p + 8 * i); }
#define GAS1 __attribute__((address_space(1)))
#define ARG_IN(i) ((const float*)(const GAS1 float*)karg64(i))
#define ARG_OUT ((float*)(GAS1 float*)karg64(17))
#define ARG_WS ((unsigned char*)(GAS1 unsigned char*)karg64(18))

__global__ void __launch_bounds__(NTHR, 2) fwd_kernel(Args a) {
    extern __shared__ __attribute__((aligned(16))) unsigned char lds_raw[];
    LAS unsigned char* lds = (LAS unsigned char*)lds_raw;
    cg::grid_group grid = cg::this_grid();
    const int G = gridDim.x, bx = blockIdx.x, NGW = G * NWAVES;
    const int G1 = (G == 256) ? 235 : G - (G / 12 > 0 ? G / 12 : 1);
    if (threadIdx.x == 0) { ((volatile LAS unsigned*)(lds + LDS_XB))[0] = 0u; ((volatile LAS unsigned*)(lds + LDS_XB))[1] = 0u; }
    const XcdBarrier xbar = xcd_barrier_post((unsigned*)(ARG_WS + CTL_BAR), (volatile LAS unsigned*)(lds + LDS_XB));
#define TID_DECL int tid_l = threadIdx.x; asm volatile("" : "+v"(tid_l)); const int tid = tid_l, lane = tid & 63, wave = __builtin_amdgcn_readfirstlane(tid >> 6), gw = bx * NWAVES + wave; (void)lane; (void)gw;
#define P_SS(i) ((float*)(ws + CTL_SS) + (size_t)(i) * M)
#define P_LF ((float*)(ws + CTL_LF))
#define P_WF ((float*)(ws + CTL_WF))
#define P_CNT ((unsigned*)(ws + CTL_CNT))
#define P_BF(off) ((bf16*)(ws + (off)))
#define P_ACT P_BF(WS_R1)
#define P_QKV P_BF(WS_R1)
#define P_OB P_BF(WS_R1 + 96 * MiB)
#define P_AB P_BF(WS_AB)
#define P_H ((float*)(ws + WS_H))

    {
    if constexpr (PH_ON(0)) {
        unsigned char* const ws = ARG_WS;
        TID_DECL
        LAS float* scr = (LAS float*)(lds + wave * 16896);
        conv_matrix<true, true, false>(ARG_IN(3), NGU, ARG_IN(2), P_BF(WS_WGU1), D, NGU, gw, NGW, scr, lane, lds);
        for (int m = gw; m < M; m += 2 * NGW) {
            const int m2 = (m + NGW < M) ? m + NGW : m;
            const f32x4* xa = (const f32x4*)(ARG_IN(0) + (size_t)m * D) + lane; const f32x4* xb_ = (const f32x4*)(ARG_IN(0) + (size_t)m2 * D) + lane; f32x4 va[8], vb[8];
#pragma unroll
            for (int j = 0; j < 8; ++j) va[j] = __builtin_nontemporal_load(xa + 64 * j);
#pragma unroll
            for (int j = 0; j < 8; ++j) vb[j] = __builtin_nontemporal_load(xb_ + 64 * j);
            float sa = 0.f, sb = 0.f;
#pragma unroll
            for (int j = 0; j < 8; ++j) { sa += (va[j][0] * va[j][0] + va[j][1] * va[j][1]) + (va[j][2] * va[j][2] + va[j][3] * va[j][3]); sb += (vb[j][0] * vb[j][0] + vb[j][1] * vb[j][1]) + (vb[j][2] * vb[j][2] + vb[j][3] * vb[j][3]); }
            sa = wave_sum(sa); sb = wave_sum(sb); if (lane == 0) { P_SS(0)[m] = sa; P_SS(0)[m2] = sb; }
            v2u* oa = (v2u*)(P_AB + (size_t)m * D) + lane; v2u* ob_ = (v2u*)(P_AB + (size_t)m2 * D) + lane;
#pragma unroll
            for (int j = 0; j < 8; ++j) { v2u o; o.x = pk2(va[j][0], va[j][1]); o.y = pk2(va[j][2], va[j][3]); oa[64 * j] = o; }
#pragma unroll
            for (int j = 0; j < 8; ++j) { v2u o; o.x = pk2(vb[j][0], vb[j][1]); o.y = pk2(vb[j][2], vb[j][3]); ob_[64 * j] = o; }
        }
        for (int i = bx * NTHR + tid; i < 4 * M; i += G * NTHR) P_SS(1)[i] = 0.f;
        if (bx == 0 && tid == 0) { P_CNT[0] = 0u; P_CNT[64] = 0u; }
        if (bx == 1) for (int i = tid; i < 32 * 64; i += NTHR) ((unsigned*)(ws + CTL_PCNT))[i] = 0u;
    }
    }
    if (ARG_WS == nullptr) grid.sync();
    xcd_barrier(xbar);

    {
    if constexpr (PH_ON(1)) {
        unsigned char* const ws = ARG_WS;
        if (bx < G1) { pg8::Gemm g{P_AB, P_BF(WS_WGU1), M, NGU, D}; pg8::StaticOrder S; S.init(M, NGU, G1, bx);
          pg8::EpiSwiglu E{P_ACT, P_SS(0)};
          pg8::gemm_phase<pg8::EpiSwiglu, pg8::StaticOrder, true, true>(lds, g, S, E); }
        else {
            TID_DECL
            LAS float* scr = (LAS float*)(lds + wave * 16896); const int wv = (bx - G1) * NWAVES + wave, nwv = (G - G1) * NWAVES;
            for (int i = (bx - G1) * NTHR + tid; i < 8 * D; i += (G - G1) * NTHR) { const int j = i / D, k = i % D; P_WF[i] = ARG_IN(5)[k] * ARG_IN(6)[(size_t)k * DIN + NQKV + j]; }
            conv_matrix<false, false, true, USE_TILED>(ARG_IN(4), D, nullptr, P_BF(WS_WD1), FF, D, wv, nwv, scr, lane, lds);
            conv_matrix<false, false, true>(ARG_IN(15), D, nullptr, P_BF(WS_WP), DPLE, D, wv, nwv, scr, lane, lds);
            conv_matrix<true, false, true>(ARG_IN(6), DIN, ARG_IN(5), P_BF(WS_WIN), D, NQKV, wv, nwv, scr, lane, lds);
            conv_matrix<false, false, true>(ARG_IN(9), D, nullptr, P_BF(WS_WOUT), D, D, wv, nwv, scr, lane, lds);
        }
    }
    }
    xcd_barrier(xbar);
    if constexpr (PH_ON(2)) {
        unsigned char* const ws = ARG_WS;
        pg8::Gemm g{P_ACT, P_BF(WS_WD1), M, D, FF}; pg8::StaticOrder S; S.init(M, D, G, bx);
        pg8::EpiResid<true> E{nullptr, P_AB, P_SS(1), 0.5f, xbar};
        pg8::gemm_phase<pg8::EpiResid<true>, pg8::StaticOrder, false, true, USE_TILED>(lds, g, S, E);
    }
    {
    if constexpr (PH_ON(3)) {
        unsigned char* const ws = ARG_WS;
        TID_DECL
        pg8::Gemm g{P_AB, P_BF(WS_WIN), M, NQKV, D}; pg8::StaticOrder S; S.init(M, NQKV, G, bx);
        pg8::EpiQKV E{P_QKV, P_SS(1), 0.08838834764831845f * 1.4426950408889634f, QKV_T};
        pg8::gemm_phase<pg8::EpiQKV, pg8::StaticOrder, true, true>(lds, g, S, E);
        for (int m = gw; m < M; m += 2 * NGW) {
            const int m2 = (m + NGW < M) ? m + NGW : m;
            const v2u* hra = (const v2u*)(P_AB + (size_t)m * D) + lane; const v2u* hrb = (const v2u*)(P_AB + (size_t)m2 * D) + lane; f32x4 va[8], vb[8];
#pragma unroll
            for (int j = 0; j < 8; ++j) { const v2u w = hra[64 * j]; va[j] = (f32x4){__uint_as_float(w.x << 16), __uint_as_float(w.x & 0xffff0000u), __uint_as_float(w.y << 16), __uint_as_float(w.y & 0xffff0000u)}; }
#pragma unroll
            for (int j = 0; j < 8; ++j) { const v2u w = hrb[64 * j]; vb[j] = (f32x4){__uint_as_float(w.x << 16), __uint_as_float(w.x & 0xffff0000u), __uint_as_float(w.y << 16), __uint_as_float(w.y & 0xffff0000u)}; }
            float sa[8], sb[8];
#pragma unroll
            for (int jj = 0; jj < 8; ++jj) { const f32x4* wr_ = (const f32x4*)(P_WF + (size_t)jj * D) + lane; float a = 0.f, b = 0.f;
#pragma unroll
                for (int j = 0; j < 8; ++j) { const f32x4 wv = wr_[64 * j];
                    a += (va[j][0] * wv[0] + va[j][1] * wv[1]) + (va[j][2] * wv[2] + va[j][3] * wv[3]); b += (vb[j][0] * wv[0] + vb[j][1] * wv[1]) + (vb[j][2] * wv[2] + vb[j][3] * wv[3]); }
                sa[jj] = a; sb[jj] = b; }
            const bool u5 = lane >= 32, u4 = (lane >> 4) & 1, u3 = (lane >> 3) & 1;
#define FRED(s, out) { float b4[4], c2[2]; _Pragma("unroll") for (int k = 0; k < 4; ++k) { const float snd = u5 ? s[k] : s[k + 4]; b4[k] = (u5 ? s[k + 4] : s[k]) + __shfl_xor(snd, 32); } \
                _Pragma("unroll") for (int k = 0; k < 2; ++k) { const float snd = u4 ? b4[k] : b4[k + 2]; c2[k] = (u4 ? b4[k + 2] : b4[k]) + __shfl_xor(snd, 16); } \
                { const float snd = u3 ? c2[0] : c2[1]; out = (u3 ? c2[1] : c2[0]) + __shfl_xor(snd, 8); } out += __shfl_xor(out, 4); out += __shfl_xor(out, 2); out += __shfl_xor(out, 1); }
            float da, db; FRED(sa, da) FRED(sb, db)
#undef FRED
            if ((lane & 7) == 0) { const int jj = lane >> 3; const float bf = ARG_IN(7)[jj];
                const float za = da * pg8::rs_of(P_SS(1), m) + bf, zb = db * pg8::rs_of(P_SS(1), m2) + bf;
                P_LF[(size_t)m * 8 + jj] = fminf(za, 0.f) - log1pf(__expf(-fabsf(za))); P_LF[(size_t)m2 * 8 + jj] = fminf(zb, 0.f) - log1pf(__expf(-fabsf(zb))); }
        }
    }
    xcd_barrier(xbar);
    }
    if constexpr (PH_ON(4)) {
        unsigned char* const ws = ARG_WS;
        TID_DECL
        const int GA = G - 56;
        if (bx >= GA) {
            LAS float* scr = (LAS float*)(lds + wave * 16896); const int wv = (bx - GA) * NWAVES + wave, nwv = (G - GA) * NWAVES;
            conv_matrix<true, true, true>(ARG_IN(11), NGU, ARG_IN(10), P_BF(WS_WGU2), D, NGU, wv, nwv, scr, lane, lds);
            { constexpr int NP4 = M * DPLE / 4; const int t0 = (bx - GA) * NTHR + tid, st = (G - GA) * NTHR;
              for (int i = t0; i < NP4; i += 8 * st) { f32x4 v[8];
#pragma unroll
                for (int q = 0; q < 8; ++q) { const int ii = i + q * st; v[q] = ((const f32x4*)ARG_IN(1))[ii < NP4 ? ii : i]; }
#pragma unroll
                for (int q = 0; q < 8; ++q) { const int ii = i + q * st; if (ii < NP4) { v2u o; o.x = pk2(v[q][0], v[q][1]); o.y = pk2(v[q][2], v[q][3]); ((v2u*)P_BF(WS_PB))[ii] = o; } } } }
            __syncthreads();
        }
        {
        LAS unsigned* slot = (LAS unsigned*)(lds + att::OFF_MISC);
        att::Tensors TA{P_QKV, P_QKV + QKV_T, P_QKV + 2 * QKV_T, P_OB, P_LF, ARG_IN(8)};
        att::Tensors TB{P_QKV + 3 * QKV_T, P_QKV + 4 * QKV_T, P_QKV + 5 * QKV_T, P_OB + 1024, P_LF, ARG_IN(8)};
        { const int rep = 0;
        for (;;) {
            if (tid == 0) slot[0] = atomicAdd(P_CNT + 64 * rep, 1u);
            __syncthreads();
            const int item = (int)slot[0];
            __syncthreads();
            if (item >= 512) break;
            int mode, blk_, bh;
            bh = item % 32; { const int grp = item / 32;
              if (grp < 5) { mode = 1; blk_ = 7 - grp; }
              else if (grp < 11) { mode = 0; blk_ = 12 - grp; }
              else if (grp == 11) { mode = 1; blk_ = 2; }
              else if (grp == 12) { mode = 0; blk_ = 1; }
              else if (grp == 13) { mode = 1; blk_ = 1; }
              else if (grp == 14) { mode = 0; blk_ = 0; }
              else { mode = 1; blk_ = 0; } }
            if (mode) att::attn_item<1>(lds, TB, bh >> 3, bh & 7, blk_); else att::attn_item<0>(lds, TA, bh >> 3, bh & 7, blk_);
        }
        }
        }
    }
    xcd_barrier(xbar);
    if constexpr (PH_ON(5)) {
        unsigned char* const ws = ARG_WS;
        pg8::Gemm g{P_OB, P_BF(WS_WOUT), M, D, D}; pg8::StaticOrder S; S.init(M, D, G, bx);
        pg8::EpiResid<true> E{nullptr, P_AB, P_SS(2), 1.0f, xbar};
        pg8::gemm_phase<pg8::EpiResid<true>, pg8::StaticOrder, false, true>(lds, g, S, E);
    }
    {
    if constexpr (PH_ON(6)) {
        unsigned char* const ws = ARG_WS;
        if (bx < G1) { pg8::Gemm g{P_AB, P_BF(WS_WGU2), M, NGU, D}; pg8::StaticOrder S; S.init(M, NGU, G1, bx);
          pg8::EpiSwiglu E{P_ACT, P_SS(2)};
          pg8::gemm_phase<pg8::EpiSwiglu, pg8::StaticOrder, true, true>(lds, g, S, E); }
        else {
            { int Kpp = DPLE; asm volatile("" : "+s"(Kpp));
              pg8::Gemm g2{P_BF(WS_PB), P_BF(WS_WP), M, D, Kpp}; pg8::StaticOrder S2; S2.init(M, D, G - G1, bx - G1); pg8::EpiBf16Plain E2{P_OB};
              pg8::gemm_phase<pg8::EpiBf16Plain, pg8::StaticOrder, true, true>(lds, g2, S2, E2); }
            TID_DECL
            LAS float* scr = (LAS float*)(lds + wave * 16896); const int wv = (bx - G1) * NWAVES + wave, nwv = (G - G1) * NWAVES;
            conv_matrix<false, false, true, USE_TILED>(ARG_IN(12), D, nullptr, P_BF(WS_WD2), FF, D, wv, nwv, scr, lane, lds);
            conv_matrix<true, false, true>(ARG_IN(14), D, ARG_IN(13), P_BF(WS_WG), D, D, wv, nwv, scr, lane, lds);
        }
    }
    xcd_barrier(xbar);
    }
    if constexpr (PH_ON(7)) {
        unsigned char* const ws = ARG_WS;
        pg8::Gemm g{P_ACT, P_BF(WS_WD2), M, D, FF}; pg8::StaticOrder S; S.init(M, D, G, bx);
        pg8::EpiResid<true> E{nullptr, P_AB, P_SS(3), 0.5f, xbar};
        pg8::gemm_phase<pg8::EpiResid<true>, pg8::StaticOrder, false, true, USE_TILED>(lds, g, S, E);
    }
    if constexpr (PH_ON(8)) {
        unsigned char* const ws = ARG_WS;
        pg8::Gemm g{P_AB, P_BF(WS_WG), M, D, D}; pg8::StaticOrder S; S.init(M, D, G, bx);
        pg8::EpiPleNorm E{P_AB, ARG_OUT, P_SS(3), P_SS(4), ARG_IN(16), (unsigned*)(ws + CTL_PCNT), P_OB};
        pg8::gemm_phase<pg8::EpiPleNorm, pg8::StaticOrder, false, true>(lds, g, S, E);
    }
}

extern "C" void kernel_launch(void* const* d_in, const int* in_sizes, int n_in, void* d_out, int out_size, void* d_ws, size_t ws_size, hipStream_t stream) {
    static int grid = 0;
    if (grid == 0) {
        if (n_in != 17 || out_size != M * D || ws_size < WS_END) { fprintf(stderr, "kernel_launch: unexpected problem (n_in %d, out %d, ws %zu, need %zu)\n", n_in, out_size, ws_size, (size_t)WS_END); grid = -1; return; }
        int dev = 0, cus = 0, per_cu = 0;
        hipGetDevice(&dev); hipDeviceGetAttribute(&cus, hipDeviceAttributeMultiprocessorCount, dev);
        if (hipFuncSetAttribute((const void*)fwd_kernel, hipFuncAttributeMaxDynamicSharedMemorySize, LDS_BYTES) != hipSuccess) { fprintf(stderr, "kernel_launch: hipFuncSetAttribute failed\n"); grid = -1; return; }
        if (hipOccupancyMaxActiveBlocksPerMultiprocessor(&per_cu, (const void*)fwd_kernel, NTHR, LDS_BYTES) != hipSuccess || per_cu < 1) { fprintf(stderr, "kernel_launch: occupancy query says %d\n", per_cu); per_cu = 1; }
        (void)hipGetLastError();
        if (cus != 256) { fprintf(stderr, "kernel_launch: built for a 256-CU device (got %d CUs); nothing launched\n", cus); grid = -1; return; }
        grid = cus;
    }
    if (grid < 0) return;
    Args a{};
    for (int i = 0; i < 17; ++i) a.in[i] = (const float*)d_in[i];
    a.out = (float*)d_out; a.ws = (unsigned char*)d_ws;
    void* args[] = {&a};
    if (hipMemsetAsync((char*)d_ws + CTL_BAR, 0, XCD_BAR_WORDS * 4, stream) != hipSuccess) { fprintf(stderr, "kernel_launch: hipMemsetAsync failed\n"); return; }
    hipError_t e = hipLaunchCooperativeKernel((const void*)fwd_kernel, dim3(grid), dim3(NTHR), args, LDS_BYTES, stream);
    if (e != hipSuccess) fprintf(stderr, "cooperative launch failed: %s (grid %d)\n", hipGetErrorString(e), grid);
}
```

```cpp
#include <hip/hip_runtime.h>
#include <hip/hip_cooperative_groups.h>
#include <cstdio>
#include <cstdint>
namespace cg = cooperative_groups;
#define LAS __attribute__((address_space(3)))
#define XB_TMO      128
#define XB_XCNT(j)  (256  + 64 * (j))
#define XB_XSUB(j)  (1280 + 64 * (j))
#define XB_XGEN(j)  (2304 + 64 * (j))
#define XB_TOP      3328
#define XB_TOPGEN   3392
#define XCD_BAR_WORDS 3456
#define XB_SPIN_CAP (1u << 18)

__device__ __forceinline__ unsigned xb_ld(unsigned* p)              { return __hip_atomic_load(p, __ATOMIC_RELAXED, __HIP_MEMORY_SCOPE_AGENT); }
__device__ __forceinline__ unsigned xb_add(unsigned* p, unsigned v) { return __hip_atomic_fetch_add(p, v, __ATOMIC_RELAXED, __HIP_MEMORY_SCOPE_AGENT); }
__device__ __forceinline__ unsigned xb_xcc_id() { return (unsigned)__builtin_amdgcn_s_getreg((3 << 11) | 20) & 0xFu; }
#define XB_SPIN(cond, bar) do { unsigned _sp = 0; while (cond) { __builtin_amdgcn_s_sleep(1); \
    if ((++_sp & 255u) == 0u) { if (xb_ld(&(bar)[XB_TMO])) break; if (_sp > XB_SPIN_CAP) { atomicAdd(&(bar)[XB_TMO], 1u); break; } } } } while (0)

struct XcdBarrier {
    unsigned* bar; unsigned x;
    volatile LAS unsigned* st;
};

__device__ __forceinline__ XcdBarrier xcd_barrier_post(unsigned* bar, volatile LAS unsigned* st) {
    XcdBarrier b; b.bar = bar; b.x = xb_xcc_id(); b.st = st;
    if (threadIdx.x == 0) (void)xb_add(&bar[XB_XCNT(b.x)], 1u);
    return b;
}
__device__ __forceinline__ void xcd_barrier_complete(unsigned* bar, unsigned x, unsigned& nloc, unsigned& nx) {
    const unsigned G = gridDim.x * gridDim.y * gridDim.z;
    unsigned sum, cnt, mine, sp = 0u;
    for (;;) {
        sum = 0u; cnt = 0u; mine = 0u;
#pragma unroll
        for (unsigned j = 0; j < 16; ++j) { const unsigned c = xb_ld(&bar[XB_XCNT(j)]); sum += c; cnt += (c > 0u) ? 1u : 0u; mine = (j == x) ? c : mine; }
        if (sum == G) break;
        __builtin_amdgcn_s_sleep(1);
        if ((++sp & 255u) == 0u) { if (xb_ld(&bar[XB_TMO])) break; if (sp > XB_SPIN_CAP) { atomicAdd(&bar[XB_TMO], 1u); break; } }
    }
    nloc = mine > 0u ? mine : 1u; nx = cnt > 0u ? cnt : 1u;
}

__device__ __forceinline__ void xcd_barrier(const XcdBarrier& b) {
    asm volatile("s_waitcnt vmcnt(0)" ::: "memory");
    __syncthreads();
    if (threadIdx.x == 0) {
        unsigned* bar = b.bar;
        __builtin_amdgcn_s_waitcnt(0);
        unsigned nloc = b.st[0], nx = b.st[1];
        if (nloc == 0u) { xcd_barrier_complete(bar, b.x, nloc, nx); b.st[0] = nloc; b.st[1] = nx; }
        const unsigned old = xb_add(&bar[XB_XSUB(b.x)], 1u);
        const unsigned gen = old / nloc;
        if (old + 1u == (gen + 1u) * nloc) {
            __builtin_amdgcn_fence(__ATOMIC_RELEASE, "agent");
            asm volatile("s_waitcnt vmcnt(0)" ::: "memory");
            const unsigned og = xb_add(&bar[XB_TOP], 1u);
            const unsigned tg = og / nx;
            if (og + 1u == (tg + 1u) * nx) xb_add(&bar[XB_TOPGEN], 1u);
            else XB_SPIN(xb_ld(&bar[XB_TOPGEN]) == tg, bar);
            __builtin_amdgcn_fence(__ATOMIC_ACQUIRE, "agent");
            xb_add(&bar[XB_XGEN(b.x)], 1u);
            asm volatile("s_waitcnt vmcnt(0)" ::: "memory");
        } else {
            XB_SPIN(xb_ld(&bar[XB_XGEN(b.x)]) == gen, bar);
            __builtin_amdgcn_fence(__ATOMIC_ACQUIRE, "agent");
            asm volatile("s_waitcnt vmcnt(0)" ::: "memory");
        }
    }
    __syncthreads();
}

namespace pg8 {
#define PG8_LAS __attribute__((address_space(3)))
typedef unsigned short bf16_t;
typedef short bf16x8 __attribute__((ext_vector_type(8)));
typedef float f32x4 __attribute__((ext_vector_type(4)));
typedef unsigned u32x4 __attribute__((ext_vector_type(4)));
constexpr int BM = 256, BK = 64, HALF = 128, HTB = HALF * BK * 2  , STAGE_BYTES = 8 * HTB, NXCD = 8, WGM = 8;

__host__ __device__ __forceinline__ int lds_byte(int r, int c) { const int st = (r >> 4) * 2 + (c >> 5), rr = r & 15, cc = c & 31, ob = rr * 64 + cc * 2; return st * 1024 + (ob ^ (((ob >> 9) & 1) << 5)); }
__host__ __device__ __forceinline__ void stage_rc(int b, int& R, int& C) { const int st = b / 1024, sb = b % 1024, swz = sb ^ (((sb >> 9) & 1) << 5); R = (st >> 1) * 16 + swz / 64; C = (st & 1) * 32 + (swz % 64) / 2; }
__host__ __device__ __forceinline__ int perm32(int rho) { const int n = rho >> 4, i = rho & 15; return 8 * (i >> 2) + 4 * n + (i & 3); }

struct Unit { int pm, pn; };
struct Gemm { const bf16_t* A; const bf16_t* Bt; int M, N, K; };

struct StaticOrder {
    int nM, nN, nwg, G, c;
    __host__ __device__ void init(int M, int N, int G_, int c_) { nM = M / BM; nN = N / BM; nwg = nM * nN; G = G_; c = c_; }
    __host__ __device__ bool next(int i, Unit& u) const {
        const long L = (long)i * G + c; if (L >= nwg) return false;
        int wgid = (int)L; { const int q = nwg / NXCD, r = nwg % NXCD, xcd = wgid % NXCD, off = wgid / NXCD; wgid = (xcd < r ? xcd * (q + 1) : r * (q + 1) + (xcd - r) * q) + off; }
        const int nig = WGM * nN, gid = wgid / nig, fm = gid * WGM, gsz = (nM - fm) < WGM ? (nM - fm) : WGM;
        u.pm = fm + ((wgid % nig) % gsz); u.pn = (wgid % nig) / gsz; return true;
    }
    __device__ __forceinline__ void a_ready(const Unit&) const {}
    __device__ __forceinline__ void done(const Unit&) const {}
};

__device__ __forceinline__ unsigned cvt_pk_bf16(float lo, float hi) { unsigned r; asm volatile("v_cvt_pk_bf16_f32 %0, %1, %2" : "=v"(r) : "v"(lo), "v"(hi)); return r; }
typedef float f32x2 __attribute__((ext_vector_type(2)));
#ifndef USE_TILED
#define USE_TILED false
#endif
constexpr float RMS_EPS = 1e-6f;
constexpr int DM = 2048, DFF = 5632;
__device__ __forceinline__ float rs_of(const float* ss, int row) { return __builtin_amdgcn_rsqf(ss[row] * (1.0f / 2048.0f) + RMS_EPS); }
__device__ __forceinline__ float silu_f(float a) { return a * __builtin_amdgcn_rcpf(1.0f + __builtin_amdgcn_exp2f(-1.4426950408889634f * a)); }
__device__ __forceinline__ float sigm_f(float a) { return __builtin_amdgcn_rcpf(1.0f + __builtin_amdgcn_exp2f(-1.4426950408889634f * a)); }
__device__ __forceinline__ u32x4 pack8(const f32x4 v0, const f32x4 v1) { u32x4 w; w.x = cvt_pk_bf16(v0[0], v0[1]); w.y = cvt_pk_bf16(v0[2], v0[3]); w.z = cvt_pk_bf16(v1[0], v1[1]); w.w = cvt_pk_bf16(v1[2], v1[3]); return w; }

struct EpiSwiglu {
    static constexpr bool PERM = true, AFTER_DRAIN = false;
    static constexpr bool PRELOAD = true;
    bf16_t* O; const float* ss;
    __device__ __forceinline__ void preload(const Unit& u, int wr, int fr, float (&pre)[8]) const {
#pragma unroll
        for (int i = 0; i < 8; ++i) pre[i] = ss[u.pm * BM + wr * 64 + fr + (i >> 2) * HALF + (i & 3) * 16];
    }
    __device__ __forceinline__ void operator()(const f32x4 (&acc)[2][2][4][2], const Unit& u, int wr, int wc, int fr, int fq, const float (&pre)[8]) const {
        const int row0 = u.pm * BM + wr * 64 + fr, col0 = u.pn * 128 + wc * 32 + 8 * fq;
        float rsv[2][4];
#pragma unroll
        for (int ai = 0; ai < 2; ++ai)
#pragma unroll
            for (int m = 0; m < 4; ++m) rsv[ai][m] = pre[4 * ai + m];
#pragma unroll
        for (int ai = 0; ai < 2; ++ai)
#pragma unroll
            for (int m = 0; m < 4; ++m) {
                const int r = row0 + ai * HALF + m * 16; const float rs = __builtin_amdgcn_rsqf(rsv[ai][m] * (1.0f / 2048.0f) + RMS_EPS);
                f32x4 v[2];
                const float k1 = -1.4426950408889634f * rs, rs2 = rs * rs;
#pragma unroll
                for (int n = 0; n < 2; ++n) { const f32x4 a = acc[ai][0][m][n], b = acc[ai][1][m][n];
#pragma unroll
                    for (int q = 0; q < 4; ++q) v[n][q] = (a[q] * b[q]) * rs2 * __builtin_amdgcn_rcpf(1.0f + __builtin_amdgcn_exp2f(k1 * a[q])); }
                if (USE_TILED) *(u32x4*)(O + ((size_t)(r >> 8) * (DFF / 64) + (col0 >> 6)) * 16384 + (size_t)(r & 255) * 64 + (col0 & 63)) = pack8(v[0], v[1]);
                else *(u32x4*)(O + (size_t)r * DFF + col0) = pack8(v[0], v[1]);
            }
    }
};
template <bool IN_BF16> struct EpiResid {
    static constexpr bool PERM = true, AFTER_DRAIN = true;
    const float* hin; bf16_t* hb; float* ss; float scale; ::XcdBarrier xbar;
    __device__ __forceinline__ void fused(f32x4 (&acc)[2][2][4][2], const Unit& u, int wr, int wc, int fr, int fq, PG8_LAS unsigned char*, int, int) const {
        const int row0 = u.pm * BM + wr * 64 + fr, col0 = u.pn * BM + wc * 32 + 8 * fq;
        f32x4 xv[4][2][2][2];
#define EPIRESID_LOAD(k) _Pragma("unroll") for (int mm = 0; mm < 2; ++mm) _Pragma("unroll") for (int bj = 0; bj < 2; ++bj) { \
            const size_t off_ = (size_t)(row0 + ((k) >> 1) * HALF + (2 * ((k) & 1) + mm) * 16) * DM + col0 + bj * HALF; \
            if (IN_BF16) { const u32x4 w_ = *(const u32x4*)(hb + off_); \
                xv[k][mm][bj][0] = (f32x4){__uint_as_float(w_.x << 16), __uint_as_float(w_.x & 0xffff0000u), __uint_as_float(w_.y << 16), __uint_as_float(w_.y & 0xffff0000u)}; \
                xv[k][mm][bj][1] = (f32x4){__uint_as_float(w_.z << 16), __uint_as_float(w_.z & 0xffff0000u), __uint_as_float(w_.w << 16), __uint_as_float(w_.w & 0xffff0000u)}; } \
            else { xv[k][mm][bj][0] = *(const f32x4*)(hin + off_); xv[k][mm][bj][1] = *(const f32x4*)(hin + off_ + 4); } }
        EPIRESID_LOAD(0)
#pragma unroll
        for (int k = 0; k < 4; ++k) {
            if (k == 0) { EPIRESID_LOAD(1) } else if (k == 1) { EPIRESID_LOAD(2) } else if (k == 2) { EPIRESID_LOAD(3) }
            asm volatile("" ::: "memory");
            const int ai = k >> 1;
#pragma unroll
            for (int mm = 0; mm < 2; ++mm) { const int m = 2 * (k & 1) + mm, r = row0 + ai * HALF + m * 16; float sq = 0.f;
#pragma unroll
                for (int bj = 0; bj < 2; ++bj) { const size_t off = (size_t)r * DM + col0 + bj * HALF;
                    const f32x4 a = xv[k][mm][bj][0] + acc[ai][bj][m][0] * scale, b = xv[k][mm][bj][1] + acc[ai][bj][m][1] * scale;
                    *(u32x4*)(hb + off) = pack8(a, b);
                    sq += (a[0] * a[0] + a[1] * a[1]) + (a[2] * a[2] + a[3] * a[3]) + (b[0] * b[0] + b[1] * b[1]) + (b[2] * b[2] + b[3] * b[3]); }
                sq += __shfl_xor(sq, 16); sq += __shfl_xor(sq, 32);
                if (fq == 0) unsafeAtomicAdd(ss + r, sq); }
            asm volatile("" ::: "memory");
        }
#undef EPIRESID_LOAD
        ::xcd_barrier(xbar);
    }
};
struct EpiQKV {
    static constexpr bool PERM = true, AFTER_DRAIN = false;
    static constexpr bool PRELOAD = true;
    bf16_t* base; const float* ss; float qscale; size_t tstride;
    __device__ __forceinline__ void preload(const Unit& u, int wr, int fr, float (&pre)[8]) const {
#pragma unroll
        for (int i = 0; i < 8; ++i) pre[i] = ss[u.pm * BM + wr * 64 + fr + (i >> 2) * HALF + (i & 3) * 16];
    }
    __device__ __forceinline__ void operator()(const f32x4 (&acc)[2][2][4][2], const Unit& u, int wr, int wc, int fr, int fq, const float (&pre)[8]) const {
        const int t = u.pn >> 2; const float sc = (t == 0 || t == 3) ? qscale : 1.0f;
        const int row0 = u.pm * BM + wr * 64 + fr, col0 = (u.pn & 3) * BM + wc * 32 + 8 * fq; bf16_t* O = base + (size_t)t * tstride;
        float rsv[2][4];
#pragma unroll
        for (int ai = 0; ai < 2; ++ai)
#pragma unroll
            for (int m = 0; m < 4; ++m) rsv[ai][m] = pre[4 * ai + m];
#pragma unroll
        for (int ai = 0; ai < 2; ++ai)
#pragma unroll
            for (int m = 0; m < 4; ++m) {
                const int r = row0 + ai * HALF + m * 16; const float rs = __builtin_amdgcn_rsqf(rsv[ai][m] * (1.0f / 2048.0f) + RMS_EPS) * sc;
#pragma unroll
                for (int bj = 0; bj < 2; ++bj) *(u32x4*)(O + (size_t)r * 1024 + col0 + bj * HALF) = pack8(acc[ai][bj][m][0] * rs, acc[ai][bj][m][1] * rs);
            }
    }
};
struct EpiF32 {
    static constexpr bool PERM = true, AFTER_DRAIN = false;
    float* O;
    __device__ __forceinline__ void operator()(const f32x4 (&acc)[2][2][4][2], const Unit& u, int wr, int wc, int fr, int fq) const {
        const int row0 = u.pm * BM + wr * 64 + fr, col0 = u.pn * BM + wc * 32 + 8 * fq;
#pragma unroll
        for (int ai = 0; ai < 2; ++ai)
#pragma unroll
            for (int m = 0; m < 4; ++m)
            {
#pragma unroll
              for (int bj = 0; bj < 2; ++bj) { float* o = O + (size_t)(row0 + ai * HALF + m * 16) * DM + col0 + bj * HALF; *(f32x4*)o = acc[ai][bj][m][0]; *(f32x4*)(o + 4) = acc[ai][bj][m][1]; } }
    }
};
struct EpiBf16Plain {
    static constexpr bool PERM = true, AFTER_DRAIN = false;
    bf16_t* O;
    __device__ __forceinline__ void operator()(const f32x4 (&acc)[2][2][4][2], const Unit& u, int wr, int wc, int fr, int fq) const {
        const int row0 = u.pm * BM + wr * 64 + fr, col0 = u.pn * BM + wc * 32 + 8 * fq;
#pragma unroll
        for (int ai = 0; ai < 2; ++ai)
#pragma unroll
            for (int m = 0; m < 4; ++m)
#pragma unroll
                for (int bj = 0; bj < 2; ++bj) *(u32x4*)(O + (size_t)(row0 + ai * HALF + m * 16) * DM + col0 + bj * HALF) = pack8(acc[ai][bj][m][0], acc[ai][bj][m][1]);
    }
};
struct EpiPle {
    static constexpr bool PERM = true, AFTER_DRAIN = false;
    const float* hin; float* out; const float* ss3; float* ss4;
    __device__ __forceinline__ void operator()(const f32x4 (&acc)[2][2][4][2], const Unit& u, int wr, int wc, int fr, int fq) const {
        const int row0 = u.pm * BM + wr * 64 + fr, col0 = u.pn * BM + wc * 32 + 8 * fq;
#pragma unroll
        for (int ai = 0; ai < 2; ++ai)
#pragma unroll
            for (int m = 0; m < 4; ++m) {
                const int r = row0 + ai * HALF + m * 16; const float rs = rs_of(ss3, r); float sq = 0.f;
#pragma unroll
                for (int bj = 0; bj < 2; ++bj) { const size_t off = (size_t)r * DM + col0 + bj * HALF;
                    const f32x4 x0 = *(const f32x4*)(hin + off), x1 = *(const f32x4*)(hin + off + 4), p0 = *(const f32x4*)(out + off), p1 = *(const f32x4*)(out + off + 4);
                    const f32x4 a0 = acc[ai][bj][m][0] * rs, a1 = acc[ai][bj][m][1] * rs;
                    const f32x4 g0 = (f32x4){sigm_f(a0[0]), sigm_f(a0[1]), sigm_f(a0[2]), sigm_f(a0[3])}, g1 = (f32x4){sigm_f(a1[0]), sigm_f(a1[1]), sigm_f(a1[2]), sigm_f(a1[3])};
                    const f32x4 y0 = x0 + g0 * p0, y1 = x1 + g1 * p1;
                    *(f32x4*)(out + off) = y0; *(f32x4*)(out + off + 4) = y1;
                    sq += (y0[0] * y0[0] + y0[1] * y0[1]) + (y0[2] * y0[2] + y0[3] * y0[3]) + (y1[0] * y1[0] + y1[1] * y1[1]) + (y1[2] * y1[2] + y1[3] * y1[3]); }
                sq += __shfl_xor(sq, 16); sq += __shfl_xor(sq, 32);
                if (fq == 0) unsafeAtomicAdd(ss4 + r, sq);
            }
    }
};

struct EpiPleNorm {
    static constexpr bool PERM = true, AFTER_DRAIN = true;
    const bf16_t* hbin; float* out; const float* ss3; float* ss4; const float* gfin; unsigned* pcnt; const bf16_t* ppb;
    __device__ __forceinline__ void fused(f32x4 (&acc)[2][2][4][2], const Unit& u, int wr, int wc, int fr, int fq, PG8_LAS unsigned char*, int, int lane) const {
        const int row0 = u.pm * BM + wr * 64 + fr, col0 = u.pn * BM + wc * 32 + 8 * fq;
        float rsv[2][4];
#pragma unroll
        for (int ai = 0; ai < 2; ++ai)
#pragma unroll
            for (int m = 0; m < 4; ++m) rsv[ai][m] = ss3[row0 + ai * HALF + m * 16];
#pragma unroll
        for (int ai = 0; ai < 2; ++ai)
#pragma unroll
            for (int mh = 0; mh < 2; ++mh) {
                f32x4 xv[2][2][2]; u32x4 pw[2][2];
#pragma unroll
                for (int mm = 0; mm < 2; ++mm)
#pragma unroll
                    for (int bj = 0; bj < 2; ++bj) { const size_t off = (size_t)(row0 + ai * HALF + (2 * mh + mm) * 16) * DM + col0 + bj * HALF;
                        const u32x4 w_ = *(const u32x4*)(hbin + off);
                        xv[mm][bj][0] = (f32x4){__uint_as_float(w_.x << 16), __uint_as_float(w_.x & 0xffff0000u), __uint_as_float(w_.y << 16), __uint_as_float(w_.y & 0xffff0000u)};
                        xv[mm][bj][1] = (f32x4){__uint_as_float(w_.z << 16), __uint_as_float(w_.z & 0xffff0000u), __uint_as_float(w_.w << 16), __uint_as_float(w_.w & 0xffff0000u)};
                        pw[mm][bj] = *(const u32x4*)(ppb + off); }
#pragma unroll
                for (int mm = 0; mm < 2; ++mm) { const int m = 2 * mh + mm, r = row0 + ai * HALF + m * 16; const float rs = __builtin_amdgcn_rsqf(rsv[ai][m] * (1.0f / 2048.0f) + RMS_EPS); float sq = 0.f;
#pragma unroll
                    for (int bj = 0; bj < 2; ++bj) {
                        const f32x4 a0 = acc[ai][bj][m][0] * rs, a1 = acc[ai][bj][m][1] * rs;
                        const f32x4 g0 = (f32x4){sigm_f(a0[0]), sigm_f(a0[1]), sigm_f(a0[2]), sigm_f(a0[3])}, g1 = (f32x4){sigm_f(a1[0]), sigm_f(a1[1]), sigm_f(a1[2]), sigm_f(a1[3])};
                        const u32x4 w = pw[mm][bj];
                        const f32x4 p0 = (f32x4){__uint_as_float(w.x << 16), __uint_as_float(w.x & 0xffff0000u), __uint_as_float(w.y << 16), __uint_as_float(w.y & 0xffff0000u)}, p1 = (f32x4){__uint_as_float(w.z << 16), __uint_as_float(w.z & 0xffff0000u), __uint_as_float(w.w << 16), __uint_as_float(w.w & 0xffff0000u)};
                        const f32x4 y0 = xv[mm][bj][0] + g0 * p0, y1 = xv[mm][bj][1] + g1 * p1;
                        acc[ai][bj][m][0] = y0; acc[ai][bj][m][1] = y1;
                        sq += (y0[0] * y0[0] + y0[1] * y0[1]) + (y0[2] * y0[2] + y0[3] * y0[3]) + (y1[0] * y1[0] + y1[1] * y1[1]) + (y1[2] * y1[2] + y1[3] * y1[3]); }
                    sq += __shfl_xor(sq, 16); sq += __shfl_xor(sq, 32);
                    if (fq == 0) unsafeAtomicAdd(ss4 + r, sq); }
            }
        asm volatile("s_waitcnt vmcnt(0)" ::: "memory");
        unsigned* c = pcnt + 64 * u.pm;
        if (lane == 0) __hip_atomic_fetch_add(c, 1u, __ATOMIC_RELAXED, __HIP_MEMORY_SCOPE_AGENT);
        if (wr == 0 && wc == 0) { unsigned sp = 0; while ((unsigned)__builtin_amdgcn_readfirstlane(__hip_atomic_load(c, __ATOMIC_RELAXED, __HIP_MEMORY_SCOPE_AGENT)) < 64u) { __builtin_amdgcn_s_sleep(4); if (++sp > (1u << 21)) break; } }
        asm volatile("s_waitcnt vmcnt(0) lgkmcnt(0)" ::: "memory"); __builtin_amdgcn_s_barrier(); asm volatile("" ::: "memory");
        f32x4 gv[2][2];
#pragma unroll
        for (int bj = 0; bj < 2; ++bj) { gv[bj][0] = *(const f32x4*)(gfin + col0 + bj * HALF); gv[bj][1] = *(const f32x4*)(gfin + col0 + bj * HALF + 4); }
        float s4[2][4];
#pragma unroll
        for (int ai = 0; ai < 2; ++ai)
#pragma unroll
            for (int m = 0; m < 4; ++m) s4[ai][m] = __hip_atomic_load(ss4 + row0 + ai * HALF + m * 16, __ATOMIC_RELAXED, __HIP_MEMORY_SCOPE_AGENT);
#pragma unroll
        for (int ai = 0; ai < 2; ++ai)
#pragma unroll
            for (int m = 0; m < 4; ++m) {
                const int r = row0 + ai * HALF + m * 16;
                const float rs = __builtin_amdgcn_rsqf(s4[ai][m] * (1.0f / 2048.0f) + RMS_EPS);
#pragma unroll
                for (int bj = 0; bj < 2; ++bj) { float* o = out + (size_t)r * DM + col0 + bj * HALF;
                    *(f32x4*)o = acc[ai][bj][m][0] * rs * gv[bj][0]; *(f32x4*)(o + 4) = acc[ai][bj][m][1] * rs * gv[bj][1]; }
            }
    }
};
template <class E_> struct has_preload { template <class T> static constexpr auto test(int) -> decltype(T::PRELOAD, true) { return T::PRELOAD; } template <class> static constexpr bool test(...) { return false; } static constexpr bool value = test<E_>(0); };
template <class Epi, class Sched, bool ALIGN_EPI = false, bool SP2 = false, bool TILED = false  >
__device__ __forceinline__ void gemm_phase(PG8_LAS unsigned char* lds, const Gemm g, const Sched& S, const Epi& E) {
    int tid_l = threadIdx.x; asm volatile("" : "+v"(tid_l));
    const int tid = tid_l, wid = __builtin_amdgcn_readfirstlane(tid >> 6), lane = tid & 63, wr = wid >> 2, wc = wid & 3, fr = lane & 15, fq = lane >> 4;
    const int K = g.K, nt = K / BK;
    unsigned voffA[2], voffB[2];
#pragma unroll
    for (int i = 0; i < 2; ++i) { int R, C; stage_rc(tid * 16 + i * 8192, R, C); const int Rb = Epi::PERM ? ((R & ~31) + perm32(R & 31)) : R;
        voffA[i] = (unsigned)(R * (TILED ? BK : K) + C) * 2u; voffB[i] = (unsigned)(Rb * (TILED ? BK : K) + C) * 2u; }
    const size_t kstep = TILED ? (size_t)(BM * BK * 2) : (size_t)(BK * 2);
    const size_t hstep = TILED ? (size_t)(HALF * BK * 2) : (size_t)HALF * K * 2;
    const size_t tstep = (size_t)BM * K * 2;
    const unsigned ldsw = (unsigned)wid * 1024u;
    const int aoff = lds_byte(wr * 64 + fr, fq * 8), boff = lds_byte(wc * 32 + fr, fq * 8);
#define PG8_SA(b, h) (((b) * 2 + (h)) * HTB)
#define PG8_SB(b, h) ((4 + (b) * 2 + (h)) * HTB)
#define PG8_STAGE(bufoff, gbase, voff) do { _Pragma("unroll") for (int _i = 0; _i < 2; ++_i) \
        __builtin_amdgcn_global_load_lds((const unsigned*)((const char*)(gbase) + (voff)[_i]), (PG8_LAS unsigned*)(lds + (bufoff) + ldsw + _i * 8192), 16, 0, 0); } while (0)
#define PG8_LDA(dst, b, h) do { _Pragma("unroll") for (int m = 0; m < 4; ++m) _Pragma("unroll") for (int k = 0; k < 2; ++k) dst[m][k] = *(const PG8_LAS bf16x8*)(lds + PG8_SA(b, h) + aoff + m * 2048 + k * 1024); } while (0)
#define PG8_LDB(dst, b, h) do { _Pragma("unroll") for (int n = 0; n < 2; ++n) _Pragma("unroll") for (int k = 0; k < 2; ++k) dst[n][k] = *(const PG8_LAS bf16x8*)(lds + PG8_SB(b, h) + boff + n * 2048 + k * 1024); } while (0)
#define PG8_MMA(ai, bj, At, Bt) do { __builtin_amdgcn_s_setprio(1); _Pragma("unroll") for (int m = 0; m < 4; ++m) _Pragma("unroll") for (int n = 0; n < 2; ++n) _Pragma("unroll") for (int k = 0; k < 2; ++k) \
        acc[ai][bj][m][n] = __builtin_amdgcn_mfma_f32_16x16x32_bf16(Bt[n][k], At[m][k], acc[ai][bj][m][n], 0, 0, 0); __builtin_amdgcn_s_setprio(0); } while (0)
#define PG8_WAIT_V(n) asm volatile("s_waitcnt vmcnt(" #n ")" ::: "memory")
#define PG8_WAIT_L(n) asm volatile("s_waitcnt lgkmcnt(" #n ")" ::: "memory")
#define PG8_BAR __builtin_amdgcn_s_barrier()
#define PG8_SCHED __builtin_amdgcn_sched_barrier(0)
    Unit cur, nxt; int ui = 0;
    if (!S.next(0, cur)) return;
    f32x4 acc[2][2][4][2];
#pragma unroll
    for (int a = 0; a < 2; ++a)
#pragma unroll
        for (int b = 0; b < 2; ++b)
#pragma unroll
            for (int m = 0; m < 4; ++m)
#pragma unroll
                for (int n = 0; n < 2; ++n) acc[a][b][m][n] = (f32x4){0.f, 0.f, 0.f, 0.f};
    bf16x8 At[4][2], B0[2][2], B1[2][2];
    const char* cA = (const char*)g.A + (size_t)cur.pm * tstep; const char* cB = (const char*)g.Bt + (size_t)cur.pn * tstep;
    S.a_ready(cur);
    float pre[8];
    if constexpr (has_preload<Epi>::value) E.preload(cur, wr, fr, pre);
    if constexpr (SP2) {
        PG8_STAGE(PG8_SB(0, 0), cB, voffB); PG8_STAGE(PG8_SB(0, 1), cB + hstep, voffB); PG8_STAGE(PG8_SA(0, 0), cA, voffA); PG8_STAGE(PG8_SA(0, 1), cA + hstep, voffA);
        if (wr == 1) PG8_BAR;
        PG8_WAIT_V(2); PG8_BAR;
        PG8_STAGE(PG8_SB(1, 0), cB + kstep, voffB); PG8_STAGE(PG8_SA(1, 0), cA + kstep, voffA); PG8_STAGE(PG8_SB(1, 1), cB + hstep + kstep, voffB);
        PG8_WAIT_V(6); PG8_BAR;
    } else {
        PG8_STAGE(PG8_SB(0, 0), cB, voffB); PG8_STAGE(PG8_SA(0, 0), cA, voffA); PG8_STAGE(PG8_SB(0, 1), cB + hstep, voffB); PG8_STAGE(PG8_SA(0, 1), cA + hstep, voffA);
        if (wr == 1) PG8_BAR;
        PG8_WAIT_V(4); PG8_BAR;
        PG8_STAGE(PG8_SB(1, 0), cB + kstep, voffB); PG8_STAGE(PG8_SA(1, 0), cA + kstep, voffA); PG8_STAGE(PG8_SB(1, 1), cB + hstep + kstep, voffB);
        PG8_WAIT_V(6); PG8_BAR;
    }
    for (;;) {
        const bool has_next = S.next(ui + 1, nxt);
        const char* nA = has_next ? (const char*)g.A + (size_t)nxt.pm * tstep : cA; const char* nB = has_next ? (const char*)g.Bt + (size_t)nxt.pn * tstep : cB;
        for (int t = 0; t < nt; t += 2) {
            const bool last = (t == nt - 2);
            const char* a1 = cA + (size_t)(t + 1) * kstep;
            const char* a2 = last ? nA : cA + (size_t)(t + 2) * kstep; const char* b2 = last ? nB : cB + (size_t)(t + 2) * kstep;
            const char* a3 = a2 + kstep; const char* b3 = b2 + kstep;
            if (last && has_next) S.a_ready(nxt);
            if constexpr (SP2) {
            PG8_LDB(B0, 0, 0); PG8_LDB(B1, 0, 1); PG8_SCHED; PG8_LDA(At, 0, 0); PG8_STAGE(PG8_SA(1, 1), a1 + hstep, voffA);
            PG8_WAIT_V(8); PG8_WAIT_L(0); PG8_BAR; PG8_MMA(0, 0, At, B0); PG8_MMA(0, 1, At, B1); PG8_BAR; PG8_SCHED;
            PG8_LDA(At, 0, 1); PG8_STAGE(PG8_SB(0, 0), b2, voffB); PG8_STAGE(PG8_SB(0, 1), b2 + hstep, voffB); PG8_STAGE(PG8_SA(0, 0), a2, voffA);
            PG8_WAIT_V(8); PG8_WAIT_L(0); PG8_BAR; PG8_MMA(1, 0, At, B0); PG8_MMA(1, 1, At, B1); PG8_BAR; PG8_SCHED;
            PG8_LDB(B0, 1, 0); PG8_LDB(B1, 1, 1); PG8_SCHED; PG8_LDA(At, 1, 0); PG8_STAGE(PG8_SA(0, 1), a2 + hstep, voffA);
            PG8_WAIT_V(8); PG8_WAIT_L(0); PG8_BAR; PG8_MMA(0, 0, At, B0); PG8_MMA(0, 1, At, B1); PG8_BAR; PG8_SCHED;
            PG8_LDA(At, 1, 1); PG8_STAGE(PG8_SB(1, 0), b3, voffB); PG8_STAGE(PG8_SB(1, 1), b3 + hstep, voffB); PG8_STAGE(PG8_SA(1, 0), a3, voffA);
            PG8_WAIT_V(8); PG8_WAIT_L(0); PG8_BAR; PG8_MMA(1, 0, At, B0); PG8_MMA(1, 1, At, B1); PG8_BAR; PG8_SCHED;
            } else {
            PG8_LDB(B0, 0, 0); PG8_SCHED; PG8_LDA(At, 0, 0); PG8_STAGE(PG8_SA(1, 1), a1 + hstep, voffA);
            PG8_WAIT_L(8); PG8_BAR; PG8_WAIT_L(0); PG8_MMA(0, 0, At, B0); PG8_BAR; PG8_SCHED;
            PG8_LDB(B1, 0, 1); PG8_STAGE(PG8_SB(0, 0), b2, voffB);
            PG8_BAR; PG8_WAIT_L(0); PG8_MMA(0, 1, At, B1); PG8_BAR;
            PG8_LDA(At, 0, 1); PG8_STAGE(PG8_SA(0, 0), a2, voffA);
            PG8_BAR; PG8_WAIT_L(0); PG8_MMA(1, 0, At, B0); PG8_BAR; PG8_SCHED;
            PG8_STAGE(PG8_SB(0, 1), b2 + hstep, voffB);
            PG8_WAIT_V(6); PG8_BAR; PG8_MMA(1, 1, At, B1); PG8_BAR;
            PG8_LDB(B0, 1, 0); PG8_SCHED; PG8_LDA(At, 1, 0); PG8_STAGE(PG8_SA(0, 1), a2 + hstep, voffA);
            PG8_WAIT_L(8); PG8_BAR; PG8_WAIT_L(0); PG8_MMA(0, 0, At, B0); PG8_BAR; PG8_SCHED;
            PG8_LDB(B1, 1, 1); PG8_STAGE(PG8_SB(1, 0), b3, voffB);
            PG8_BAR; PG8_WAIT_L(0); PG8_MMA(0, 1, At, B1); PG8_BAR;
            PG8_LDA(At, 1, 1); PG8_STAGE(PG8_SA(1, 0), a3, voffA);
            PG8_BAR; PG8_WAIT_L(0); PG8_MMA(1, 0, At, B0); PG8_BAR; PG8_SCHED;
            PG8_STAGE(PG8_SB(1, 1), b3 + hstep, voffB);
            PG8_WAIT_V(6); PG8_BAR; PG8_MMA(1, 1, At, B1); PG8_BAR;
            }
        }
        if constexpr (ALIGN_EPI) { if (wr == 0) PG8_BAR; }
        if constexpr (!Epi::AFTER_DRAIN) { if constexpr (has_preload<Epi>::value) E(acc, cur, wr, wc, fr, fq, pre); else E(acc, cur, wr, wc, fr, fq); S.done(cur); }
        if (!has_next) break;
#pragma unroll
        for (int a = 0; a < 2; ++a)
#pragma unroll
            for (int b = 0; b < 2; ++b)
#pragma unroll
                for (int m = 0; m < 4; ++m)
#pragma unroll
                    for (int n = 0; n < 2; ++n) acc[a][b][m][n] = (f32x4){0.f, 0.f, 0.f, 0.f};
        cur = nxt; cA = nA; cB = nB; ++ui;
        if constexpr (has_preload<Epi>::value) E.preload(cur, wr, fr, pre);
        if constexpr (ALIGN_EPI) { if (wr == 1) PG8_BAR; }
    }
    PG8_WAIT_V(0);
    if constexpr (!ALIGN_EPI) { if (wr == 0) PG8_BAR; }
    PG8_BAR;
    if constexpr (Epi::AFTER_DRAIN) { E.fused(acc, cur, wr, wc, fr, fq, lds, wid, lane); S.done(cur); }
#undef PG8_SA
#undef PG8_SB
#undef PG8_STAGE
#undef PG8_LDA
#undef PG8_LDB
#undef PG8_MMA
#undef PG8_WAIT_V
#undef PG8_WAIT_L
#undef PG8_BAR
#undef PG8_SCHED
}
}
namespace att {
#define ALAS __attribute__((address_space(3)))
typedef unsigned short bf16;
typedef short bf16x8 __attribute__((ext_vector_type(8)));
typedef short s16x4 __attribute__((ext_vector_type(4)));
typedef float f32x16 __attribute__((ext_vector_type(16)));
typedef float f32x4 __attribute__((ext_vector_type(4)));
typedef unsigned u32x4 __attribute__((ext_vector_type(4)));
typedef unsigned u32x2 __attribute__((ext_vector_type(2)));
typedef float f32x2_t __attribute__((ext_vector_type(2))); typedef __bf16 bf16x2_t __attribute__((ext_vector_type(2)));
constexpr int SEQ = 2048, NB = 4, NH = 8, HD = 128, ROWP = 1024;
constexpr int OFF_K = 0, OFF_V = 32768, OFF_NEGF = 65536, OFF_BIAS = 65536 + 8192, OFF_MISC = OFF_BIAS + 2304;
constexpr float LOG2E = 1.4426950408889634f;
__device__ __forceinline__ unsigned off_b(unsigned row, unsigned ch) { return 256u * row + 16u * (ch ^ (((row & 3u) << 2) | ((row >> 2) & 3u))); }
__device__ __forceinline__ unsigned cvtpk_s(float lo, float hi) { f32x2_t v = {lo, hi}; bf16x2_t b = __builtin_convertvector(v, bf16x2_t); return __builtin_bit_cast(unsigned, b); }
__device__ __forceinline__ float fadd_s(float x, float y) { float r = x + y; asm("" : "+v"(r)); return r; }
__device__ __forceinline__ float fsub_s(float x, float y) { float r = x - y; asm("" : "+v"(r)); return r; }
__device__ __forceinline__ float fmul_s(float x, float y) { float r = x * y; asm("" : "+v"(r)); return r; }
__device__ __forceinline__ s16x4 vtr(ALAS const unsigned char* p) { return __builtin_bit_cast(s16x4, __builtin_amdgcn_ds_read_tr16_b64_v4i16((ALAS s16x4*)p)); }

struct TileRegs { u32x4 k[2], v[2]; };
__device__ __forceinline__ void tile_gload(TileRegs& R, const bf16* Kg, const bf16* Vg, int tok0, int tid) {
#pragma unroll
    for (int i = 0; i < 2; ++i) { const int id = tid + 512 * i, row = id >> 4, ch = id & 15; const size_t o = (size_t)(tok0 + row) * ROWP + ch * 8;
        R.k[i] = *(const u32x4*)(Kg + o); R.v[i] = *(const u32x4*)(Vg + o); }
}
__device__ __forceinline__ void tile_lstore(const TileRegs& R, ALAS unsigned char* kbuf, ALAS unsigned char* vbuf, int tid) {
#pragma unroll
    for (int i = 0; i < 2; ++i) { const int id = tid + 512 * i, row = id >> 4, ch = id & 15; const unsigned o = off_b(row, ch);
        *(ALAS u32x4*)(kbuf + o) = R.k[i]; *(ALAS u32x4*)(vbuf + o) = R.v[i]; }
}

template <int MODE>
__device__ __forceinline__ void tile_compute(f32x16 (&o)[4], float& m_run, float& l_run, const bf16x8 (&qf)[8], ALAS const unsigned char* lds, ALAS const unsigned char* kbuf, ALAS const unsigned char* vbuf,
                                             int lane, int rel0  , bool cst  , int key0  , bool diag, int tloc  ) {
    const int r = lane & 31, h = lane >> 5;
    const int kap = (r & 0x13) | ((r & 4) << 1) | ((r & 8) >> 1);
    f32x16 s[2];
    if (MODE == 1) {
        ALAS const float* nf = (ALAS const float*)(lds + OFF_NEGF) + key0;
#pragma unroll
        for (int kb = 0; kb < 2; ++kb)
#pragma unroll
            for (int g = 0; g < 4; ++g) { const f32x4 f = *(ALAS const f32x4*)(nf + 32 * kb + 4 * (g & 1) + 16 * (g >> 1));
#pragma unroll
                for (int e = 0; e < 4; ++e) s[kb][4 * g + e] = f[e]; }
    } else {
        const float c = cst ? ((ALAS const float*)(lds + OFF_BIAS))[512] : 0.f;
#pragma unroll
        for (int i = 0; i < 16; ++i) { s[0][i] = c; s[1][i] = c; }
    }
#pragma unroll
    for (int ks = 0; ks < 8; ++ks) {
        const bf16x8 k0 = *(ALAS const bf16x8*)(kbuf + off_b(kap, 2 * ks + h));
        const bf16x8 k1 = *(ALAS const bf16x8*)(kbuf + 8192 + off_b(kap, 2 * ks + h));
        s[0] = __builtin_amdgcn_mfma_f32_32x32x16_bf16(k0, qf[ks], s[0], 0, 0, 0);
        s[1] = __builtin_amdgcn_mfma_f32_32x32x16_bf16(k1, qf[ks], s[1], 0, 0, 0);
    }
    if (MODE == 0) {
        if (!cst) { ALAS const float* bt = (ALAS const float*)(lds + OFF_BIAS);
#pragma unroll
            for (int kb = 0; kb < 2; ++kb)
#pragma unroll
                for (int i = 0; i < 16; ++i) { int rel = rel0 - 32 * kb - (i & 7) - 16 * (i >> 3); rel = rel < 256 ? rel : 256; rel = rel > -256 ? rel : -256; s[kb][i] = fadd_s(s[kb][i], bt[rel + 256]); }
        }
    } else if (diag) {
#pragma unroll
        for (int kb = 0; kb < 2; ++kb)
#pragma unroll
            for (int i = 0; i < 16; ++i) if (32 * kb + (i & 7) + 16 * (i >> 3) > tloc) s[kb][i] = -INFINITY;
    }
    float mx = s[0][0];
#pragma unroll
    for (int i = 1; i < 16; ++i) mx = fmaxf(mx, s[0][i]);
#pragma unroll
    for (int i = 0; i < 16; ++i) mx = fmaxf(mx, s[1][i]);
    { auto rr = __builtin_amdgcn_permlane32_swap(__float_as_uint(mx), __float_as_uint(mx), false, false); mx = fmaxf(__uint_as_float(rr[0]), __uint_as_float(rr[1])); }
    constexpr float RESC_THR = 10.0f;
    if (__builtin_amdgcn_ballot_w64(mx > m_run + RESC_THR) != 0ull) {
        const float m_new = fmaxf(m_run, mx), alpha = __builtin_amdgcn_exp2f(m_run - m_new);
        m_run = m_new; l_run *= alpha;
#pragma unroll
        for (int c = 0; c < 4; ++c)
#pragma unroll
            for (int i = 0; i < 16; ++i) o[c][i] = fmul_s(o[c][i], alpha);
    }
    float ps = 0.f;
#pragma unroll
    for (int kb = 0; kb < 2; ++kb)
#pragma unroll
        for (int i = 0; i < 16; ++i) { const float p = __builtin_amdgcn_exp2f(fsub_s(s[kb][i], m_run)); s[kb][i] = p; ps = fadd_s(ps, p); }
    l_run += ps;
    bf16x8 pf[4];
#pragma unroll
    for (int ks = 0; ks < 4; ++ks) { const int kb = ks >> 1, b8 = 8 * (ks & 1); u32x4 w;
        w.x = cvtpk_s(s[kb][b8 + 0], s[kb][b8 + 1]); w.y = cvtpk_s(s[kb][b8 + 2], s[kb][b8 + 3]); w.z = cvtpk_s(s[kb][b8 + 4], s[kb][b8 + 5]); w.w = cvtpk_s(s[kb][b8 + 6], s[kb][b8 + 7]);
        pf[ks] = __builtin_bit_cast(bf16x8, w); }
    const unsigned blk = (lane >> 4) & 1, q4 = (lane & 15) >> 2, p4 = lane & 3;
#pragma unroll
    for (int c = 0; c < 4; ++c)
#pragma unroll
        for (int ks = 0; ks < 4; ++ks) {
            ALAS const unsigned char* a0 = vbuf + off_b(16 * ks + 8 * h + q4, 4 * c + 2 * blk + (p4 >> 1)) + 8 * (p4 & 1);
            ALAS const unsigned char* a1 = vbuf + off_b(16 * ks + 8 * h + 4 + q4, 4 * c + 2 * blk + (p4 >> 1)) + 8 * (p4 & 1);
            const s16x4 lo = vtr(a0), hi = vtr(a1);
            const bf16x8 vf = (bf16x8){lo[0], lo[1], lo[2], lo[3], hi[0], hi[1], hi[2], hi[3]};
            o[c] = __builtin_amdgcn_mfma_f32_32x32x16_bf16(vf, pf[ks], o[c], 0, 0, 0);
        }
}

struct Tensors { const bf16* q; const bf16* k; const bf16* v; bf16* o; const float* lf; const float* rel_bias; };

template <int MODE>
__device__ __forceinline__ void attn_item(ALAS unsigned char* lds, const Tensors& T, int b, int hd, int blk) {
    int tid_l = threadIdx.x; asm volatile("" : "+v"(tid_l));
    const int tid = tid_l, lane = tid & 63, w = __builtin_amdgcn_readfirstlane(tid >> 6), r = lane & 31, h = lane >> 5;
    if (MODE == 0) {
        ALAS float* bt = (ALAS float*)(lds + OFF_BIAS);
        for (int i = tid; i < 513; i += 512) bt[i] = T.rel_bias[hd * 513 + i] * LOG2E;
    } else {
        ALAS float* negF = (ALAS float*)(lds + OFF_NEGF); ALAS float* wsum = (ALAS float*)(lds + OFF_MISC + 64);
        float v[4];
#pragma unroll
        for (int e = 0; e < 4; ++e) v[e] = T.lf[((size_t)(b * SEQ + 4 * tid + e)) * 8 + hd];
        v[1] += v[0]; v[2] += v[1]; v[3] += v[2];
        const float tot = v[3]; float x = tot;
#pragma unroll
        for (int o_ = 1; o_ < 64; o_ <<= 1) { const float y = __shfl_up(x, o_); if (lane >= o_) x += y; }
        if (lane == 63) wsum[w] = x;
        __syncthreads();
        float offs = x - tot;
        for (int j = 0; j < w; ++j) offs += wsum[j];
#pragma unroll
        for (int e = 0; e < 4; ++e) negF[4 * tid + e] = -(v[e] + offs) * LOG2E;
    }
    const int qt = 4 * blk + (w >> 1);
    const int t_lo = (MODE == 0) ? (4 * blk - 8 > 0 ? 4 * blk - 8 : 0) : 0, t_hi = 4 * blk + 3;
    const int w_lo = (MODE == 0) ? qt - 8 : 0, w_hi = qt;
    const int tokq = b * SEQ + 64 * qt + 32 * (w & 1) + r;
    bf16x8 qf[8];
#pragma unroll
    for (int ks = 0; ks < 8; ++ks) qf[ks] = *(const bf16x8*)(T.q + (size_t)tokq * ROWP + hd * HD + 16 * ks + 8 * h);
    f32x16 o[4];
#pragma unroll
    for (int c = 0; c < 4; ++c)
#pragma unroll
        for (int i = 0; i < 16; ++i) o[c][i] = 0.f;
    float m_run = -1e30f, l_run = 0.f;
    const bf16* Kg = T.k + hd * HD; const bf16* Vg = T.v + hd * HD;
    TileRegs R;
    tile_gload(R, Kg, Vg, b * SEQ + 64 * t_lo, tid);
    tile_lstore(R, lds + OFF_K, lds + OFF_V, tid);
    __syncthreads();
    int cur = 0;
    for (int t = t_lo; t <= t_hi; ++t) {
        const bool more = t < t_hi;
        if (more) tile_gload(R, Kg, Vg, b * SEQ + 64 * (t + 1), tid);
        if (t >= w_lo && t <= w_hi) {
            const int tq = 64 * qt + 32 * (w & 1) + r;
            tile_compute<MODE>(o, m_run, l_run, qf, lds, lds + OFF_K + cur * 16384, lds + OFF_V + cur * 16384, lane,
                               tq - 64 * t - 8 * h, (qt - t) >= 5, 64 * t + 8 * h, t == qt, tq - 64 * t - 8 * h);
        }
        if (more) tile_lstore(R, lds + OFF_K + (cur ^ 1) * 16384, lds + OFF_V + (cur ^ 1) * 16384, tid);
        __syncthreads();
        cur ^= 1;
    }
    float l_tot = l_run; { auto rr = __builtin_amdgcn_permlane32_swap(__float_as_uint(l_run), __float_as_uint(l_run), false, false); l_tot = __uint_as_float(rr[0]) + __uint_as_float(rr[1]); }
    const float inv = 1.0f / l_tot;
    ALAS unsigned char* stg = lds + w * 8704;
#pragma unroll
    for (int c = 0; c < 4; ++c)
#pragma unroll
        for (int g = 0; g < 4; ++g) { u32x2 wv; wv.x = cvtpk_s(o[c][4 * g] * inv, o[c][4 * g + 1] * inv); wv.y = cvtpk_s(o[c][4 * g + 2] * inv, o[c][4 * g + 3] * inv);
            *(ALAS u32x2*)(stg + r * 272 + (32 * c + 8 * g + 4 * h) * 2) = wv; }
    asm volatile("s_waitcnt lgkmcnt(0)" ::: "memory");
    const int tok0 = b * SEQ + 64 * qt + 32 * (w & 1);
#pragma unroll
    for (int j = 0; j < 8; ++j) { const int row = (lane >> 4) + 4 * j, ch = lane & 15;
        const u32x4 v = *(ALAS const u32x4*)(stg + row * 272 + ch * 16);
        *(u32x4*)(T.o + (size_t)(tok0 + row) * 2048 + hd * HD + ch * 8) = v; }
}
}
typedef unsigned short bf16;
typedef float f32x4 __attribute__((ext_vector_type(4)));
typedef unsigned v4u __attribute__((ext_vector_type(4)));
typedef unsigned v2u __attribute__((ext_vector_type(2)));
constexpr int NWAVES = 8, NTHR = 512;
constexpr int M = 8192, D = 2048, FF = 5632, NGU = 2 * FF, DIN = 6152, NQKV = 6144, DPLE = 256, SEQ = 2048, NHB = 8;
constexpr size_t MiB = 1u << 20;
constexpr size_t WS_CTL = 0;
constexpr size_t CTL_CNT = 0;
constexpr size_t CTL_SS = 4096;
constexpr size_t CTL_LF = CTL_SS + 5 * (size_t)M * 4;
constexpr size_t CTL_WF = CTL_LF + (size_t)M * 8 * 4;
static_assert(CTL_WF + 8 * (size_t)D * 4 <= MiB, "control region");
constexpr size_t WS_WGU1 = 1 * MiB, WS_WD1 = WS_WGU1 + 44 * MiB, WS_WIN = WS_WD1 + 22 * MiB, WS_WOUT = WS_WIN + 24 * MiB, WS_WGU2 = WS_WOUT + 8 * MiB,
                 WS_WD2 = WS_WGU2 + 44 * MiB, WS_WG = WS_WD2 + 22 * MiB, WS_WP = WS_WG + 8 * MiB, WS_PB = WS_WP + 1 * MiB  , WS_AB = WS_PB + 4 * MiB  ,
                 WS_R1 = WS_AB + 32 * MiB  , WS_H = WS_R1 + 128 * MiB  , WS_END = WS_H + 64 * MiB;
constexpr size_t QKV_T = (size_t)M * 1024;
constexpr int LDS_BYTES = 147456;

__device__ __forceinline__ unsigned f2bf(float f) { unsigned u = __builtin_bit_cast(unsigned, f); return (u + 0x7fffu + ((u >> 16) & 1u)) >> 16; }
__device__ __forceinline__ unsigned pk2(float lo, float hi) { typedef float f2_t __attribute__((ext_vector_type(2))); typedef __bf16 b2_t __attribute__((ext_vector_type(2))); f2_t v = {lo, hi}; b2_t b = __builtin_convertvector(v, b2_t); return __builtin_bit_cast(unsigned, b); }
__device__ __forceinline__ float wave_sum(float v) {
#pragma unroll
    for (int o = 1; o < 64; o <<= 1) v += __shfl_xor(v, o);
    return v;
}
struct ConvRegs { f32x4 v[16]; };
constexpr int LDS_G = 8 * 16896;
__device__ __forceinline__ void conv_load(ConvRegs& R, const float* __restrict__ W, int ldw, int k0, int n0, int lane) {
#pragma unroll
    for (int it = 0; it < 8; ++it) { const int kk = 8 * it + (lane >> 3); const float* src = W + (size_t)(k0 + kk) * ldw + n0 + 4 * (lane & 7);
        R.v[it] = __builtin_nontemporal_load((const f32x4*)src); R.v[8 + it] = __builtin_nontemporal_load((const f32x4*)(src + 32)); }
}
template <bool HAS_G, bool TILED> __device__ __forceinline__ void conv_store(const ConvRegs& R, const LAS float* gl, bf16* WT, int K, int k0, int drowA, int drowB, LAS float* scr, int lane) {
#pragma unroll
    for (int it = 0; it < 8; ++it) { const int kk = 8 * it + (lane >> 3); const float gg = HAS_G ? gl[k0 + kk] : 1.0f; LAS float* s = scr + kk * 33 + 4 * (lane & 7);
        s[0] = R.v[it][0] * gg; s[1] = R.v[it][1] * gg; s[2] = R.v[it][2] * gg; s[3] = R.v[it][3] * gg;
        s[2112 + 0] = R.v[8 + it][0] * gg; s[2112 + 1] = R.v[8 + it][1] * gg; s[2112 + 2] = R.v[8 + it][2] * gg; s[2112 + 3] = R.v[8 + it][3] * gg; }
    asm volatile("s_waitcnt lgkmcnt(0)" ::: "memory");
    const int c = lane & 7;
#pragma unroll
    for (int hf = 0; hf < 2; ++hf)
#pragma unroll
        for (int j = 0; j < 4; ++j) { const int n = (lane >> 3) + 8 * j; const LAS float* s = scr + hf * 2112 + (8 * c) * 33 + n;
            v4u o; o.x = pk2(s[0 * 33], s[1 * 33]); o.y = pk2(s[2 * 33], s[3 * 33]); o.z = pk2(s[4 * 33], s[5 * 33]); o.w = pk2(s[6 * 33], s[7 * 33]);
            const int row = (hf ? drowB : drowA) + n;
            if (TILED) *(v4u*)(WT + ((size_t)(row >> 8) * (K >> 6) + (k0 >> 6)) * 16384 + (size_t)(row & 255) * 64 + 8 * c) = o;
            else *(v4u*)(WT + (size_t)row * K + k0 + 8 * c) = o; }
    asm volatile("s_waitcnt lgkmcnt(0)" ::: "memory");
}
__device__ __forceinline__ int gu_row(int n0) { const int hi = n0 >= FF, n = n0 - (hi ? FF : 0); return 256 * (n >> 7) + (n & 127) + 128 * hi; }
template <bool HAS_G, bool gu, bool PIPE, bool TILED = false> __device__ __forceinline__ void conv_matrix(const float* W, int ldw, const float* g, bf16* WT, int K, int ncols, int wv, int nwv, LAS float* scr, int lane, LAS unsigned char* lds) {
    const LAS float* gl = (const LAS float*)(lds + LDS_G);
    if (HAS_G) { __syncthreads(); for (int i = threadIdx.x; i < K; i += NTHR) ((LAS float*)(lds + LDS_G))[i] = g[i]; __syncthreads(); }
    const int nb = ncols / 64, total = (K / 64) * nb, last = total - 1;
    ConvRegs RA, RB;
    int it = wv;
    if (!PIPE) {
        if (it < total) conv_load(RA, W, ldw, 64 * (it / nb), 64 * (it % nb), lane);
        while (it < total) {
            const int itB = it + nwv, itA2 = itB + nwv;
            if (itB < total) conv_load(RB, W, ldw, 64 * (itB / nb), 64 * (itB % nb), lane);
            { const int n0 = 64 * (it % nb); conv_store<HAS_G, TILED>(RA, gl, WT, K, 64 * (it / nb), gu ? gu_row(n0) : n0, gu ? gu_row(n0 + 32) : n0 + 32, scr, lane); }
            if (itA2 < total) conv_load(RA, W, ldw, 64 * (itA2 / nb), 64 * (itA2 % nb), lane);
            if (itB < total) { const int n0 = 64 * (itB % nb); conv_store<HAS_G, TILED>(RB, gl, WT, K, 64 * (itB / nb), gu ? gu_row(n0) : n0, gu ? gu_row(n0 + 32) : n0 + 32, scr, lane); }
            it = itA2;
        }
        return;
    }
    if (it >= total) return;
    conv_load(RA, W, ldw, 64 * (it / nb), 64 * (it % nb), lane);
    while (it < total) {
        const int itB = (it + nwv < last) ? it + nwv : last, itA2 = (it + 2 * nwv < last) ? it + 2 * nwv : last;
        conv_load(RB, W, ldw, 64 * (itB / nb), 64 * (itB % nb), lane);
        { const int n0 = 64 * (it % nb); conv_store<HAS_G, TILED>(RA, gl, WT, K, 64 * (it / nb), gu ? gu_row(n0) : n0, gu ? gu_row(n0 + 32) : n0 + 32, scr, lane); }
        conv_load(RA, W, ldw, 64 * (itA2 / nb), 64 * (itA2 % nb), lane);
        { const int n0 = 64 * (itB % nb); conv_store<HAS_G, TILED>(RB, gl, WT, K, 64 * (itB / nb), gu ? gu_row(n0) : n0, gu ? gu_row(n0 + 32) : n0 + 32, scr, lane); }
        it += 2 * nwv;
    }
}


constexpr size_t CTL_BAR = 512 * 1024;
static_assert(CTL_WF + 8 * (size_t)D * 4 <= CTL_BAR && CTL_BAR + XCD_BAR_WORDS * 4 <= MiB, "control region");
constexpr size_t CTL_PCNT = CTL_BAR + 16384;
static_assert(CTL_PCNT + 32 * 256 <= MiB, "control region");
constexpr int LDS_XB = LDS_BYTES - 64;
#ifndef USE_TILED
#define USE_TILED false
#endif
#ifndef PHMASK
#define PHMASK 0x3ff
#endif
#define PH_ON(k) (((PHMASK) >> (k)) & 1)
struct Args { const float* in[17]; float* out; unsigned char* ws; };
typedef const __attribute__((address_space(4))) unsigned char* kargp_t;
__device__ __forceinline__ unsigned long long karg64(int i) { kargp_t p = (kargp_t)__builtin_amdgcn_kernarg_segment_ptr(); asm volatile("" : "+s"(p)); return *(const __attribute__((address_space(4))) unsigned long long*)(p + 8 * i); }
#define GAS1 __attribute__((address_space(1)))
#define ARG_IN(i) ((const float*)(const GAS1 float*)karg64(i))
#define ARG_OUT ((float*)(GAS1 float*)karg64(17))
#define ARG_WS ((unsigned char*)(GAS1 unsigned char*)karg64(18))

__global__ void __launch_bounds__(NTHR, 2) fwd_kernel(Args a) {
    extern __shared__ __attribute__((aligned(16))) unsigned char lds_raw[];
    LAS unsigned char* lds = (LAS unsigned char*)lds_raw;
    cg::grid_group grid = cg::this_grid();
    const int G = gridDim.x, bx = blockIdx.x, NGW = G * NWAVES;
    const int G1 = (G == 256) ? 235 : G - (G / 12 > 0 ? G / 12 : 1);
    if (threadIdx.x == 0) { ((volatile LAS unsigned*)(lds + LDS_XB))[0] = 0u; ((volatile LAS unsigned*)(lds + LDS_XB))[1] = 0u; }
    const XcdBarrier xbar = xcd_barrier_post((unsigned*)(ARG_WS + CTL_BAR), (volatile LAS unsigned*)(lds + LDS_XB));
#define TID_DECL int tid_l = threadIdx.x; asm volatile("" : "+v"(tid_l)); const int tid = tid_l, lane = tid & 63, wave = __builtin_amdgcn_readfirstlane(tid >> 6), gw = bx * NWAVES + wave; (void)lane; (void)gw;
#define P_SS(i) ((float*)(ws + CTL_SS) + (size_t)(i) * M)
#define P_LF ((float*)(ws + CTL_LF))
#define P_WF ((float*)(ws + CTL_WF))
#define P_CNT ((unsigned*)(ws + CTL_CNT))
#define P_BF(off) ((bf16*)(ws + (off)))
#define P_ACT P_BF(WS_R1)
#define P_QKV P_BF(WS_R1)
#define P_OB P_BF(WS_R1 + 96 * MiB)
#define P_AB P_BF(WS_AB)
#define P_H ((float*)(ws + WS_H))

    {
    if constexpr (PH_ON(0)) {
        unsigned char* const ws = ARG_WS;
        TID_DECL
        LAS float* scr = (LAS float*)(lds + wave * 16896);
        if ((bx & 1) != 0) {
        conv_matrix<true, true, false>(ARG_IN(3), NGU, ARG_IN(2), P_BF(WS_WGU1), D, NGU, gw, NGW, scr, lane, lds);
        }
        for (int m = gw; m < M; m += 2 * NGW) {
            const int m2 = (m + NGW < M) ? m + NGW : m;
            const f32x4* xa = (const f32x4*)(ARG_IN(0) + (size_t)m * D) + lane; const f32x4* xb_ = (const f32x4*)(ARG_IN(0) + (size_t)m2 * D) + lane; f32x4 va[8], vb[8];
#pragma unroll
            for (int j = 0; j < 8; ++j) va[j] = __builtin_nontemporal_load(xa + 64 * j);
#pragma unroll
            for (int j = 0; j < 8; ++j) vb[j] = __builtin_nontemporal_load(xb_ + 64 * j);
            float sa = 0.f, sb = 0.f;
#pragma unroll
            for (int j = 0; j < 8; ++j) { sa += (va[j][0] * va[j][0] + va[j][1] * va[j][1]) + (va[j][2] * va[j][2] + va[j][3] * va[j][3]); sb += (vb[j][0] * vb[j][0] + vb[j][1] * vb[j][1]) + (vb[j][2] * vb[j][2] + vb[j][3] * vb[j][3]); }
            sa = wave_sum(sa); sb = wave_sum(sb); if (lane == 0) { P_SS(0)[m] = sa; P_SS(0)[m2] = sb; }
            v2u* oa = (v2u*)(P_AB + (size_t)m * D) + lane; v2u* ob_ = (v2u*)(P_AB + (size_t)m2 * D) + lane;
#pragma unroll
            for (int j = 0; j < 8; ++j) { v2u o; o.x = pk2(va[j][0], va[j][1]); o.y = pk2(va[j][2], va[j][3]); oa[64 * j] = o; }
#pragma unroll
            for (int j = 0; j < 8; ++j) { v2u o; o.x = pk2(vb[j][0], vb[j][1]); o.y = pk2(vb[j][2], vb[j][3]); ob_[64 * j] = o; }
        }
        if ((bx & 1) == 0) {
        conv_matrix<true, true, false>(ARG_IN(3), NGU, ARG_IN(2), P_BF(WS_WGU1), D, NGU, gw, NGW, scr, lane, lds);
        }
        for (int i = bx * NTHR + tid; i < 4 * M; i += G * NTHR) P_SS(1)[i] = 0.f;
        if (bx == 0 && tid == 0) { P_CNT[0] = 0u; P_CNT[64] = 0u; }
        if (bx == 1) for (int i = tid; i < 32 * 64; i += NTHR) ((unsigned*)(ws + CTL_PCNT))[i] = 0u;
    }
    }
    if (ARG_WS == nullptr) grid.sync();
    xcd_barrier(xbar);

    {
    if constexpr (PH_ON(1)) {
        unsigned char* const ws = ARG_WS;
        if (bx < G1) { pg8::Gemm g{P_AB, P_BF(WS_WGU1), M, NGU, D}; pg8::StaticOrder S; S.init(M, NGU, G1, bx);
          pg8::EpiSwiglu E{P_ACT, P_SS(0)};
          pg8::gemm_phase<pg8::EpiSwiglu, pg8::StaticOrder, true, true>(lds, g, S, E); }
        else {
            TID_DECL
            LAS float* scr = (LAS float*)(lds + wave * 16896); const int wv = (bx - G1) * NWAVES + wave, nwv = (G - G1) * NWAVES;
            for (int i = (bx - G1) * NTHR + tid; i < 8 * D; i += (G - G1) * NTHR) { const int j = i / D, k = i % D; P_WF[i] = ARG_IN(5)[k] * ARG_IN(6)[(size_t)k * DIN + NQKV + j]; }
            conv_matrix<false, false, true, USE_TILED>(ARG_IN(4), D, nullptr, P_BF(WS_WD1), FF, D, wv, nwv, scr, lane, lds);
            conv_matrix<false, false, true>(ARG_IN(15), D, nullptr, P_BF(WS_WP), DPLE, D, wv, nwv, scr, lane, lds);
            conv_matrix<true, false, true>(ARG_IN(6), DIN, ARG_IN(5), P_BF(WS_WIN), D, NQKV, wv, nwv, scr, lane, lds);
            conv_matrix<false, false, true>(ARG_IN(9), D, nullptr, P_BF(WS_WOUT), D, D, wv, nwv, scr, lane, lds);
        }
    }
    }
    xcd_barrier(xbar);
    if constexpr (PH_ON(2)) {
        unsigned char* const ws = ARG_WS;
        pg8::Gemm g{P_ACT, P_BF(WS_WD1), M, D, FF}; pg8::StaticOrder S; S.init(M, D, G, bx);
        pg8::EpiResid<true> E{nullptr, P_AB, P_SS(1), 0.5f, xbar};
        pg8::gemm_phase<pg8::EpiResid<true>, pg8::StaticOrder, false, true, USE_TILED>(lds, g, S, E);
    }
    {
    if constexpr (PH_ON(3)) {
        unsigned char* const ws = ARG_WS;
        TID_DECL
        pg8::Gemm g{P_AB, P_BF(WS_WIN), M, NQKV, D}; pg8::StaticOrder S; S.init(M, NQKV, G, bx);
        pg8::EpiQKV E{P_QKV, P_SS(1), 0.08838834764831845f * 1.4426950408889634f, QKV_T};
        pg8::gemm_phase<pg8::EpiQKV, pg8::StaticOrder, true, true>(lds, g, S, E);
        for (int m = gw; m < M; m += 2 * NGW) {
            const int m2 = (m + NGW < M) ? m + NGW : m;
            const v2u* hra = (const v2u*)(P_AB + (size_t)m * D) + lane; const v2u* hrb = (const v2u*)(P_AB + (size_t)m2 * D) + lane; f32x4 va[8], vb[8];
#pragma unroll
            for (int j = 0; j < 8; ++j) { const v2u w = hra[64 * j]; va[j] = (f32x4){__uint_as_float(w.x << 16), __uint_as_float(w.x & 0xffff0000u), __uint_as_float(w.y << 16), __uint_as_float(w.y & 0xffff0000u)}; }
#pragma unroll
            for (int j = 0; j < 8; ++j) { const v2u w = hrb[64 * j]; vb[j] = (f32x4){__uint_as_float(w.x << 16), __uint_as_float(w.x & 0xffff0000u), __uint_as_float(w.y << 16), __uint_as_float(w.y & 0xffff0000u)}; }
            float sa[8], sb[8];
#pragma unroll
            for (int jj = 0; jj < 8; ++jj) { const f32x4* wr_ = (const f32x4*)(P_WF + (size_t)jj * D) + lane; float a = 0.f, b = 0.f;
#pragma unroll
                for (int j = 0; j < 8; ++j) { const f32x4 wv = wr_[64 * j];
                    a += (va[j][0] * wv[0] + va[j][1] * wv[1]) + (va[j][2] * wv[2] + va[j][3] * wv[3]); b += (vb[j][0] * wv[0] + vb[j][1] * wv[1]) + (vb[j][2] * wv[2] + vb[j][3] * wv[3]); }
                sa[jj] = a; sb[jj] = b; }
            const bool u5 = lane >= 32, u4 = (lane >> 4) & 1, u3 = (lane >> 3) & 1;
#define FRED(s, out) { float b4[4], c2[2]; _Pragma("unroll") for (int k = 0; k < 4; ++k) { const float snd = u5 ? s[k] : s[k + 4]; b4[k] = (u5 ? s[k + 4] : s[k]) + __shfl_xor(snd, 32); } \
                _Pragma("unroll") for (int k = 0; k < 2; ++k) { const float snd = u4 ? b4[k] : b4[k + 2]; c2[k] = (u4 ? b4[k + 2] : b4[k]) + __shfl_xor(snd, 16); } \
                { const float snd = u3 ? c2[0] : c2[1]; out = (u3 ? c2[1] : c2[0]) + __shfl_xor(snd, 8); } out += __shfl_xor(out, 4); out += __shfl_xor(out, 2); out += __shfl_xor(out, 1); }
            float da, db; FRED(sa, da) FRED(sb, db)
#undef FRED
            if ((lane & 7) == 0) { const int jj = lane >> 3; const float bf = ARG_IN(7)[jj];
                const float za = da * pg8::rs_of(P_SS(1), m) + bf, zb = db * pg8::rs_of(P_SS(1), m2) + bf;
                P_LF[(size_t)m * 8 + jj] = fminf(za, 0.f) - log1pf(__expf(-fabsf(za))); P_LF[(size_t)m2 * 8 + jj] = fminf(zb, 0.f) - log1pf(__expf(-fabsf(zb))); }
        }
    }
    xcd_barrier(xbar);
    }
    if constexpr (PH_ON(4)) {
        unsigned char* const ws = ARG_WS;
        TID_DECL
        const int GA = G - 56;
        if (bx >= GA) {
            LAS float* scr = (LAS float*)(lds + wave * 16896); const int wv = (bx - GA) * NWAVES + wave, nwv = (G - GA) * NWAVES;
            conv_matrix<true, true, true>(ARG_IN(11), NGU, ARG_IN(10), P_BF(WS_WGU2), D, NGU, wv, nwv, scr, lane, lds);
            { constexpr int NP4 = M * DPLE / 4; const int t0 = (bx - GA) * NTHR + tid, st = (G - GA) * NTHR;
              for (int i = t0; i < NP4; i += 8 * st) { f32x4 v[8];
#pragma unroll
                for (int q = 0; q < 8; ++q) { const int ii = i + q * st; v[q] = ((const f32x4*)ARG_IN(1))[ii < NP4 ? ii : i]; }
#pragma unroll
                for (int q = 0; q < 8; ++q) { const int ii = i + q * st; if (ii < NP4) { v2u o; o.x = pk2(v[q][0], v[q][1]); o.y = pk2(v[q][2], v[q][3]); ((v2u*)P_BF(WS_PB))[ii] = o; } } } }
            __syncthreads();
        }
        {
        LAS unsigned* slot = (LAS unsigned*)(lds + att::OFF_MISC);
        att::Tensors TA{P_QKV, P_QKV + QKV_T, P_QKV + 2 * QKV_T, P_OB, P_LF, ARG_IN(8)};
        att::Tensors TB{P_QKV + 3 * QKV_T, P_QKV + 4 * QKV_T, P_QKV + 5 * QKV_T, P_OB + 1024, P_LF, ARG_IN(8)};
        { const int rep = 0;
        for (;;) {
            if (tid == 0) slot[0] = atomicAdd(P_CNT + 64 * rep, 1u);
            __syncthreads();
            const int item = (int)slot[0];
            __syncthreads();
            if (item >= 512) break;
            int mode, blk_, bh;
            bh = item % 32; { const int grp = item / 32;
              if (grp < 5) { mode = 1; blk_ = 7 - grp; }
              else if (grp < 11) { mode = 0; blk_ = 12 - grp; }
              else if (grp == 11) { mode = 1; blk_ = 2; }
              else if (grp == 12) { mode = 0; blk_ = 1; }
              else if (grp == 13) { mode = 1; blk_ = 1; }
              else if (grp == 14) { mode = 0; blk_ = 0; }
              else { mode = 1; blk_ = 0; } }
            if (mode) att::attn_item<1>(lds, TB, bh >> 3, bh & 7, blk_); else att::attn_item<0>(lds, TA, bh >> 3, bh & 7, blk_);
        }
        }
        }
    }
    xcd_barrier(xbar);
    if constexpr (PH_ON(5)) {
        unsigned char* const ws = ARG_WS;
        pg8::Gemm g{P_OB, P_BF(WS_WOUT), M, D, D}; pg8::StaticOrder S; S.init(M, D, G, bx);
        pg8::EpiResid<true> E{nullptr, P_AB, P_SS(2), 1.0f, xbar};
        pg8::gemm_phase<pg8::EpiResid<true>, pg8::StaticOrder, false, true>(lds, g, S, E);
    }
    {
    if constexpr (PH_ON(6)) {
        unsigned char* const ws = ARG_WS;
        if (bx < G1) { pg8::Gemm g{P_AB, P_BF(WS_WGU2), M, NGU, D}; pg8::StaticOrder S; S.init(M, NGU, G1, bx);
          pg8::EpiSwiglu E{P_ACT, P_SS(2)};
          pg8::gemm_phase<pg8::EpiSwiglu, pg8::StaticOrder, true, true>(lds, g, S, E); }
        else {
            { int Kpp = DPLE; asm volatile("" : "+s"(Kpp));
              pg8::Gemm g2{P_BF(WS_PB), P_BF(WS_WP), M, D, Kpp}; pg8::StaticOrder S2; S2.init(M, D, G - G1, bx - G1); pg8::EpiBf16Plain E2{P_OB};
              pg8::gemm_phase<pg8::EpiBf16Plain, pg8::StaticOrder, true, true>(lds, g2, S2, E2); }
            TID_DECL
            LAS float* scr = (LAS float*)(lds + wave * 16896); const int wv = (bx - G1) * NWAVES + wave, nwv = (G - G1) * NWAVES;
            conv_matrix<false, false, true, USE_TILED>(ARG_IN(12), D, nullptr, P_BF(WS_WD2), FF, D, wv, nwv, scr, lane, lds);
            conv_matrix<true, false, true>(ARG_IN(14), D, ARG_IN(13), P_BF(WS_WG), D, D, wv, nwv, scr, lane, lds);
        }
    }
    xcd_barrier(xbar);
    }
    if constexpr (PH_ON(7)) {
        unsigned char* const ws = ARG_WS;
        pg8::Gemm g{P_ACT, P_BF(WS_WD2), M, D, FF}; pg8::StaticOrder S; S.init(M, D, G, bx);
        pg8::EpiResid<true> E{nullptr, P_AB, P_SS(3), 0.5f, xbar};
        pg8::gemm_phase<pg8::EpiResid<true>, pg8::StaticOrder, false, true, USE_TILED>(lds, g, S, E);
    }
    if constexpr (PH_ON(8)) {
        unsigned char* const ws = ARG_WS;
        pg8::Gemm g{P_AB, P_BF(WS_WG), M, D, D}; pg8::StaticOrder S; S.init(M, D, G, bx);
        pg8::EpiPleNorm E{P_AB, ARG_OUT, P_SS(3), P_SS(4), ARG_IN(16), (unsigned*)(ws + CTL_PCNT), P_OB};
        pg8::gemm_phase<pg8::EpiPleNorm, pg8::StaticOrder, false, true>(lds, g, S, E);
    }
}

extern "C" void kernel_launch(void* const* d_in, const int* in_sizes, int n_in, void* d_out, int out_size, void* d_ws, size_t ws_size, hipStream_t stream) {
    static int grid = 0;
    if (grid == 0) {
        if (n_in != 17 || out_size != M * D || ws_size < WS_END) { fprintf(stderr, "kernel_launch: unexpected problem (n_in %d, out %d, ws %zu, need %zu)\n", n_in, out_size, ws_size, (size_t)WS_END); grid = -1; return; }
        int dev = 0, cus = 0, per_cu = 0;
        hipGetDevice(&dev); hipDeviceGetAttribute(&cus, hipDeviceAttributeMultiprocessorCount, dev);
        if (hipFuncSetAttribute((const void*)fwd_kernel, hipFuncAttributeMaxDynamicSharedMemorySize, LDS_BYTES) != hipSuccess) { fprintf(stderr, "kernel_launch: hipFuncSetAttribute failed\n"); grid = -1; return; }
        if (hipOccupancyMaxActiveBlocksPerMultiprocessor(&per_cu, (const void*)fwd_kernel, NTHR, LDS_BYTES) != hipSuccess || per_cu < 1) { fprintf(stderr, "kernel_launch: occupancy query says %d\n", per_cu); per_cu = 1; }
        (void)hipGetLastError();
        if (cus != 256) { fprintf(stderr, "kernel_launch: built for a 256-CU device (got %d CUs); nothing launched\n", cus); grid = -1; return; }
        grid = cus;
    }
    if (grid < 0) return;
    Args a{};
    for (int i = 0; i < 17; ++i) a.in[i] = (const float*)d_in[i];
    a.out = (float*)d_out; a.ws = (unsigned char*)d_ws;
    void* args[] = {&a};
    if (hipMemsetAsync((char*)d_ws + CTL_BAR, 0, XCD_BAR_WORDS * 4, stream) != hipSuccess) { fprintf(stderr, "kernel_launch: hipMemsetAsync failed\n"); return; }
    hipError_t e = hipLaunchCooperativeKernel((const void*)fwd_kernel, dim3(grid), dim3(NTHR), args, LDS_BYTES, stream);
    if (e != hipSuccess) fprintf(stderr, "cooperative launch failed: %s (grid %d)\n", hipGetErrorString(e), grid);
}
```
